# Optimizing an MI355X kernel written in HIP

```python
import math
import jax
import jax.numpy as jnp
from jax import lax
import numpy as np


D_MODEL = 1024
BATCH = 8
SEQ = 2048
DEPTH = 4

RMS_EPS = 1e-6
LN_EPS = 1e-5
NEG_INF = -1e30

NSA_HEADS = 8
NSA_KV_HEADS = 2
NSA_GROUP = NSA_HEADS // NSA_KV_HEADS
HEAD_DIM = 64
CMP_BLOCK = 32
CMP_STRIDE = 16
CMP_HIDDEN = 256
SEL_BLOCK = 64
SEL_TOPK = 16
WINDOW = 512
Q_BLOCK = 64
FORCE_BONUS = 1e4

SSM_HEADS = 8
SSM_HEAD_DIM = 64
SSM_D_INNER = SSM_HEADS * SSM_HEAD_DIM
SSM_GROUPS = 2
SSM_STATE = 128
SSM_CONV = 4
SSM_CHUNK = 128
SSM_BC_DIM = SSM_GROUPS * SSM_STATE
SSM_CONV_DIM = SSM_D_INNER + 2 * SSM_BC_DIM

GMLP_WIDTH = 2 * D_MODEL
GMLP_GROUPS = 8
GMLP_GROUP_DIM = GMLP_WIDTH // GMLP_GROUPS
GMLP_CHUNK = 128

FFN_HIDDEN = -(-8 * D_MODEL // (3 * 256)) * 256

NSA_Q_DIM = NSA_HEADS * HEAD_DIM
NSA_KV_DIM = NSA_KV_HEADS * HEAD_DIM
NSA_GATE_DIM = 3 * NSA_HEADS
EVEN_SPLITS = (NSA_Q_DIM,) + (NSA_KV_DIM,) * 6 + (NSA_GATE_DIM, SSM_D_INNER, SSM_CONV_DIM, SSM_HEADS)
EVEN_SPLIT_POINTS = [int(v) for v in np.cumsum(EVEN_SPLITS)[:-1]]
EVEN_IN_DIM = int(sum(EVEN_SPLITS))
EVEN_MIX_DIM = NSA_Q_DIM + SSM_D_INNER

kernel_name = 'hybrid_nsa_ssd_gmlp_trunk'


def rms_norm(x, w):
    xf = x.astype(jnp.float32)
    y = xf * lax.rsqrt(jnp.mean(jnp.square(xf), axis=-1, keepdims=True) + RMS_EPS)
    return (y * w.astype(jnp.float32)).astype(x.dtype)


def layer_norm(x, w, b):
    xf = x.astype(jnp.float32)
    mu = jnp.mean(xf, axis=-1, keepdims=True)
    var = jnp.mean(jnp.square(xf - mu), axis=-1, keepdims=True)
    y = (xf - mu) * lax.rsqrt(var + LN_EPS) * w.astype(jnp.float32) + b.astype(jnp.float32)
    return y.astype(x.dtype)


def masked_softmax(scores, mask):
    p = jax.nn.softmax(jnp.where(mask, scores, NEG_INF), axis=-1)
    return jnp.where(mask, p, 0.0)


def alibi_slopes(n):
    return (2.0 ** (-8.0 * np.arange(1, n + 1) / n)).astype(np.float32)


def compress_blocks(kv, pe, w1, w2):
    s = kv.shape[2]
    n_cmp = (s - CMP_BLOCK) // CMP_STRIDE + 1
    idx = np.arange(n_cmp)[:, None] * CMP_STRIDE + np.arange(CMP_BLOCK)[None, :]
    blocks = kv[:, :, idx] + pe
    blocks = blocks.reshape(blocks.shape[:3] + (CMP_BLOCK * HEAD_DIM,))
    return jax.nn.silu(blocks @ w1) @ w2


def selection_overlap(n_cmp, n_sel):
    cs = np.arange(n_cmp)[:, None] * CMP_STRIDE
    ss = np.arange(n_sel)[None, :] * SEL_BLOCK
    ov = np.minimum(cs + CMP_BLOCK, ss + SEL_BLOCK) - np.maximum(cs, ss)
    return (np.clip(ov, 0, None) / CMP_BLOCK).astype(np.float32)


def nsa_attention(q, kc, vc, ks, vs, kw, vw, gate_logits, cmp_pe, cmp_w1, cmp_w2):
    b, s = q.shape[0], q.shape[1]
    dtype = q.dtype
    f32 = jnp.float32
    g, r, hd = NSA_KV_HEADS, NSA_GROUP, HEAD_DIM
    qg = (q * (hd ** -0.5)).transpose(0, 2, 1, 3).reshape(b, g, r, s, hd)
    kc, vc, ks, vs, kw, vw = [t.transpose(0, 2, 1, 3) for t in (kc, vc, ks, vs, kw, vw)]
    slopes = jnp.asarray(alibi_slopes(NSA_HEADS).reshape(g, r))[:, :, None, None]
    pos = np.arange(s)

    kcb = compress_blocks(kc, cmp_pe[0], cmp_w1[0], cmp_w2[0])
    vcb = compress_blocks(vc, cmp_pe[1], cmp_w1[1], cmp_w2[1])
    n_cmp = kcb.shape[2]
    cmp_end = np.arange(n_cmp) * CMP_STRIDE + CMP_BLOCK - 1
    d_cmp = (pos[:, None] - cmp_end[None, :]).astype(np.float32)
    s_cmp = jnp.einsum('bgrtd,bgcd->bgrtc', qg, kcb).astype(f32) - slopes * d_cmp
    p_cmp = masked_softmax(s_cmp, d_cmp >= 0)
    o_cmp = jnp.einsum('bgrtc,bgcd->bgrtd', p_cmp.astype(dtype), vcb)

    n_sel = s // SEL_BLOCK
    top_k = min(SEL_TOPK, n_sel)
    imp = jnp.einsum('bgrtc,cj->bgtj', p_cmp, jnp.asarray(selection_overlap(n_cmp, n_sel)))
    blk = np.arange(n_sel)[None, :]
    cur = (pos // SEL_BLOCK)[:, None]
    forced = ((blk == 0) | (blk == cur) | (blk == cur - 1)).astype(np.float32) * FORCE_BONUS
    eligible = blk * SEL_BLOCK <= pos[:, None]
    imp = jnp.where(eligible, imp + forced, -1.0)
    _, sel_idx = lax.top_k(imp, top_k)

    nqb = s // Q_BLOCK
    q_blocks = qg.reshape(b, g, r, nqb, Q_BLOCK, hd).transpose(3, 0, 1, 2, 4, 5)
    idx_blocks = sel_idx.reshape(b, g, nqb, Q_BLOCK, top_k).transpose(2, 0, 1, 3, 4)
    ks_blk = ks.reshape(b, g, n_sel, SEL_BLOCK, hd)
    vs_blk = vs.reshape(b, g, n_sel, SEL_BLOCK, hd)
    pad = ((0, 0), (0, 0), (WINDOW, 0), (0, 0))
    kw_pad = jnp.pad(kw, pad)
    vw_pad = jnp.pad(vw, pad)
    gather_blocks = jax.vmap(jax.vmap(lambda kv, ix: kv[ix]))
    n_key_sel = top_k * SEL_BLOCK
    n_key_win = Q_BLOCK + WINDOW

    def query_block(args):
        qi, q_blk, ix = args
        start = qi * Q_BLOCK
        t = start + jnp.arange(Q_BLOCK)
        k_sel = gather_blocks(ks_blk, ix).reshape(b, g, Q_BLOCK, n_key_sel, hd)
        v_sel = gather_blocks(vs_blk, ix).reshape(b, g, Q_BLOCK, n_key_sel, hd)
        s_pos = (ix[..., None] * SEL_BLOCK + jnp.arange(SEL_BLOCK)).reshape(b, g, Q_BLOCK, n_key_sel)
        d_sel = (t[:, None] - s_pos)[:, :, None]
        s_sel = jnp.einsum('bgrqd,bgqkd->bgrqk', q_blk, k_sel).astype(f32) - slopes * d_sel.astype(f32)
        o_sel = jnp.einsum('bgrqk,bgqkd->bgrqd', masked_softmax(s_sel, d_sel >= 0).astype(dtype), v_sel)
        k_win = lax.dynamic_slice_in_dim(kw_pad, start, n_key_win, axis=2)
        v_win = lax.dynamic_slice_in_dim(vw_pad, start, n_key_win, axis=2)
        w_pos = start - WINDOW + jnp.arange(n_key_win)
        d_win = t[:, None] - w_pos[None, :]
        s_win = jnp.einsum('bgrqd,bgkd->bgrqk', q_blk, k_win).astype(f32) - slopes * d_win.astype(f32)
        win_mask = (d_win >= 0) & (d_win < WINDOW) & (w_pos >= 0)[None, :]
        o_win = jnp.einsum('bgrqk,bgkd->bgrqd', masked_softmax(s_win, win_mask).astype(dtype), v_win)
        return o_sel, o_win

    o_sel, o_win = lax.map(query_block, (jnp.arange(nqb), q_blocks, idx_blocks))
    o_sel = o_sel.transpose(1, 2, 3, 0, 4, 5).reshape(b, g, r, s, hd)
    o_win = o_win.transpose(1, 2, 3, 0, 4, 5).reshape(b, g, r, s, hd)

    gates = jax.nn.sigmoid(gate_logits.astype(f32)).astype(dtype).transpose(0, 2, 1, 3).reshape(b, g, r, s, 3)
    out = gates[..., 0:1] * o_cmp + gates[..., 1:2] * o_sel + gates[..., 2:3] * o_win
    return out.reshape(b, NSA_HEADS, s, hd).transpose(0, 2, 1, 3).reshape(b, s, NSA_HEADS * hd)


def causal_depthwise_conv(x, w, bias):
    ch = x.shape[-1]
    y = lax.conv_general_dilated(x, w[:, None, :].astype(x.dtype), window_strides=(1,),
                                 padding=[(SSM_CONV - 1, 0)], dimension_numbers=('NWC', 'WIO', 'NWC'),
                                 feature_group_count=ch)
    return y + bias.astype(x.dtype)


def ssd_chunked(x, a, bm, cm):
    b, s, h, p = x.shape
    g, n = bm.shape[2], bm.shape[3]
    r = h // g
    c, l = s // SSM_CHUNK, SSM_CHUNK
    x = x.reshape(b, c, l, g, r, p)
    bm = bm.reshape(b, c, l, g, n)
    cm = cm.reshape(b, c, l, g, n)
    a_cs = jnp.cumsum(a.reshape(b, c, l, g, r).transpose(0, 3, 4, 1, 2), axis=-1)
    causal = np.tril(np.ones((l, l), dtype=bool))
    decay_in = jnp.exp(jnp.where(causal, a_cs[..., :, None] - a_cs[..., None, :], -jnp.inf))
    cb = jnp.einsum('bclgn,bcsgn->bgcls', cm, bm)
    y_diag = jnp.einsum('bgrcls,bcsgrp->bclgrp', cb[:, :, None] * decay_in, x)
    decay_states = jnp.exp(a_cs[..., -1:] - a_cs)
    states = jnp.einsum('bcsgn,bgrcs,bcsgrp->bcgrpn', bm, decay_states, x)
    chunk_decay = jnp.exp(a_cs[..., -1])

    def step(carry, inp):
        st, dec = inp
        return carry * dec[..., None, None] + st, carry

    init = jnp.zeros((b, g, r, p, n), jnp.float32)
    _, prev = lax.scan(step, init, (states.transpose(1, 0, 2, 3, 4, 5), chunk_decay.transpose(3, 0, 1, 2)))
    prev = prev.transpose(1, 0, 2, 3, 4, 5)
    y_off = jnp.einsum('bclgn,bcgrpn,bgrcl->bclgrp', cm, prev, jnp.exp(a_cs))
    return (y_diag + y_off).reshape(b, s, h, p)


def mamba2_mixer(z, xbc, dt, conv_w, conv_b, dt_bias, a_log, d_skip, norm_w):
    b, s = z.shape[0], z.shape[1]
    dtype = z.dtype
    f32 = jnp.float32
    xbc = jax.nn.silu(causal_depthwise_conv(xbc, conv_w, conv_b))
    xs, bm, cm = jnp.split(xbc, [SSM_D_INNER, SSM_D_INNER + SSM_BC_DIM], axis=-1)
    xs = xs.reshape(b, s, SSM_HEADS, SSM_HEAD_DIM).astype(f32)
    bm = bm.reshape(b, s, SSM_GROUPS, SSM_STATE).astype(f32)
    cm = cm.reshape(b, s, SSM_GROUPS, SSM_STATE).astype(f32)
    dt = jax.nn.softplus(dt.astype(f32) + dt_bias.astype(f32))
    a = -jnp.exp(a_log.astype(f32))
    y = ssd_chunked(xs * dt[..., None], dt * a, bm, cm)
    y = y + xs * d_skip.astype(f32)[:, None]
    gsz = SSM_D_INNER // SSM_GROUPS
    y = y.reshape(b, s, SSM_GROUPS, gsz) * jax.nn.silu(z.astype(f32)).reshape(b, s, SSM_GROUPS, gsz)
    y = rms_norm(y, norm_w.reshape(SSM_GROUPS, gsz))
    return y.reshape(b, s, SSM_D_INNER).astype(dtype)


def attn_ssm_mixer(h, w_in, w_out, cmp_pe, cmp_w1, cmp_w2, conv_w, conv_b, dt_bias, a_log, d_skip, norm_w):
    b, s = h.shape[0], h.shape[1]
    q, kc, vc, ks, vs, kw, vw, gl, z, xbc, dt = jnp.split(h @ w_in, EVEN_SPLIT_POINTS, axis=-1)
    kv = [t.reshape(b, s, NSA_KV_HEADS, HEAD_DIM) for t in (kc, vc, ks, vs, kw, vw)]
    o_attn = nsa_attention(q.reshape(b, s, NSA_HEADS, HEAD_DIM), kv[0], kv[1], kv[2], kv[3], kv[4], kv[5],
                           gl.reshape(b, s, NSA_HEADS, 3), cmp_pe, cmp_w1, cmp_w2)
    o_ssm = mamba2_mixer(z, xbc, dt, conv_w, conv_b, dt_bias, a_log, d_skip, norm_w)
    return jnp.concatenate([o_attn, o_ssm], axis=-1) @ w_out


def chunked_gmlp(h, w_in, ln_w, ln_b, w_s, b_s, w_out):
    b, s = h.shape[0], h.shape[1]
    u, v = jnp.split(jax.nn.gelu(h @ w_in, approximate=False), 2, axis=-1)
    v = layer_norm(v, ln_w, ln_b).reshape(b, s // GMLP_CHUNK, GMLP_CHUNK, GMLP_GROUPS, GMLP_GROUP_DIM)
    causal = np.tril(np.ones((GMLP_CHUNK, GMLP_CHUNK), dtype=bool))
    ws = jnp.where(causal, w_s, jnp.zeros_like(w_s))
    mixed = jnp.einsum('gts,bcsgd->bctgd', ws, v) + b_s.T[:, :, None]
    return (u * mixed.reshape(b, s, GMLP_WIDTH)) @ w_out


def swiglu_ffn(h, w_gate, w_up, w_down):
    return (jax.nn.silu(h @ w_gate) * (h @ w_up)) @ w_down


def setup_inputs(seed: int = 0) -> dict:
    key = jax.random.key(seed)
    k = jax.random.split(key, 24)
    ne, no = (DEPTH + 1) // 2, DEPTH // 2
    f32 = jnp.float32

    def normal(kk, shape, scale):
        return scale * jax.random.normal(kk, shape, f32)

    dt0 = jnp.exp(jax.random.uniform(k[12], (ne, SSM_HEADS), f32, math.log(1e-3), math.log(1e-1)))
    return {
        'x': normal(k[0], (BATCH, SEQ, D_MODEL), 1.0),
        'norm_gains': 1.0 + normal(k[1], (DEPTH, 4, D_MODEL), 0.05),
        'ffn_w_gate': normal(k[2], (DEPTH, D_MODEL, FFN_HIDDEN), D_MODEL ** -0.5),
        'ffn_w_up': normal(k[3], (DEPTH, D_MODEL, FFN_HIDDEN), D_MODEL ** -0.5),
        'ffn_w_down': normal(k[4], (DEPTH, FFN_HIDDEN, D_MODEL), FFN_HIDDEN ** -0.5),
        'ev_w_in': normal(k[5], (ne, D_MODEL, EVEN_IN_DIM), D_MODEL ** -0.5),
        'ev_w_out': normal(k[6], (ne, EVEN_MIX_DIM, D_MODEL), EVEN_MIX_DIM ** -0.5),
        'nsa_cmp_pe': normal(k[7], (ne, 2, CMP_BLOCK, HEAD_DIM), 0.1),
        'nsa_cmp_w1': normal(k[8], (ne, 2, CMP_BLOCK * HEAD_DIM, CMP_HIDDEN), (CMP_BLOCK * HEAD_DIM) ** -0.5),
        'nsa_cmp_w2': normal(k[9], (ne, 2, CMP_HIDDEN, HEAD_DIM), CMP_HIDDEN ** -0.5),
        'ssm_conv_w': normal(k[10], (ne, SSM_CONV, SSM_CONV_DIM), SSM_CONV ** -0.5),
        'ssm_conv_b': normal(k[11], (ne, SSM_CONV_DIM), 0.02),
        'ssm_dt_bias': dt0 + jnp.log(-jnp.expm1(-dt0)),
        'ssm_a_log': jnp.log(jax.random.uniform(k[13], (ne, SSM_HEADS), f32, 1.0, 16.0)),
        'ssm_d': 1.0 + normal(k[14], (ne, SSM_HEADS), 0.1),
        'ssm_norm_w': 1.0 + normal(k[15], (ne, SSM_D_INNER), 0.05),
        'od_w_in': normal(k[16], (no, D_MODEL, 2 * GMLP_WIDTH), D_MODEL ** -0.5),
        'od_ln_w': 1.0 + normal(k[17], (no, GMLP_WIDTH), 0.05),
        'od_ln_b': normal(k[18], (no, GMLP_WIDTH), 0.02),
        'od_w_s': normal(k[19], (no, GMLP_GROUPS, GMLP_CHUNK, GMLP_CHUNK), GMLP_CHUNK ** -0.5),
        'od_b_s': 1.0 + normal(k[20], (no, GMLP_GROUPS, GMLP_CHUNK), 0.05),
        'od_w_out': normal(k[21], (no, GMLP_WIDTH, D_MODEL), GMLP_WIDTH ** -0.5),
    }


def reference(x, norm_gains, ffn_w_gate, ffn_w_up, ffn_w_down, ev_w_in, ev_w_out, nsa_cmp_pe, nsa_cmp_w1,
              nsa_cmp_w2, ssm_conv_w, ssm_conv_b, ssm_dt_bias, ssm_a_log, ssm_d, ssm_norm_w, od_w_in, od_ln_w,
              od_ln_b, od_w_s, od_b_s, od_w_out):
    h = x
    for layer in range(DEPTH):
        gains = norm_gains[layer]
        i = layer // 2
        y = rms_norm(h, gains[0])
        if layer % 2 == 0:
            y = attn_ssm_mixer(y, ev_w_in[i], ev_w_out[i], nsa_cmp_pe[i], nsa_cmp_w1[i], nsa_cmp_w2[i],
                               ssm_conv_w[i], ssm_conv_b[i], ssm_dt_bias[i], ssm_a_log[i], ssm_d[i], ssm_norm_w[i])
        else:
            y = chunked_gmlp(y, od_w_in[i], od_ln_w[i], od_ln_b[i], od_w_s[i], od_b_s[i], od_w_out[i])
        h = h + rms_norm(y, gains[1])
        y = swiglu_ffn(rms_norm(h, gains[2]), ffn_w_gate[layer], ffn_w_up[layer], ffn_w_down[layer])
        h = h + rms_norm(y, gains[3])
    return h
```

```cpp
#include <hip/hip_runtime.h>
#include <cstdio>
#include <cstdint>

namespace pg8 {
#define PG8_LAS __attribute__((address_space(3)))
typedef unsigned short bf16_t;
typedef short bf16x8 __attribute__((ext_vector_type(8)));
typedef float f32x4 __attribute__((ext_vector_type(4)));
typedef unsigned u32x4 __attribute__((ext_vector_type(4)));
typedef float f32x2 __attribute__((ext_vector_type(2)));
constexpr int BM = 256, BK = 64, HALF = 128, HTB = HALF * BK * 2  , STAGE_BYTES = 8 * HTB, NXCD = 8, WGM = 8;

__host__ __device__ __forceinline__ int lds_byte(int r, int c) { const int st = (r >> 4) * 2 + (c >> 5), rr = r & 15, cc = c & 31, ob = rr * 64 + cc * 2; return st * 1024 + (ob ^ (((ob >> 9) & 1) << 5)); }
__host__ __device__ __forceinline__ void stage_rc(int b, int& R, int& C) { const int st = b / 1024, sb = b % 1024, swz = sb ^ (((sb >> 9) & 1) << 5); R = (st >> 1) * 16 + swz / 64; C = (st & 1) * 32 + (swz % 64) / 2; }
__host__ __device__ __forceinline__ int perm32(int rho) { const int n = rho >> 4, i = rho & 15; return 8 * (i >> 2) + 4 * n + (i & 3); }

struct Unit { int pm, pn; };
struct Gemm { const bf16_t* A; const bf16_t* Bt; int M, N, K, lda; };

struct StaticOrder {
    int nM, nN, nwg, G, c;
    __host__ __device__ void init(int M, int N, int G_, int c_) { nM = M / BM; nN = N / BM; nwg = nM * nN; G = G_; c = c_; }
    __host__ __device__ bool next(int i, Unit& u) const {
        const long L = (long)i * G + c; if (L >= nwg) return false;
        int wgid = (int)L; { const int q = nwg / NXCD, r = nwg % NXCD, xcd = wgid % NXCD, off = wgid / NXCD; wgid = (xcd < r ? xcd * (q + 1) : r * (q + 1) + (xcd - r) * q) + off; }
        const int nig = WGM * nN, gid = wgid / nig, fm = gid * WGM, gsz = (nM - fm) < WGM ? (nM - fm) : WGM;
        u.pm = fm + ((wgid % nig) % gsz); u.pn = (wgid % nig) / gsz; return true;
    }
    __device__ __forceinline__ void a_ready(const Unit&) const {}
    __device__ __forceinline__ void done(const Unit&) const {}
};
struct CmpOrder {
    int c;
    __device__ bool next(int i, Unit& u) const { if (i > 0 || c >= 16) return false; u.pm = c; u.pn = c >> 3; return true; }
    __device__ __forceinline__ void a_ready(const Unit&) const {}
    __device__ __forceinline__ void done(const Unit&) const {}
};

__device__ __forceinline__ unsigned cvt_pk_bf16(float lo, float hi) { unsigned r; asm volatile("v_cvt_pk_bf16_f32 %0, %1, %2" : "=v"(r) : "v"(lo), "v"(hi)); return r; }
__device__ __forceinline__ f32x2 gelu_pk(f32x2 v) {
    const f32x2 av = __builtin_elementwise_abs(v), d = av * 0.2316418882f + 1.0f;
    f32x2 t; t.x = __builtin_amdgcn_rcpf(d.x); t.y = __builtin_amdgcn_rcpf(d.y);
    f32x2 q = t * 0.5307027145f + (-0.7265760135f); q = q * t + 0.7107068705f; q = q * t + (-0.142248368f); q = q * t + 0.127414796f; q = q * t;
    const f32x2 s = (v * v) * (-0.72134752044f);
    f32x2 e; e.x = __builtin_amdgcn_exp2f(s.x); e.y = __builtin_amdgcn_exp2f(s.y);
    const f32x2 m = v * (q * e), r = v - m;
    f32x2 o; o.x = v.x < 0.f ? m.x : r.x; o.y = v.y < 0.f ? m.y : r.y; return o;
}
__device__ __forceinline__ float silu_f(float x) { return x * __builtin_amdgcn_rcpf(1.0f + __builtin_amdgcn_exp2f(-1.4426950408889634f * x)); }
__device__ __forceinline__ u32x4 pack8(const f32x4 v0, const f32x4 v1) { u32x4 w; w.x = cvt_pk_bf16(v0[0], v0[1]); w.y = cvt_pk_bf16(v0[2], v0[3]); w.z = cvt_pk_bf16(v1[0], v1[1]); w.w = cvt_pk_bf16(v1[2], v1[3]); return w; }

struct EpiBf16Plain {
    static constexpr bool PERM = true, AFTER_DRAIN = false;
    bf16_t* O; int ldc;
    __device__ __forceinline__ void operator()(const f32x4 (&acc)[2][2][4][2], const Unit& u, int wr, int wc, int fr, int fq) const {
        const int row0 = u.pm * BM + wr * 64 + fr, col0 = u.pn * BM + wc * 32 + 8 * fq;
#pragma unroll
        for (int ai = 0; ai < 2; ++ai)
#pragma unroll
            for (int m = 0; m < 4; ++m) { bf16_t* rowp = O + (size_t)(row0 + ai * HALF + m * 16) * ldc + col0;
#pragma unroll
                for (int bj = 0; bj < 2; ++bj) *(u32x4*)(rowp + bj * HALF) = pack8(acc[ai][bj][m][0], acc[ai][bj][m][1]); }
    }
};
struct EpiProj {
    static constexpr bool PERM = true, AFTER_DRAIN = false;
    bf16_t* Q; bf16_t* KV; bf16_t* Z; bf16_t* XBC; float* GLDT;
    __device__ __forceinline__ void operator()(const f32x4 (&acc)[2][2][4][2], const Unit& u, int wr, int wc, int fr, int fq) const {
        const int row0 = u.pm * BM + wr * 64 + fr, pn = u.pn, cl = wc * 32 + 8 * fq;
        if (pn == 11) {
            if (wc == 0) {
#pragma unroll
                for (int ai = 0; ai < 2; ++ai)
#pragma unroll
                    for (int m = 0; m < 4; ++m) { float* rowp = GLDT + (size_t)(row0 + ai * HALF + m * 16) * 32 + 8 * fq;
                        *(f32x4*)(rowp) = acc[ai][0][m][0]; *(f32x4*)(rowp + 4) = acc[ai][0][m][1]; }
            }
            return;
        }
        bf16_t* base0; int stride, laneoff, halfstep;
        if (pn < 2) { base0 = Q + pn * 256; stride = 512; laneoff = cl; halfstep = HALF; }
        else if (pn < 5) { const int b = (u.pm * BM) >> 11; base0 = KV + ((size_t)((pn - 2) * 2) << 21) + (size_t)b * 131072; stride = 64; laneoff = (wc >> 1) * 131072 + (wc & 1) * 32 + 8 * fq; halfstep = 1 << 21; }
        else if (pn < 7) { base0 = Z + (pn - 5) * 256; stride = 512; laneoff = cl; halfstep = HALF; }
        else { base0 = XBC + (pn - 7) * 256; stride = 1024; laneoff = cl; halfstep = HALF; }
        const unsigned off0 = (unsigned)(row0 * stride + laneoff);
#pragma unroll
        for (int ai = 0; ai < 2; ++ai)
#pragma unroll
            for (int m = 0; m < 4; ++m) {
                const unsigned off = off0 + (unsigned)((ai * HALF + m * 16) * stride);
                *(u32x4*)(base0 + off) = pack8(acc[ai][0][m][0], acc[ai][0][m][1]);
                *(u32x4*)(base0 + halfstep + off) = pack8(acc[ai][1][m][0], acc[ai][1][m][1]);
                asm volatile("" ::: "memory");
            }
    }
};
struct EpiSwiGLU {
    static constexpr bool PERM = true, AFTER_DRAIN = false;
    bf16_t* T; int ldc;
    __device__ __forceinline__ void operator()(const f32x4 (&acc)[2][2][4][2], const Unit& u, int wr, int wc, int fr, int fq) const {
        const int row0 = u.pm * BM + wr * 64 + fr, col0 = u.pn * HALF + wc * 32 + 8 * fq;
#pragma unroll
        for (int ai = 0; ai < 2; ++ai)
#pragma unroll
            for (int m = 0; m < 4; ++m) {
                f32x4 v0, v1;
#pragma unroll
                for (int j = 0; j < 4; ++j) { v0[j] = silu_f(acc[ai][0][m][0][j]) * acc[ai][1][m][0][j]; v1[j] = silu_f(acc[ai][0][m][1][j]) * acc[ai][1][m][1][j]; }
                *(u32x4*)(T + (size_t)(row0 + ai * HALF + m * 16) * ldc + col0) = pack8(v0, v1);
            }
    }
};
struct EpiGelu {
    static constexpr bool PERM = true, AFTER_DRAIN = false;
    bf16_t* U; bf16_t* V; float* ST;
    __device__ __forceinline__ void operator()(const f32x4 (&acc)[2][2][4][2], const Unit& u, int wr, int wc, int fr, int fq) const {
        const int row0 = u.pm * BM + wr * 64 + fr, pn = u.pn;
        const bool isv = pn >= 8; bf16_t* base = isv ? V : U; const int col0 = (isv ? pn - 8 : pn) * BM + wc * 32 + 8 * fq;
#pragma unroll
        for (int ai = 0; ai < 2; ++ai)
#pragma unroll
            for (int m = 0; m < 4; ++m) {
                const int row = row0 + ai * HALF + m * 16; float s = 0.f, ss = 0.f;
#pragma unroll
                for (int bj = 0; bj < 2; ++bj) {
                    const f32x4 x0 = acc[ai][bj][m][0], x1 = acc[ai][bj][m][1];
                    const f32x2 a = gelu_pk((f32x2){x0[0], x0[1]}), b = gelu_pk((f32x2){x0[2], x0[3]}), c = gelu_pk((f32x2){x1[0], x1[1]}), d = gelu_pk((f32x2){x1[2], x1[3]});
                    s += (a.x + a.y) + (b.x + b.y) + (c.x + c.y) + (d.x + d.y);
                    ss += (a.x * a.x + a.y * a.y) + (b.x * b.x + b.y * b.y) + (c.x * c.x + c.y * c.y) + (d.x * d.x + d.y * d.y);
                    *(u32x4*)(base + (size_t)row * 2048 + col0 + bj * HALF) = pack8((f32x4){a.x, a.y, b.x, b.y}, (f32x4){c.x, c.y, d.x, d.y});
                }
                if (isv) {
                    s += __shfl_xor(s, 16); s += __shfl_xor(s, 32); ss += __shfl_xor(ss, 16); ss += __shfl_xor(ss, 32);
                    if (fq == 0) *(f32x2*)(ST + ((size_t)row * 32 + (pn - 8) * 4 + wc) * 2) = (f32x2){s, ss};
                }
            }
    }
};
struct EpiCmp {
    static constexpr bool PERM = true, AFTER_DRAIN = false;
    bf16_t* H1; const float* bias;
    __device__ __forceinline__ void operator()(const f32x4 (&acc)[2][2][4][2], const Unit& u, int wr, int wc, int fr, int fq) const {
        const int row0 = u.pm * BM + wr * 64 + fr, cl = wc * 32 + 8 * fq; const float* bs = bias + u.pn * 256;
#pragma unroll
        for (int bj = 0; bj < 2; ++bj) {
            const f32x4 b0 = *(const f32x4*)(bs + bj * HALF + cl), b1 = *(const f32x4*)(bs + bj * HALF + cl + 4);
#pragma unroll
            for (int ai = 0; ai < 2; ++ai)
#pragma unroll
                for (int m = 0; m < 4; ++m) {
                    f32x4 v0 = acc[ai][bj][m][0] + b0, v1 = acc[ai][bj][m][1] + b1;
#pragma unroll
                    for (int j = 0; j < 4; ++j) { v0[j] = silu_f(v0[j]); v1[j] = silu_f(v1[j]); }
                    *(u32x4*)(H1 + (size_t)(row0 + ai * HALF + m * 16) * 256 + bj * HALF + cl) = pack8(v0, v1);
                }
        }
    }
};

template <class Epi, class Sched, bool ALIGN_EPI = false, bool SP2 = false>
__device__ __forceinline__ void gemm_phase(PG8_LAS unsigned char* lds, const Gemm g, const Sched& S, const Epi& E, const int tid) {
    const int wid = __builtin_amdgcn_readfirstlane(tid >> 6), lane = tid & 63, wr = wid >> 2, wc = wid & 3, fr = lane & 15, fq = lane >> 4;
    const int K = g.K, nt = K / BK;
    unsigned voffA[2], voffB[2];
#pragma unroll
    for (int i = 0; i < 2; ++i) { int R, C; stage_rc(tid * 16 + i * 8192, R, C); const int Rb = Epi::PERM ? ((R & ~31) + perm32(R & 31)) : R;
        voffA[i] = (unsigned)(R * g.lda + C) * 2u; voffB[i] = (unsigned)(Rb * K + C) * 2u; }
    const size_t kstep = (size_t)(BK * 2);
    const size_t hstepB = (size_t)HALF * K * 2, hstepA = (size_t)HALF * g.lda * 2;
    const size_t tstepA = 2 * hstepA, tstepB = 2 * hstepB;
    const unsigned ldsw = (unsigned)wid * 1024u;
    const int aoff = lds_byte(wr * 64 + fr, fq * 8), boff = lds_byte(wc * 32 + fr, fq * 8);
#define PG8_SA(b, h) (((b) * 2 + (h)) * HTB)
#define PG8_SB(b, h) ((4 + (b) * 2 + (h)) * HTB)
#define PG8_STAGE(bufoff, gbase, voff) do { _Pragma("unroll") for (int _i = 0; _i < 2; ++_i) \
        __builtin_amdgcn_global_load_lds((const unsigned*)((const char*)(gbase) + (voff)[_i]), (PG8_LAS unsigned*)(lds + (bufoff) + ldsw + _i * 8192), 16, 0, 0); } while (0)
#define PG8_LDA(dst, b, h) do { _Pragma("unroll") for (int m = 0; m < 4; ++m) _Pragma("unroll") for (int k = 0; k < 2; ++k) dst[m][k] = *(const PG8_LAS bf16x8*)(lds + PG8_SA(b, h) + aoff + m * 2048 + k * 1024); } while (0)
#define PG8_LDB(dst, b, h) do { _Pragma("unroll") for (int n = 0; n < 2; ++n) _Pragma("unroll") for (int k = 0; k < 2; ++k) dst[n][k] = *(const PG8_LAS bf16x8*)(lds + PG8_SB(b, h) + boff + n * 2048 + k * 1024); } while (0)
#define PG8_MMA(ai, bj, At, Bt) do { __builtin_amdgcn_s_setprio(1); _Pragma("unroll") for (int m = 0; m < 4; ++m) _Pragma("unroll") for (int n = 0; n < 2; ++n) _Pragma("unroll") for (int k = 0; k < 2; ++k) \
        acc[ai][bj][m][n] = __builtin_amdgcn_mfma_f32_16x16x32_bf16(Bt[n][k], At[m][k], acc[ai][bj][m][n], 0, 0, 0); __builtin_amdgcn_s_setprio(0); } while (0)
#define PG8_WAIT_V(n) asm volatile("s_waitcnt vmcnt(" #n ")" ::: "memory")
#define PG8_WAIT_L(n) asm volatile("s_waitcnt lgkmcnt(" #n ")" ::: "memory")
#define PG8_BAR __builtin_amdgcn_s_barrier()
#define PG8_SCHED __builtin_amdgcn_sched_barrier(0)
    Unit cur, nxt; int ui = 0;
    if (!S.next(0, cur)) return;
    f32x4 acc[2][2][4][2];
#pragma unroll
    for (int a = 0; a < 2; ++a)
#pragma unroll
        for (int b = 0; b < 2; ++b)
#pragma unroll
            for (int m = 0; m < 4; ++m)
#pragma unroll
                for (int n = 0; n < 2; ++n) acc[a][b][m][n] = (f32x4){0.f, 0.f, 0.f, 0.f};
    bf16x8 At[4][2], B0[2][2], B1[2][2];
    const char* cA = (const char*)g.A + (size_t)cur.pm * tstepA; const char* cB = (const char*)g.Bt + (size_t)cur.pn * tstepB;
    S.a_ready(cur);
    if constexpr (SP2) {
        PG8_STAGE(PG8_SB(0, 0), cB, voffB); PG8_STAGE(PG8_SB(0, 1), cB + hstepB, voffB); PG8_STAGE(PG8_SA(0, 0), cA, voffA); PG8_STAGE(PG8_SA(0, 1), cA + hstepA, voffA);
        if (wr == 1) PG8_BAR;
        PG8_WAIT_V(2); PG8_BAR;
        PG8_STAGE(PG8_SB(1, 0), cB + kstep, voffB); PG8_STAGE(PG8_SA(1, 0), cA + kstep, voffA); PG8_STAGE(PG8_SB(1, 1), cB + hstepB + kstep, voffB);
        PG8_WAIT_V(6); PG8_BAR;
    } else {
        PG8_STAGE(PG8_SB(0, 0), cB, voffB); PG8_STAGE(PG8_SA(0, 0), cA, voffA); PG8_STAGE(PG8_SB(0, 1), cB + hstepB, voffB); PG8_STAGE(PG8_SA(0, 1), cA + hstepA, voffA);
        if (wr == 1) PG8_BAR;
        PG8_WAIT_V(4); PG8_BAR;
        PG8_STAGE(PG8_SB(1, 0), cB + kstep, voffB); PG8_STAGE(PG8_SA(1, 0), cA + kstep, voffA); PG8_STAGE(PG8_SB(1, 1), cB + hstepB + kstep, voffB);
        PG8_WAIT_V(6); PG8_BAR;
    }
    for (;;) {
        const bool has_next = S.next(ui + 1, nxt);
        const char* nA = has_next ? (const char*)g.A + (size_t)nxt.pm * tstepA : cA; const char* nB = has_next ? (const char*)g.Bt + (size_t)nxt.pn * tstepB : cB;
        for (int t = 0; t < nt; t += 2) {
            const bool last = (t == nt - 2);
            const char* a1 = cA + (size_t)(t + 1) * kstep;
            const char* a2 = last ? nA : cA + (size_t)(t + 2) * kstep; const char* b2 = last ? nB : cB + (size_t)(t + 2) * kstep;
            const char* a3 = a2 + kstep; const char* b3 = b2 + kstep;
            if (last && has_next) S.a_ready(nxt);
            if constexpr (SP2) {
            PG8_LDB(B0, 0, 0); PG8_LDB(B1, 0, 1); PG8_SCHED; PG8_LDA(At, 0, 0); PG8_STAGE(PG8_SA(1, 1), a1 + hstepA, voffA);
            PG8_WAIT_V(8); PG8_WAIT_L(0); PG8_BAR; PG8_MMA(0, 0, At, B0); PG8_MMA(0, 1, At, B1); PG8_BAR; PG8_SCHED;
            PG8_LDA(At, 0, 1); PG8_STAGE(PG8_SB(0, 0), b2, voffB); PG8_STAGE(PG8_SB(0, 1), b2 + hstepB, voffB); PG8_STAGE(PG8_SA(0, 0), a2, voffA);
            PG8_WAIT_V(8); PG8_WAIT_L(0); PG8_BAR; PG8_MMA(1, 0, At, B0); PG8_MMA(1, 1, At, B1); PG8_BAR; PG8_SCHED;
            PG8_LDB(B0, 1, 0); PG8_LDB(B1, 1, 1); PG8_SCHED; PG8_LDA(At, 1, 0); PG8_STAGE(PG8_SA(0, 1), a2 + hstepA, voffA);
            PG8_WAIT_V(8); PG8_WAIT_L(0); PG8_BAR; PG8_MMA(0, 0, At, B0); PG8_MMA(0, 1, At, B1); PG8_BAR; PG8_SCHED;
            PG8_LDA(At, 1, 1); PG8_STAGE(PG8_SB(1, 0), b3, voffB); PG8_STAGE(PG8_SB(1, 1), b3 + hstepB, voffB); PG8_STAGE(PG8_SA(1, 0), a3, voffA);
            PG8_WAIT_V(8); PG8_WAIT_L(0); PG8_BAR; PG8_MMA(1, 0, At, B0); PG8_MMA(1, 1, At, B1); PG8_BAR; PG8_SCHED;
            } else {
            PG8_LDB(B0, 0, 0); PG8_SCHED; PG8_LDA(At, 0, 0); PG8_STAGE(PG8_SA(1, 1), a1 + hstepA, voffA);
            PG8_WAIT_L(8); PG8_BAR; PG8_WAIT_L(0); PG8_MMA(0, 0, At, B0); PG8_BAR; PG8_SCHED;
            PG8_LDB(B1, 0, 1); PG8_STAGE(PG8_SB(0, 0), b2, voffB);
            PG8_BAR; PG8_WAIT_L(0); PG8_MMA(0, 1, At, B1); PG8_BAR;
            PG8_LDA(At, 0, 1); PG8_STAGE(PG8_SA(0, 0), a2, voffA);
            PG8_BAR; PG8_WAIT_L(0); PG8_MMA(1, 0, At, B0); PG8_BAR; PG8_SCHED;
            PG8_STAGE(PG8_SB(0, 1), b2 + hstepB, voffB);
            PG8_WAIT_V(6); PG8_BAR; PG8_MMA(1, 1, At, B1); PG8_BAR;
            PG8_LDB(B0, 1, 0); PG8_SCHED; PG8_LDA(At, 1, 0); PG8_STAGE(PG8_SA(0, 1), a2 + hstepA, voffA);
            PG8_WAIT_L(8); PG8_BAR; PG8_WAIT_L(0); PG8_MMA(0, 0, At, B0); PG8_BAR; PG8_SCHED;
            PG8_LDB(B1, 1, 1); PG8_STAGE(PG8_SB(1, 0), b3, voffB);
            PG8_BAR; PG8_WAIT_L(0); PG8_MMA(0, 1, At, B1); PG8_BAR;
            PG8_LDA(At, 1, 1); PG8_STAGE(PG8_SA(1, 0), a3, voffA);
            PG8_BAR; PG8_WAIT_L(0); PG8_MMA(1, 0, At, B0); PG8_BAR; PG8_SCHED;
            PG8_STAGE(PG8_SB(1, 1), b3 + hstepB, voffB);
            PG8_WAIT_V(6); PG8_BAR; PG8_MMA(1, 1, At, B1); PG8_BAR;
            }
        }
        if constexpr (ALIGN_EPI) { if (wr == 0) PG8_BAR; }
        if constexpr (!Epi::AFTER_DRAIN) { E(acc, cur, wr, wc, fr, fq); S.done(cur); }
        if (!has_next) break;
#pragma unroll
        for (int a = 0; a < 2; ++a)
#pragma unroll
            for (int b = 0; b < 2; ++b)
#pragma unroll
                for (int m = 0; m < 4; ++m)
#pragma unroll
                    for (int n = 0; n < 2; ++n) acc[a][b][m][n] = (f32x4){0.f, 0.f, 0.f, 0.f};
        cur = nxt; cA = nA; cB = nB; ++ui;
        if constexpr (ALIGN_EPI) { if (wr == 1) PG8_BAR; }
    }
    PG8_WAIT_V(0);
    if constexpr (!ALIGN_EPI) { if (wr == 0) PG8_BAR; }
    PG8_BAR;
    if constexpr (Epi::AFTER_DRAIN) { E.fused(acc, cur, wr, wc, fr, fq, lds, wid, lane); S.done(cur); }
#undef PG8_SA
#undef PG8_SB
#undef PG8_STAGE
#undef PG8_LDA
#undef PG8_LDB
#undef PG8_MMA
#undef PG8_WAIT_V
#undef PG8_WAIT_L
#undef PG8_BAR
#undef PG8_SCHED
}
}

constexpr int NWAVES = 8;
constexpr int BATCH = 8, SEQ = 2048, D = 1024, M = BATCH * SEQ, FFH = 2816, DEPTH = 4;
constexpr int EV_IN = 2848, EV_IN_PAD = 3072;
constexpr float RMS_EPS = 1e-6f, LN_EPS = 1e-5f;

constexpr size_t MiB = 1u << 20;
constexpr size_t WS_CTL = 0, CTL_ZERO_BYTES = 64 * 1024;
constexpr size_t WS_SMALL = 1 * MiB;
constexpr size_t WS_WFFN = 2 * MiB, WFFN_STRIDE = 17301504;
constexpr size_t WS_WEV = 68 * MiB, WEV_STRIDE = 10 * MiB;
constexpr size_t WS_WOD = 88 * MiB, WOD_STRIDE = 12 * MiB;
constexpr size_t WS_A = 112 * MiB;
constexpr size_t WS_BIG = 144 * MiB;
constexpr size_t WS_Q = WS_BIG, WS_KV = WS_BIG + 16 * MiB, WS_Z = WS_BIG + 40 * MiB, WS_XBC = WS_BIG + 56 * MiB, WS_GLDT = WS_BIG + 88 * MiB, WS_XBCC = WS_BIG + 90 * MiB,
                 WS_H1 = WS_BIG + 122 * MiB, WS_KCB = WS_BIG + 124 * MiB, WS_YEV = WS_BIG;
constexpr size_t WS_T = WS_BIG, WS_YFF = WS_BIG + 88 * MiB;
constexpr size_t WS_U = WS_BIG, WS_V = WS_BIG + 64 * MiB, WS_ST = WS_BIG + 128 * MiB, WS_YOD = WS_BIG + 64 * MiB;
constexpr size_t WS_END = 276 * MiB;
constexpr int CW_BAR = 4096;

constexpr int SCR_BYTES = 152 * 1024;
constexpr int MISC_OFF = SCR_BYTES;
constexpr int LDS_BYTES = SCR_BYTES + 512;

#define GAS __attribute__((address_space(1)))
#define LAS __attribute__((address_space(3)))
typedef unsigned short bf16;
typedef unsigned v4u __attribute__((ext_vector_type(4)));
typedef unsigned v2u __attribute__((ext_vector_type(2)));
typedef float f32x4 __attribute__((ext_vector_type(4)));
typedef float f32x2 __attribute__((ext_vector_type(2)));
typedef GAS unsigned gu32;
#define RLX_AGENT __ATOMIC_RELAXED, __HIP_MEMORY_SCOPE_AGENT
#define LDS_WAIT() asm volatile("s_waitcnt lgkmcnt(0)" ::: "memory")
#define VM_WAIT() asm volatile("s_waitcnt vmcnt(0)" ::: "memory")
__device__ __forceinline__ unsigned f2bf(float f) { unsigned u = __builtin_bit_cast(unsigned, f); return (u + 0x7fffu + ((u >> 16) & 1u)) >> 16; }
__device__ __forceinline__ unsigned pk2(float lo, float hi) { return f2bf(lo) | (f2bf(hi) << 16); }
__device__ __forceinline__ float bflo(unsigned w) { return __builtin_bit_cast(float, w << 16); }
__device__ __forceinline__ float bfhi(unsigned w) { return __builtin_bit_cast(float, w & 0xffff0000u); }
__device__ __forceinline__ float bf2f(bf16 h) { return __builtin_bit_cast(float, (unsigned)h << 16); }
__device__ __forceinline__ float wave_sum(float v) {
#pragma unroll
    for (int o = 1; o < 64; o <<= 1) v += __shfl_xor(v, o);
    return v;
}
__device__ __forceinline__ float wave_max(float v) {
#pragma unroll
    for (int o = 1; o < 64; o <<= 1) v = fmaxf(v, __shfl_xor(v, o));
    return v;
}
__device__ __forceinline__ float silu_f(float x) { return x / (1.0f + __expf(-x)); }
__device__ __forceinline__ float sigmoid_f(float x) { return 1.0f / (1.0f + __expf(-x)); }

__device__ __forceinline__ int flane() { return (int)__builtin_amdgcn_mbcnt_hi(~0u, __builtin_amdgcn_mbcnt_lo(~0u, 0u)); }
#define XB_TMO      128
#define XB_XCNT(j)  (256  + 64 * (j))
#define XB_XSUB(j)  (1280 + 64 * (j))
#define XB_XGEN(j)  (2304 + 64 * (j))
#define XB_TOP      3328
#define XB_TOPGEN   3392
#define XCD_BAR_WORDS 3456
#define XB_SPIN_CAP (1u << 22)

__device__ __forceinline__ unsigned xb_ld(unsigned* p)              { return __hip_atomic_load(p, __ATOMIC_RELAXED, __HIP_MEMORY_SCOPE_AGENT); }
__device__ __forceinline__ unsigned xb_add(unsigned* p, unsigned v) { return __hip_atomic_fetch_add(p, v, __ATOMIC_RELAXED, __HIP_MEMORY_SCOPE_AGENT); }
__device__ __forceinline__ unsigned xb_xcc_id() { return (unsigned)__builtin_amdgcn_s_getreg((3 << 11) | 20) & 0xFu; }
#define XB_SPIN(cond, bar) do { unsigned _sp = 0; while (cond) { __builtin_amdgcn_s_sleep(1); \
    if ((++_sp & 255u) == 0u) { if (xb_ld(&(bar)[XB_TMO])) break; if (_sp > XB_SPIN_CAP) { atomicAdd(&(bar)[XB_TMO], 1u); break; } } } } while (0)

struct XcdBarrier { unsigned* bar; unsigned x; volatile LAS unsigned* st; };
__device__ __forceinline__ XcdBarrier xcd_barrier_post(unsigned* bar, volatile LAS unsigned* st) {
    XcdBarrier b; b.bar = bar; b.x = xb_xcc_id(); b.st = st;
    if (threadIdx.x == 0) (void)xb_add(&bar[XB_XCNT(b.x)], 1u);
    return b;
}
__device__ __forceinline__ void xcd_barrier_complete(unsigned* bar, unsigned x, unsigned& nloc, unsigned& nx) {
    const unsigned G = gridDim.x * gridDim.y * gridDim.z;
    unsigned sum, cnt, mine, sp = 0u;
    for (;;) {
        sum = 0u; cnt = 0u; mine = 0u;
#pragma unroll
        for (unsigned j = 0; j < 16; ++j) { const unsigned c = xb_ld(&bar[XB_XCNT(j)]); sum += c; cnt += (c > 0u) ? 1u : 0u; mine = (j == x) ? c : mine; }
        if (sum == G) break;
        __builtin_amdgcn_s_sleep(1);
        if ((++sp & 255u) == 0u) { if (xb_ld(&bar[XB_TMO])) break; if (sp > XB_SPIN_CAP) { atomicAdd(&bar[XB_TMO], 1u); break; } }
    }
    nloc = mine > 0u ? mine : 1u; nx = cnt > 0u ? cnt : 1u;
}
__device__ __forceinline__ void xcd_barrier(const XcdBarrier& b, const int wave) {
    asm volatile("s_waitcnt vmcnt(0)" ::: "memory");
    __syncthreads();
    if (wave == 0 && flane() == 0) {
        unsigned* bar = b.bar;
        __builtin_amdgcn_s_waitcnt(0);
        unsigned nloc = b.st[0], nx = b.st[1];
        if (nloc == 0u) { xcd_barrier_complete(bar, b.x, nloc, nx); b.st[0] = nloc; b.st[1] = nx; }
        const unsigned old = xb_add(&bar[XB_XSUB(b.x)], 1u);
        const unsigned gen = old / nloc;
        if (old + 1u == (gen + 1u) * nloc) {
            __builtin_amdgcn_fence(__ATOMIC_RELEASE, "agent");
            asm volatile("s_waitcnt vmcnt(0)" ::: "memory");
            const unsigned og = xb_add(&bar[XB_TOP], 1u);
            const unsigned tg = og / nx;
            if (og + 1u == (tg + 1u) * nx) xb_add(&bar[XB_TOPGEN], 1u);
            else XB_SPIN(xb_ld(&bar[XB_TOPGEN]) == tg, bar);
            __builtin_amdgcn_fence(__ATOMIC_ACQUIRE, "agent");
            xb_add(&bar[XB_XGEN(b.x)], 1u);
            asm volatile("s_waitcnt vmcnt(0)" ::: "memory");
        } else {
            XB_SPIN(xb_ld(&bar[XB_XGEN(b.x)]) == gen, bar);
            __builtin_amdgcn_fence(__ATOMIC_ACQUIRE, "agent");
            asm volatile("s_waitcnt vmcnt(0)" ::: "memory");
        }
    }
    __syncthreads();
}

struct Frame {
    LAS unsigned char* lds;
    unsigned char* ws;
    int tid, lane, wave, G, bid;
    float* out;
};

enum InIdx { I_X = 0, I_GAINS, I_WG, I_WU, I_WD, I_EVIN, I_EVOUT, I_PE, I_CW1, I_CW2, I_CONVW, I_CONVB, I_DTB, I_ALOG, I_DSKIP, I_SNORM, I_ODIN, I_LNW, I_LNB, I_WS, I_BS, I_ODOUT };

__device__ __forceinline__ const float* inp(const Frame& F, int i) {
    volatile LAS unsigned* t = (volatile LAS unsigned*)(F.lds + MISC_OFF) + 32 + 2 * i;
    const unsigned lo = __builtin_amdgcn_readfirstlane(t[0]), hi = __builtin_amdgcn_readfirstlane(t[1]);
    return (const float*)(((unsigned long long)hi << 32) | lo);
}
struct TJob { const float* W; int K, N; bf16* dst; int mode; const float* gain; int gain_lo; int row_off; };
__device__ __forceinline__ int evin_row(int n) {
    if (n < 1280) return n;
    if (n < 1304) return 2816 + (n - 1280);
    if (n < 1816) return 1280 + (n - 1304);
    if (n < 2840) return 1792 + (n - 1816);
    return 2840 + (n - 2840);
}
__device__ __forceinline__ void transpose_item(const TJob& J, int local, LAS float* scr, int lane) {
    const int nblk = J.N / 32, kb = local / nblk, nb = local % nblk, k0 = 64 * kb, n0 = 32 * nb;
#pragma unroll 8
    for (int i = 0; i < 32; ++i) { const int kk = 2 * i + (lane >> 5), k = k0 + kk; float g = 1.0f; if (J.gain != nullptr && k >= J.gain_lo) g = J.gain[k];
        scr[kk * 33 + (lane & 31)] = J.W[(size_t)k * J.N + n0 + (lane & 31)] * g; }
    LDS_WAIT(); asm volatile("" ::: "memory");
    const int c = lane & 7;
#pragma unroll
    for (int j = 0; j < 4; ++j) { const int n = (lane >> 3) + 8 * j, nn = n0 + n; const LAS float* s = scr + (8 * c) * 33 + n;
        int dr; float sc = 1.0f;
        if (J.mode == 0) dr = J.row_off + nn; else if (J.mode == 1) dr = 256 * (nn >> 7) + (nn & 127) + J.row_off; else { dr = evin_row(nn); if (nn < 512) sc = 0.125f; }
        v4u o; o.x = pk2(s[0 * 33] * sc, s[1 * 33] * sc); o.y = pk2(s[2 * 33] * sc, s[3 * 33] * sc); o.z = pk2(s[4 * 33] * sc, s[5 * 33] * sc); o.w = pk2(s[6 * 33] * sc, s[7 * 33] * sc);
        *(v4u*)(J.dst + (size_t)dr * J.K + k0 + 8 * c) = o; }
    LDS_WAIT(); asm volatile("" ::: "memory");
}
constexpr int IT_FFN = 16 * 88, IT_EVIN = 16 * 89, IT_EVOUT = 16 * 32, IT_W1 = 32 * 8, IT_ODIN = 16 * 128, IT_ODOUT = 32 * 32;
constexpr int IT_EV = IT_EVIN + IT_EVOUT + 2 * IT_W1, IT_OD = IT_ODIN + IT_ODOUT;
constexpr int N_TRANS = 12 * IT_FFN + 2 * IT_EV + 2 * IT_OD;
__device__ __forceinline__ void get_job(Frame& F, int it, TJob& J, int& local) {
    if (it < 12 * IT_FFN) { const int L = it / (3 * IT_FFN), r = it % (3 * IT_FFN), w = r / IT_FFN; local = r % IT_FFN;
        bf16* base = (bf16*)(F.ws + WS_WFFN + (size_t)L * WFFN_STRIDE);
        if (w == 0) J = TJob{inp(F, I_WG) + (size_t)L * D * FFH, D, FFH, base, 1, inp(F, I_GAINS) + (L * 4 + 2) * D, 0, 0};
        else if (w == 1) J = TJob{inp(F, I_WU) + (size_t)L * D * FFH, D, FFH, base, 1, inp(F, I_GAINS) + (L * 4 + 2) * D, 0, 128};
        else J = TJob{inp(F, I_WD) + (size_t)L * FFH * D, FFH, D, base + (size_t)5632 * 1024, 0, nullptr, 0, 0};
        return; }
    it -= 12 * IT_FFN;
    if (it < 2 * IT_EV) { const int i = it / IT_EV; int r = it % IT_EV; unsigned char* base = F.ws + WS_WEV + (size_t)i * WEV_STRIDE;
        if (r < IT_EVIN) { local = r; J = TJob{inp(F, I_EVIN) + (size_t)i * D * EV_IN, D, EV_IN, (bf16*)base, 2, inp(F, I_GAINS) + (2 * i * 4 + 0) * D, 0, 0}; return; } r -= IT_EVIN;
        if (r < IT_EVOUT) { local = r; J = TJob{inp(F, I_EVOUT) + (size_t)i * D * D, D, D, (bf16*)(base + 6 * MiB), 0, inp(F, I_SNORM) + i * 512 - 512, 512, 0}; return; } r -= IT_EVOUT;
        const int kv = r / IT_W1; local = r % IT_W1;
        J = TJob{inp(F, I_CW1) + (size_t)(i * 2 + kv) * 2048 * 256, 2048, 256, (bf16*)(base + 8 * MiB), 0, nullptr, 0, kv * 256}; return; }
    it -= 2 * IT_EV;
    { const int i = it / IT_OD; int r = it % IT_OD; unsigned char* base = F.ws + WS_WOD + (size_t)i * WOD_STRIDE;
        if (r < IT_ODIN) { local = r; J = TJob{inp(F, I_ODIN) + (size_t)i * D * 4096, D, 4096, (bf16*)base, 0, inp(F, I_GAINS) + ((2 * i + 1) * 4 + 0) * D, 0, 0}; return; } r -= IT_ODIN;
        local = r; J = TJob{inp(F, I_ODOUT) + (size_t)i * 2048 * D, 2048, D, (bf16*)(base + 8 * MiB), 0, nullptr, 0, 0}; }
}
__device__ __forceinline__ void rms_row_to_bf16(const float* xrow, bf16* orow, int lane) {
    const f32x4* xr = (const f32x4*)xrow + lane;
    f32x4 v[4]; float s = 0.f;
#pragma unroll
    for (int j = 0; j < 4; ++j) { v[j] = xr[64 * j]; s += (v[j].x * v[j].x + v[j].y * v[j].y) + (v[j].z * v[j].z + v[j].w * v[j].w); }
    const float rstd = 1.0f / sqrtf(wave_sum(s) * (1.f / D) + RMS_EPS);
    v2u* o8 = (v2u*)orow + lane;
#pragma unroll
    for (int j = 0; j < 4; ++j) o8[64 * j] = (v2u){pk2(v[j].x * rstd, v[j].y * rstd), pk2(v[j].z * rstd, v[j].w * rstd)};
}
__device__ __forceinline__ void p0_prologue(Frame& F) {
    LAS float* scr = (LAS float*)(F.lds + F.wave * 16384);
    const int gw = F.bid * NWAVES + F.wave, NGW = F.G * NWAVES;
    for (int it = gw; it < N_TRANS; it += NGW) { TJob J; int local; get_job(F, it, J, local); transpose_item(J, local, scr, F.lane); }
    float* bias1 = (float*)(F.ws + WS_SMALL);
    for (int o = gw; o < 1024; o += NGW) { const int ik = o >> 8, j = o & 255; const float* pe = inp(F, I_PE) + (size_t)ik * 2048; const float* w1 = inp(F, I_CW1) + (size_t)ik * 2048 * 256 + j;
        float s = 0.f;
        for (int t = 0; t < 32; ++t) { const int k = t * 64 + F.lane; s += pe[k] * w1[(size_t)k * 256]; }
        s = wave_sum(s); if (F.lane == 0) bias1[o] = s; }
    for (int m = gw; m < M; m += NGW) rms_row_to_bf16(inp(F, I_X) + (size_t)m * D, (bf16*)(F.ws + WS_A) + (size_t)m * D, F.lane);
}

__device__ __forceinline__ void rowpass(Frame& F, const bf16* Y, const float* hin, float* hout, bf16* aout, const float* gain) {
    const int gw = F.bid * NWAVES + F.wave, NGW = F.G * NWAVES, lane = F.lane;
    f32x4 gv[4];
#pragma unroll
    for (int j = 0; j < 4; ++j) gv[j] = ((const f32x4*)gain)[lane + 64 * j];
    for (int m = gw; m < M; m += NGW) {
        const v2u* yr = (const v2u*)(Y + (size_t)m * D) + lane; const f32x4* hr = (const f32x4*)(hin + (size_t)m * D) + lane;
        f32x4 y[4], h[4]; float s = 0.f;
#pragma unroll
        for (int j = 0; j < 4; ++j) { const v2u w = yr[64 * j]; y[j] = (f32x4){bflo(w.x), bfhi(w.x), bflo(w.y), bfhi(w.y)}; h[j] = hr[64 * j];
            s += (y[j].x * y[j].x + y[j].y * y[j].y) + (y[j].z * y[j].z + y[j].w * y[j].w); }
        const float rstd = 1.0f / sqrtf(wave_sum(s) * (1.f / D) + RMS_EPS);
        float s2 = 0.f;
#pragma unroll
        for (int j = 0; j < 4; ++j) { h[j] = h[j] + y[j] * rstd * gv[j]; s2 += (h[j].x * h[j].x + h[j].y * h[j].y) + (h[j].z * h[j].z + h[j].w * h[j].w); }
        f32x4* ho = (f32x4*)(hout + (size_t)m * D) + lane;
#pragma unroll
        for (int j = 0; j < 4; ++j) ho[64 * j] = h[j];
        if (aout != nullptr) {
            const float r2 = 1.0f / sqrtf(wave_sum(s2) * (1.f / D) + RMS_EPS);
            v2u* o8 = (v2u*)(aout + (size_t)m * D) + lane;
#pragma unroll
            for (int j = 0; j < 4; ++j) o8[64 * j] = (v2u){pk2(h[j].x * r2, h[j].y * r2), pk2(h[j].z * r2, h[j].w * r2)};
        }
    }
}

__device__ __forceinline__ void conv_prepass(Frame& F, int ie, int b0) {
    const bf16* X = (const bf16*)(F.ws + WS_XBC); bf16* O = (bf16*)(F.ws + WS_XBCC);
    const float* cw = inp(F, I_CONVW) + (size_t)ie * 4 * 1024; const float* cb = inp(F, I_CONVB) + (size_t)ie * 1024;
    const int nb = F.G - b0; if (F.bid < b0) return;
    for (int idx = (F.bid - b0) * 512 + F.tid; idx < M * 128; idx += nb * 512) {
        const int row = idx >> 7, ch = (idx & 127) * 8, t = row & (SEQ - 1);
        float acc[8];
#pragma unroll
        for (int e = 0; e < 8; ++e) acc[e] = cb[ch + e];
#pragma unroll
        for (int k = 0; k < 4; ++k) { const int tt = t - 3 + k; if (tt >= 0) { const v4u x = *(const v4u*)(X + (size_t)(row - 3 + k) * 1024 + ch); const float* w = cw + k * 1024 + ch;
            acc[0] += w[0] * bflo(x.x); acc[1] += w[1] * bfhi(x.x); acc[2] += w[2] * bflo(x.y); acc[3] += w[3] * bfhi(x.y);
            acc[4] += w[4] * bflo(x.z); acc[5] += w[5] * bfhi(x.z); acc[6] += w[6] * bflo(x.w); acc[7] += w[7] * bfhi(x.w); } }
#pragma unroll
        for (int e = 0; e < 8; ++e) acc[e] = silu_f(acc[e]);
        *(v4u*)(O + (size_t)row * 1024 + ch) = (v4u){pk2(acc[0], acc[1]), pk2(acc[2], acc[3]), pk2(acc[4], acc[5]), pk2(acc[6], acc[7])};
    }
}
__device__ __forceinline__ void compress2(Frame& F, int ie, int b0) {
    const bf16* H1 = (const bf16*)(F.ws + WS_H1); float* KCB = (float*)(F.ws + WS_KCB);
    const int nb = F.G - b0; if (F.bid < b0) return;
    for (int idx = (F.bid - b0) * 512 + F.tid; idx < 4096 * 64; idx += nb * 512) {
        const int r = idx >> 6, d = idx & 63, kv = r >> 11; const float* w2 = inp(F, I_CW2) + (size_t)(ie * 2 + kv) * 256 * 64 + d; const bf16* h = H1 + (size_t)r * 256;
        float s = 0.f;
        for (int j = 0; j < 256; j += 2) { const unsigned w = *(const unsigned*)(h + j); s += bflo(w) * w2[(size_t)j * 64]; s += bfhi(w) * w2[(size_t)(j + 1) * 64]; }
        KCB[idx] = s;
    }
}
__device__ __forceinline__ void ssm_scan_naive(Frame& F, int ie) {
    const int bh = F.bid * NWAVES + F.wave; if (bh >= 64) return;
    const int b = bh >> 3, h = bh & 7, g = h >> 2, lane = F.lane;
    const bf16* XC = (const bf16*)(F.ws + WS_XBCC); const float* GLDT = (const float*)(F.ws + WS_GLDT); float* Y = (float*)(F.ws + WS_XBC);
    const float A = -__expf(inp(F, I_ALOG)[ie * 8 + h]), dtb = inp(F, I_DTB)[ie * 8 + h], Dk = inp(F, I_DSKIP)[ie * 8 + h];
    float S[128];
#pragma unroll
    for (int n = 0; n < 128; ++n) S[n] = 0.f;
    size_t row = (size_t)b * SEQ;
    float nx = bf2f(XC[row * 1024 + h * 64 + lane]); unsigned nB = *(const unsigned*)(XC + row * 1024 + 512 + g * 128 + 2 * lane), nC = *(const unsigned*)(XC + row * 1024 + 768 + g * 128 + 2 * lane); float ndt = GLDT[row * 32 + 24 + h];
    for (int t = 0; t < SEQ; ++t, ++row) {
        const float x = nx, dtr = ndt + dtb; const unsigned Bp = nB, Cp = nC;
        if (t + 1 < SEQ) { const size_t r1 = row + 1; nx = bf2f(XC[r1 * 1024 + h * 64 + lane]); nB = *(const unsigned*)(XC + r1 * 1024 + 512 + g * 128 + 2 * lane); nC = *(const unsigned*)(XC + r1 * 1024 + 768 + g * 128 + 2 * lane); ndt = GLDT[r1 * 32 + 24 + h]; }
        const float dtv = fmaxf(dtr, 0.f) + log1pf(__expf(-fabsf(dtr)));
        const float dA = __expf(dtv * A), xdt = x * dtv;
        float y = 0.f;
#pragma unroll
        for (int k = 0; k < 64; ++k) {
            const unsigned bw = __builtin_amdgcn_readlane(Bp, k), cw = __builtin_amdgcn_readlane(Cp, k);
            S[2 * k] = dA * S[2 * k] + xdt * bflo(bw); y += bflo(cw) * S[2 * k];
            S[2 * k + 1] = dA * S[2 * k + 1] + xdt * bfhi(bw); y += bfhi(cw) * S[2 * k + 1];
        }
        Y[row * 512 + h * 64 + lane] = y + x * Dk;
    }
}
__device__ __forceinline__ void ssm_gate_rows(Frame& F) {
    const int gw = F.bid * NWAVES + F.wave, NGW = F.G * NWAVES, lane = F.lane;
    const float* Y = (const float*)(F.ws + WS_XBC); const bf16* Z = (const bf16*)(F.ws + WS_Z); bf16* O = (bf16*)(F.ws + WS_A);
    for (int it = gw; it < 2 * M; it += NGW) { const int row = it >> 1, grp = it & 1;
        const f32x4 y = *((const f32x4*)(Y + (size_t)row * 512 + grp * 256) + lane); const v2u zz = *((const v2u*)(Z + (size_t)row * 512 + grp * 256) + lane);
        f32x4 v; v.x = y.x * silu_f(bflo(zz.x)); v.y = y.y * silu_f(bfhi(zz.x)); v.z = y.z * silu_f(bflo(zz.y)); v.w = y.w * silu_f(bfhi(zz.y));
        const float ss = wave_sum((v.x * v.x + v.y * v.y) + (v.z * v.z + v.w * v.w)), r = 1.0f / sqrtf(ss * (1.f / 256.f) + RMS_EPS);
        *((v2u*)(O + (size_t)row * 1024 + 512 + grp * 256) + lane) = (v2u){pk2(v.x * r, v.y * r), pk2(v.z * r, v.w * r)}; }
}

constexpr int AT_QS = 0, AT_KT = 32768, AT_VT = AT_KT + 64 * 65 * 4, AT_VT1 = AT_VT + 16384, AT_PW = AT_VT1 + 16384, AT_OR = AT_PW + 2048, AT_FIN = AT_OR + 32768, AT_ML = AT_FIN + 32768, AT_GT = AT_ML + 1024, AT_SELM = AT_GT + 1536;
static_assert(AT_SELM + 128 <= SCR_BYTES, "attention LDS map");
constexpr float NEGF = -1e30f;
__device__ __forceinline__ void at_load_tile_f32(LAS float* dst, int stride, const float* src, int tid) {
    const int key = tid >> 3, part = (tid & 7) * 8; const f32x4 a = *(const f32x4*)(src + key * 64 + part), b = *(const f32x4*)(src + key * 64 + part + 4);
    LAS float* p = dst + key * stride + part; p[0] = a.x; p[1] = a.y; p[2] = a.z; p[3] = a.w; p[4] = b.x; p[5] = b.y; p[6] = b.z; p[7] = b.w;
}
__device__ __forceinline__ void at_load_tile_bf16(LAS float* dst, int stride, const bf16* src, int tid) {
    const int key = tid >> 3, part = (tid & 7) * 8; const v4u a = *(const v4u*)(src + key * 64 + part);
    LAS float* p = dst + key * stride + part; p[0] = bflo(a.x); p[1] = bfhi(a.x); p[2] = bflo(a.y); p[3] = bfhi(a.y); p[4] = bflo(a.z); p[5] = bfhi(a.z); p[6] = bflo(a.w); p[7] = bfhi(a.w);
}
__device__ __forceinline__ float at_dot(const LAS float* q, const LAS float* krow) {
    float s = 0.f;
#pragma unroll 1
    for (int d4 = 0; d4 < 16; ++d4) { const f32x4 qv = *(const LAS f32x4*)(q + 4 * d4); s += qv.x * krow[4 * d4] + qv.y * krow[4 * d4 + 1] + qv.z * krow[4 * d4 + 2] + qv.w * krow[4 * d4 + 3]; }
    return s;
}
__device__ __forceinline__ float at_pv(LAS float* pw, int lane, float p, const LAS float* vt) {
    asm volatile("" ::: "memory"); *(volatile LAS float*)(pw + lane) = p; asm volatile("s_waitcnt lgkmcnt(0)" ::: "memory");
    float o = 0.f; const LAS float* vb = vt + lane;
#pragma unroll 1
    for (int k4 = 0; k4 < 16; ++k4) { const f32x4 pv = *(const volatile LAS f32x4*)(pw + 4 * k4);
        o += pv.x * vb[(4 * k4) * 64] + pv.y * vb[(4 * k4 + 1) * 64] + pv.z * vb[(4 * k4 + 2) * 64] + pv.w * vb[(4 * k4 + 3) * 64]; }
    asm volatile("s_waitcnt lgkmcnt(0)" ::: "memory");
    return o;
}
__device__ __forceinline__ void attn_item(Frame& F, int item) {
    const int tid = F.tid, lane = F.lane, w = F.wave;
    const int qblk = 63 - (item >> 4), bg = item & 15, b = bg >> 1, g = bg & 1, t0 = qblk * 32, cur = t0 >> 6;
    LAS float* QS = (LAS float*)(F.lds + AT_QS); LAS float* KT = (LAS float*)(F.lds + AT_KT); LAS float* VT = (LAS float*)(F.lds + AT_VT); LAS float* VT1 = (LAS float*)(F.lds + AT_VT1);
    LAS float* PW = (LAS float*)(F.lds + AT_PW) + w * 64; volatile LAS float* OR = (volatile LAS float*)(F.lds + AT_OR) + w * 1024; volatile LAS float* FIN = (volatile LAS float*)(F.lds + AT_FIN) + w * 1024;
    volatile LAS float* ML = (volatile LAS float*)(F.lds + AT_ML) + w * 32; LAS float* GT = (LAS float*)(F.lds + AT_GT); volatile LAS unsigned* SELM = (volatile LAS unsigned*)(F.lds + AT_SELM) + w * 4;
    const bf16* Qg = (const bf16*)(F.ws + WS_Q); const bf16* KVg = (const bf16*)(F.ws + WS_KV); const float* KCB = (const float*)(F.ws + WS_KCB); const float* GLDT = (const float*)(F.ws + WS_GLDT);
    __syncthreads();
    { const int row = tid >> 2, part = tid & 3, qi = row >> 2, r = row & 3; const bf16* src = Qg + (size_t)(b * SEQ + t0 + qi) * 512 + (g * 4 + r) * 64 + part * 16;
      const v4u a = *(const v4u*)src, c = *(const v4u*)(src + 8); LAS float* p = QS + row * 64 + part * 16;
      p[0] = bflo(a.x); p[1] = bfhi(a.x); p[2] = bflo(a.y); p[3] = bfhi(a.y); p[4] = bflo(a.z); p[5] = bfhi(a.z); p[6] = bflo(a.w); p[7] = bfhi(a.w);
      p[8] = bflo(c.x); p[9] = bfhi(c.x); p[10] = bflo(c.y); p[11] = bfhi(c.y); p[12] = bflo(c.z); p[13] = bfhi(c.z); p[14] = bflo(c.w); p[15] = bfhi(c.w);
      if (tid < 128) { const int qi2 = tid >> 2, r2 = tid & 3; const float* gl = GLDT + (size_t)(b * SEQ + t0 + qi2) * 32 + (g * 4 + r2) * 3;
          GT[tid * 3 + 0] = sigmoid_f(gl[0]); GT[tid * 3 + 1] = sigmoid_f(gl[1]); GT[tid * 3 + 2] = sigmoid_f(gl[2]); } }
    const LAS float* krow = KT + lane * 65;
    {
        at_load_tile_f32(KT, 65, KCB + (size_t)(bg * 128) * 64, tid); at_load_tile_f32(VT, 64, KCB + (size_t)(2048 + bg * 128) * 64, tid); at_load_tile_f32(VT1, 64, KCB + (size_t)(2048 + bg * 128 + 64) * 64, tid);
        __syncthreads();
#pragma unroll 1
        for (int i = 0; i < 16; ++i) {
            const int t = t0 + 4 * w + (i >> 2); const float slope = exp2f(-(float)(4 * g + (i & 3) + 1)); const int dc0 = t - (16 * lane + 31);
            const float d0 = at_dot(QS + (16 * w + i) * 64, krow); FIN[i * 64 + lane] = dc0 >= 0 ? d0 - slope * (float)dc0 : NEGF; }
        __syncthreads();
        at_load_tile_f32(KT, 65, KCB + (size_t)(bg * 128 + 64) * 64, tid);
        __syncthreads();
        float ps0 = 0.f, ps1 = 0.f;
#pragma unroll 1
        for (int i = 0; i < 16; ++i) {
            const int ql = i >> 2, r = i & 3, t = t0 + 4 * w + ql; const float slope = exp2f(-(float)(4 * g + r + 1));
            const LAS float* q = QS + (16 * w + i) * 64;
            const int dc0 = t - (16 * lane + 31), c1 = 64 + lane, dc1 = t - (16 * c1 + 31);
            const bool v0 = dc0 >= 0, v1 = dc1 >= 0 && c1 <= 126;
            const float d1 = at_dot(q, krow);
            const float s0 = FIN[i * 64 + lane], s1 = v1 ? d1 - slope * (float)dc1 : NEGF;
            const float m = wave_max(fmaxf(s0, s1));
            const float e0 = v0 ? __expf(s0 - m) : 0.f, e1 = v1 ? __expf(s1 - m) : 0.f;
            const float l = wave_sum(e0 + e1), inv = l > 0.f ? 1.0f / l : 0.f, p0 = e0 * inv, p1 = e1 * inv;
            float o = at_pv(PW, lane, p0, VT); o += at_pv(PW, lane, p1, VT1);
            FIN[i * 64 + lane] = GT[(16 * w + i) * 3 + 0] * o;
            if (r == 0) { ps0 = 0.f; ps1 = 0.f; }
            ps0 += p0; ps1 += p1;
            if (r == 3) {
                volatile LAS float* ps = OR;
                ps[lane] = ps0; ps[64 + lane] = ps1; LDS_WAIT();
                const int j = lane & 31;
                float imp = ps[4 * j] + ps[4 * j + 1] + ps[4 * j + 2] + 0.5f * ps[4 * j + 3] + (j > 0 ? 0.5f * ps[4 * j - 1] : 0.f);
                const bool forced = (j == 0) || (j == cur) || (j == cur - 1); if (forced) imp += 1e4f;
                const float v = (j <= cur) ? imp : -1.0f;
                int rank = 0;
#pragma unroll 1
                for (int o2 = 0; o2 < 32; ++o2) { const float vo = __shfl(v, o2); rank += (vo > v || (vo == v && o2 < j)) ? 1 : 0; }
                const unsigned long long bal = __ballot(rank < 16 && lane < 32);
                if (lane == 0) SELM[ql] = (unsigned)bal;
                LDS_WAIT();
            }
        }
        __syncthreads();
    }
#pragma unroll 1
    for (int mode = 0; mode < 2; ++mode) {
        const bf16* Kg = KVg + ((size_t)(2 + 2 * mode) << 21) + (size_t)bg * SEQ * 64; const bf16* Vg = KVg + ((size_t)(3 + 2 * mode) << 21) + (size_t)bg * SEQ * 64;
        const int jlo = mode == 0 ? 0 : ((t0 - 511) > 0 ? (t0 - 511) >> 6 : 0);
#pragma unroll 1
        for (int i = 0; i < 16; ++i) { OR[i * 64 + lane] = 0.f; if (lane < 2) ML[i * 2 + lane] = lane == 0 ? NEGF : 0.f; }
        LDS_WAIT();
        const unsigned anymask = mode == 0 ? (SELM[0] | SELM[1] | SELM[2] | SELM[3]) : 0xffffffffu;
#pragma unroll 1
        for (int j = jlo; j <= cur; ++j) {
            at_load_tile_bf16(KT, 65, Kg + (size_t)j * 64 * 64, tid); at_load_tile_bf16(VT, 64, Vg + (size_t)j * 64 * 64, tid);
            __syncthreads();
            if ((anymask >> j) & 1u) {
#pragma unroll 1
                for (int i = 0; i < 16; ++i) { const int ql = i >> 2, t = t0 + 4 * w + ql; const float slope = exp2f(-(float)(4 * g + (i & 3) + 1)); const int dist = t - (64 * j + lane);
                    const bool valid = mode == 0 ? (((SELM[ql] >> j) & 1u) != 0u && dist >= 0) : (dist >= 0 && dist < 512);
                    float s = at_dot(QS + (16 * w + i) * 64, krow); s = valid ? s - slope * (float)dist : NEGF;
                    const float tm = wave_max(s);
                    if (tm > 0.5f * NEGF) { const float mo = ML[i * 2], lo = ML[i * 2 + 1], mn = fmaxf(mo, tm), p = valid ? __expf(s - mn) : 0.f, sc = __expf(mo - mn);
                        const float ln = lo * sc + wave_sum(p); const float on = OR[i * 64 + lane] * sc + at_pv(PW, lane, p, VT);
                        OR[i * 64 + lane] = on; if (lane == 0) { ML[i * 2] = mn; ML[i * 2 + 1] = ln; } LDS_WAIT(); } }
            }
            __syncthreads();
        }
#pragma unroll 1
        for (int i = 0; i < 16; ++i) { const float l = ML[i * 2 + 1]; FIN[i * 64 + lane] += GT[(16 * w + i) * 3 + 1 + mode] * (l > 0.f ? OR[i * 64 + lane] / l : 0.f); }
        LDS_WAIT();
    }
    bf16* O = (bf16*)(F.ws + WS_A);
#pragma unroll 1
    for (int i = 0; i < 16; ++i) { const int t = t0 + 4 * w + (i >> 2), r = i & 3; O[(size_t)(b * SEQ + t) * 1024 + (g * 4 + r) * 64 + lane] = (bf16)f2bf(FIN[i * 64 + lane]); }
}


__device__ __attribute__((noinline)) void attn_phase_simple(unsigned char* ws, int wave, int bid, int G) {
    Frame F; F.lds = (LAS unsigned char*)(uintptr_t)0u; F.ws = ws; F.out = nullptr; F.wave = wave; F.lane = flane(); F.tid = (wave << 6) | F.lane; F.G = G; F.bid = bid;
    for (int it = bid; it < 1024; it += G) attn_item(F, it);
}

constexpr int GM_V = 0, GM_W = 65536, GM_ST = 131072;
__device__ __forceinline__ void gmlp_item(Frame& F, int io, int item) {
    const int tid = F.tid; const int g = item & 7, bc = item >> 3; const size_t row0 = (size_t)bc * 128;
    LAS bf16* Vs = (LAS bf16*)(F.lds + GM_V); LAS float* Wt = (LAS float*)(F.lds + GM_W); LAS float* ST = (LAS float*)(F.lds + GM_ST);
    bf16* U = (bf16*)(F.ws + WS_U); const bf16* V = (const bf16*)(F.ws + WS_V); const float* STg = (const float*)(F.ws + WS_ST);
    const float* lnw = inp(F, I_LNW) + (size_t)io * 2048 + g * 256; const float* lnb = inp(F, I_LNB) + (size_t)io * 2048 + g * 256;
    const float* wsg = inp(F, I_WS) + ((size_t)io * 8 + g) * 128 * 128; const float* bsg = inp(F, I_BS) + ((size_t)io * 8 + g) * 128;
    __syncthreads();
    if (tid < 128) { const float* p = STg + (row0 + tid) * 64; float s = 0.f, ss = 0.f;
        for (int k = 0; k < 32; ++k) { s += p[2 * k]; ss += p[2 * k + 1]; }
        const float mean = s * (1.f / 2048.f), var = ss * (1.f / 2048.f) - mean * mean; ST[2 * tid] = mean; ST[2 * tid + 1] = 1.0f / sqrtf(fmaxf(var, 0.f) + LN_EPS); }
    for (int idx = tid; idx < 128 * 128; idx += 512) { const int t = idx >> 7, s = idx & 127; Wt[s * 128 + t] = (s <= t) ? wsg[idx] : 0.f; }
    __syncthreads();
    for (int idx = tid; idx < 128 * 32; idx += 512) { const int s = idx >> 5, c8 = (idx & 31) * 8; const v4u x = *(const v4u*)(V + (row0 + s) * 2048 + g * 256 + c8);
        const float mean = ST[2 * s], rstd = ST[2 * s + 1]; const float* lw = lnw + c8; const float* lb = lnb + c8;
        float f[8] = {bflo(x.x), bfhi(x.x), bflo(x.y), bfhi(x.y), bflo(x.z), bfhi(x.z), bflo(x.w), bfhi(x.w)};
#pragma unroll
        for (int e = 0; e < 8; ++e) f[e] = (f[e] - mean) * rstd * lw[e] + lb[e];
        *(LAS v4u*)(Vs + s * 256 + c8) = (v4u){pk2(f[0], f[1]), pk2(f[2], f[3]), pk2(f[4], f[5]), pk2(f[6], f[7])}; }
    __syncthreads();
    const int d = tid & 255, th = tid >> 8;
    for (int t4 = th * 64; t4 < th * 64 + 64; t4 += 4) {
        float a0 = 0.f, a1 = 0.f, a2 = 0.f, a3 = 0.f;
        for (int s = 0; s <= t4 + 3; ++s) { const float v = bf2f(Vs[s * 256 + d]); const f32x4 wv = *(const LAS f32x4*)(Wt + s * 128 + t4); a0 += wv.x * v; a1 += wv.y * v; a2 += wv.z * v; a3 += wv.w * v; }
        const float acc[4] = {a0, a1, a2, a3};
#pragma unroll
        for (int e = 0; e < 4; ++e) { const size_t o = (row0 + t4 + e) * 2048 + g * 256 + d; U[o] = (bf16)f2bf(bf2f(U[o]) * (acc[e] + bsg[t4 + e])); }
    }
}

enum Kind { K_PREP = 0, K_G1, K_E3, K_E4, K_E5, K_GY, K_RP, K_G3, K_G5, K_O2 };
constexpr int N_PHASES = 33;
struct Args { const float* in[22]; float* out; unsigned char* ws; int ph_lo, ph_hi; };

__global__ void __launch_bounds__(NWAVES * 64, 2) mk_fwd(Args args) {
    extern __shared__ __attribute__((aligned(16))) unsigned char lds_raw[];
    Frame F;
    F.lds = (LAS unsigned char*)(uintptr_t)0u  ; F.ws = args.ws; F.out = args.out;
    F.wave = __builtin_amdgcn_readfirstlane(threadIdx.x >> 6); F.G = gridDim.x; F.bid = blockIdx.x;
    volatile LAS unsigned* MISC = (volatile LAS unsigned*)((LAS unsigned char*)lds_raw + MISC_OFF);
    { const int t0 = threadIdx.x; if (t0 < 32) MISC[t0] = 0u;
      if (t0 >= 64 && t0 < 64 + 22) { const unsigned long long pv = (unsigned long long)args.in[t0 - 64]; MISC[32 + 2 * (t0 - 64)] = (unsigned)pv; MISC[33 + 2 * (t0 - 64)] = (unsigned)(pv >> 32); } }
    __syncthreads();
    const int wave0 = __builtin_amdgcn_readfirstlane(threadIdx.x >> 6);
    XcdBarrier bar = xcd_barrier_post((unsigned*)(F.ws + WS_CTL) + CW_BAR, MISC + 8);

    for (int p = args.ph_lo; p < args.ph_hi; ++p) {
        int L = 0, k = 0, kind = K_PREP, var = 0;
        if (p > 0) { const int q = p - 1; if (q < 9) { L = 0; k = q; } else if (q < 16) { L = 1; k = q - 9; } else if (q < 25) { L = 2; k = q - 16; } else { L = 3; k = q - 25; }
            if ((L & 1) == 0) { kind = (int)((0x657654321ull >> (4 * k)) & 15ull); var = (int)((0x110000000ull >> (4 * k)) & 15ull); }
            else { kind = (int)((0x6576598ull >> (4 * k)) & 15ull); var = (int)((0x1102200ull >> (4 * k)) & 15ull); } }
        { unsigned long long wsv = (unsigned long long)args.ws, outv = (unsigned long long)args.out; int wv = wave0, bidv = blockIdx.x, gv = gridDim.x;
          asm volatile("" : "+s"(wsv), "+s"(outv), "+s"(bidv), "+s"(gv), "+s"(wv));
          int tidv = (wv << 6) | flane(); asm volatile("" : "+v"(tidv));
          F.ws = (unsigned char*)wsv; F.out = (float*)outv; F.tid = tidv; F.lane = tidv & 63; F.wave = wv; F.G = gv; F.bid = bidv; }
        const int ie = L >> 1;
        unsigned char* wev = F.ws + WS_WEV + (size_t)ie * WEV_STRIDE; unsigned char* wod = F.ws + WS_WOD + (size_t)ie * WOD_STRIDE; unsigned char* wff = F.ws + WS_WFFN + (size_t)L * WFFN_STRIDE;
        switch (kind) {
        case K_PREP:
#ifndef NO_P0
            p0_prologue(F);
#endif
            break;
        case K_G1: {
#ifndef NO_K_G1
            pg8::Gemm g{(const bf16*)(F.ws + WS_A), (const bf16*)wev, M, EV_IN_PAD, D, D}; pg8::StaticOrder S; S.init(M, EV_IN_PAD, F.G, F.bid);
            pg8::EpiProj E{(bf16*)(F.ws + WS_Q), (bf16*)(F.ws + WS_KV), (bf16*)(F.ws + WS_Z), (bf16*)(F.ws + WS_XBC), (float*)(F.ws + WS_GLDT)};
            pg8::gemm_phase<pg8::EpiProj, pg8::StaticOrder, true, true>(F.lds, g, S, E, F.tid);
#endif
            } break;
        case K_E3: {
#ifndef NO_K_E3
            pg8::Gemm g{(const bf16*)(F.ws + WS_KV), (const bf16*)(wev + 8 * MiB), 4096, 512, 2048, 1024}; pg8::CmpOrder S{F.bid};
            pg8::EpiCmp E{(bf16*)(F.ws + WS_H1), (const float*)(F.ws + WS_SMALL) + ie * 512};
            pg8::gemm_phase<pg8::EpiCmp, pg8::CmpOrder, true, true>(F.lds, g, S, E, F.tid);
            conv_prepass(F, ie, 16);
#endif
            } break;
        case K_E4:
#ifndef NO_E4
            ssm_scan_naive(F, ie); compress2(F, ie, 8);
#endif
            break;
        case K_E5: {
#ifndef NO_E5
            for (int it = F.bid; it < 1024; it += F.G) attn_item(F, it);
#endif
            ssm_gate_rows(F); } break;
        case K_GY: {
#ifndef NO_K_GY
            const bf16* A = var == 0 ? (const bf16*)(F.ws + WS_A) : var == 1 ? (const bf16*)(F.ws + WS_T) : (const bf16*)(F.ws + WS_U);
            const bf16* W = var == 0 ? (const bf16*)(wev + 6 * MiB) : var == 1 ? (const bf16*)(wff + (size_t)5632 * 1024 * 2) : (const bf16*)(wod + 8 * MiB);
            const int K = var == 0 ? 1024 : var == 1 ? FFH : 2048; bf16* Y = (bf16*)(F.ws + (var == 0 ? WS_YEV : var == 1 ? WS_YFF : WS_YOD));
            pg8::Gemm g{A, W, M, D, K, K}; pg8::StaticOrder S; S.init(M, D, F.G, F.bid); pg8::EpiBf16Plain E{Y, D};
            pg8::gemm_phase<pg8::EpiBf16Plain, pg8::StaticOrder, true, true>(F.lds, g, S, E, F.tid);
#endif
            } break;
        case K_RP: {
            const bf16* Y = (const bf16*)(F.ws + (var == 0 ? WS_YEV : var == 1 ? WS_YFF : WS_YOD)); const bool mixer = (var != 1);
            const float* hin = (L == 0 && mixer) ? inp(F, I_X) : F.out; bf16* aout = (L == DEPTH - 1 && !mixer) ? nullptr : (bf16*)(F.ws + WS_A);
            rowpass(F, Y, hin, F.out, aout, inp(F, I_GAINS) + (L * 4 + (mixer ? 1 : 3)) * D); } break;
        case K_G3: {
#ifndef NO_K_G3
            pg8::Gemm g{(const bf16*)(F.ws + WS_A), (const bf16*)wff, M, 2 * FFH, D, D}; pg8::StaticOrder S; S.init(M, 2 * FFH, F.G, F.bid);
            pg8::EpiSwiGLU E{(bf16*)(F.ws + WS_T), FFH};
            pg8::gemm_phase<pg8::EpiSwiGLU, pg8::StaticOrder, true, true>(F.lds, g, S, E, F.tid);
#endif
            } break;
        case K_G5: {
#ifndef NO_K_G5
            pg8::Gemm g{(const bf16*)(F.ws + WS_A), (const bf16*)wod, M, 4096, D, D}; pg8::StaticOrder S; S.init(M, 4096, F.G, F.bid);
            pg8::EpiGelu E{(bf16*)(F.ws + WS_U), (bf16*)(F.ws + WS_V), (float*)(F.ws + WS_ST)};
            pg8::gemm_phase<pg8::EpiGelu, pg8::StaticOrder, true, true>(F.lds, g, S, E, F.tid);
#endif
            } break;
        case K_O2: {
#ifndef NO_O2
            for (int it = F.bid; it < 1024; it += F.G) gmlp_item(F, ie, it);
#endif
            } break;
        default: break;
        }
        if (p + 1 < args.ph_hi) xcd_barrier(bar, F.wave);
    }
}

#ifndef MK_PER_PHASE
#define MK_PER_PHASE 0
#endif
extern "C" void kernel_launch(void* const* d_in, const int* in_sizes, int n_in, void* d_out, int out_size, void* d_ws, size_t ws_size, hipStream_t stream) {
    static int grid = 0;
    if (grid == 0) {
        if (n_in != 22 || in_sizes[0] != M * D || out_size != M * D || ws_size < WS_END) { fprintf(stderr, "kernel_launch: unexpected shapes (n_in %d, in0 %d, out %d, ws %zu)\n", n_in, n_in > 0 ? in_sizes[0] : -1, out_size, ws_size); grid = -1; return; }
        int dev = 0, cus = 0, per_cu = 0;
        if (hipGetDevice(&dev) != hipSuccess || hipDeviceGetAttribute(&cus, hipDeviceAttributeMultiprocessorCount, dev) != hipSuccess) { grid = -1; return; }
        if (hipFuncSetAttribute((const void*)mk_fwd, hipFuncAttributeMaxDynamicSharedMemorySize, LDS_BYTES) != hipSuccess) { fprintf(stderr, "kernel_launch: hipFuncSetAttribute failed\n"); grid = -1; return; }
        if (hipOccupancyMaxActiveBlocksPerMultiprocessor(&per_cu, (const void*)mk_fwd, NWAVES * 64, LDS_BYTES) != hipSuccess || per_cu < 1) { fprintf(stderr, "kernel_launch: occupancy query says %d\n", per_cu); per_cu = 1; }
        (void)hipGetLastError();
        grid = cus;
        if (grid != 256) fprintf(stderr, "kernel_launch: %d CUs (built for 256)\n", grid);
    }
    if (grid < 0) return;
    Args a{};
    for (int i = 0; i < 22; ++i) a.in[i] = (const float*)d_in[i];
    a.out = (float*)d_out; a.ws = (unsigned char*)d_ws;
#if MK_PER_PHASE
    for (int p = 0; p < N_PHASES; ++p) { a.ph_lo = p; a.ph_hi = p + 1; hipLaunchKernelGGL(mk_fwd, dim3(grid), dim3(NWAVES * 64), LDS_BYTES, stream, a); }
#else
    (void)hipMemsetAsync((char*)d_ws + WS_CTL, 0, CTL_ZERO_BYTES, stream);
    a.ph_lo = 0; a.ph_hi = N_PHASES;
    hipLaunchKernelGGL(mk_fwd, dim3(grid), dim3(NWAVES * 64), LDS_BYTES, stream, a);
#endif
}
```

```cpp
#include <hip/hip_runtime.h>
#include <cstdio>
#include <cstdint>

namespace pg8 {
#define PG8_LAS __attribute__((address_space(3)))
typedef unsigned short bf16_t;
typedef short bf16x8 __attribute__((ext_vector_type(8)));
typedef float f32x4 __attribute__((ext_vector_type(4)));
typedef unsigned u32x4 __attribute__((ext_vector_type(4)));
typedef float f32x2 __attribute__((ext_vector_type(2)));
constexpr int BM = 256, BK = 64, HALF = 128, HTB = HALF * BK * 2  , STAGE_BYTES = 8 * HTB, NXCD = 8, WGM = 8;

__host__ __device__ __forceinline__ int lds_byte(int r, int c) { const int st = (r >> 4) * 2 + (c >> 5), rr = r & 15, cc = c & 31, ob = rr * 64 + cc * 2; return st * 1024 + (ob ^ (((ob >> 9) & 1) << 5)); }
__host__ __device__ __forceinline__ void stage_rc(int b, int& R, int& C) { const int st = b / 1024, sb = b % 1024, swz = sb ^ (((sb >> 9) & 1) << 5); R = (st >> 1) * 16 + swz / 64; C = (st & 1) * 32 + (swz % 64) / 2; }
__host__ __device__ __forceinline__ int perm32(int rho) { const int n = rho >> 4, i = rho & 15; return 8 * (i >> 2) + 4 * n + (i & 3); }

struct Unit { int pm, pn; };
struct Gemm { const bf16_t* A; const bf16_t* Bt; int M, N, K, lda; };

struct StaticOrder {
    int nM, nN, nwg, G, c;
    __host__ __device__ void init(int M, int N, int G_, int c_) { nM = M / BM; nN = N / BM; nwg = nM * nN; G = G_; c = c_; }
    __host__ __device__ bool next(int i, Unit& u) const {
        const long L = (long)i * G + c; if (L >= nwg) return false;
        int wgid = (int)L; { const int q = nwg / NXCD, r = nwg % NXCD, xcd = wgid % NXCD, off = wgid / NXCD; wgid = (xcd < r ? xcd * (q + 1) : r * (q + 1) + (xcd - r) * q) + off; }
        const int nig = WGM * nN, gid = wgid / nig, fm = gid * WGM, gsz = (nM - fm) < WGM ? (nM - fm) : WGM;
        u.pm = fm + ((wgid % nig) % gsz); u.pn = (wgid % nig) / gsz; return true;
    }
    __device__ __forceinline__ void a_ready(const Unit&) const {}
    __device__ __forceinline__ void done(const Unit&) const {}
};
struct CmpOrder {
    int c;
    __device__ bool next(int i, Unit& u) const { if (i > 0 || c >= 16) return false; u.pm = c; u.pn = c >> 3; return true; }
    __device__ __forceinline__ void a_ready(const Unit&) const {}
    __device__ __forceinline__ void done(const Unit&) const {}
};

__device__ __forceinline__ unsigned cvt_pk_bf16(float lo, float hi) { unsigned r; asm volatile("v_cvt_pk_bf16_f32 %0, %1, %2" : "=v"(r) : "v"(lo), "v"(hi)); return r; }
__device__ __forceinline__ f32x2 gelu_pk(f32x2 v) {
    const f32x2 av = __builtin_elementwise_abs(v), d = av * 0.2316418882f + 1.0f;
    f32x2 t; t.x = __builtin_amdgcn_rcpf(d.x); t.y = __builtin_amdgcn_rcpf(d.y);
    f32x2 q = t * 0.5307027145f + (-0.7265760135f); q = q * t + 0.7107068705f; q = q * t + (-0.142248368f); q = q * t + 0.127414796f; q = q * t;
    const f32x2 s = (v * v) * (-0.72134752044f);
    f32x2 e; e.x = __builtin_amdgcn_exp2f(s.x); e.y = __builtin_amdgcn_exp2f(s.y);
    const f32x2 m = v * (q * e), r = v - m;
    f32x2 o; o.x = v.x < 0.f ? m.x : r.x; o.y = v.y < 0.f ? m.y : r.y; return o;
}
__device__ __forceinline__ float silu_f(float x) { return x * __builtin_amdgcn_rcpf(1.0f + __builtin_amdgcn_exp2f(-1.4426950408889634f * x)); }
__device__ __forceinline__ u32x4 pack8(const f32x4 v0, const f32x4 v1) { u32x4 w; w.x = cvt_pk_bf16(v0[0], v0[1]); w.y = cvt_pk_bf16(v0[2], v0[3]); w.z = cvt_pk_bf16(v1[0], v1[1]); w.w = cvt_pk_bf16(v1[2], v1[3]); return w; }

struct EpiBf16Plain {
    static constexpr bool PERM = true, AFTER_DRAIN = false;
    bf16_t* O; int ldc;
    __device__ __forceinline__ void operator()(const f32x4 (&acc)[2][2][4][2], const Unit& u, int wr, int wc, int fr, int fq) const {
        const int row0 = u.pm * BM + wr * 64 + fr, col0 = u.pn * BM + wc * 32 + 8 * fq;
#pragma unroll
        for (int ai = 0; ai < 2; ++ai)
#pragma unroll
            for (int m = 0; m < 4; ++m) { bf16_t* rowp = O + (size_t)(row0 + ai * HALF + m * 16) * ldc + col0;
#pragma unroll
                for (int bj = 0; bj < 2; ++bj) *(u32x4*)(rowp + bj * HALF) = pack8(acc[ai][bj][m][0], acc[ai][bj][m][1]); }
    }
};
struct EpiProj {
    static constexpr bool PERM = true, AFTER_DRAIN = false;
    bf16_t* Q; bf16_t* KV; bf16_t* Z; bf16_t* XBC; float* GLDT;
    __device__ __forceinline__ void operator()(const f32x4 (&acc)[2][2][4][2], const Unit& u, int wr, int wc, int fr, int fq) const {
        const int row0 = u.pm * BM + wr * 64 + fr, pn = u.pn, cl = wc * 32 + 8 * fq;
        if (pn == 11) {
            if (wc == 0) {
#pragma unroll
                for (int ai = 0; ai < 2; ++ai)
#pragma unroll
                    for (int m = 0; m < 4; ++m) { float* rowp = GLDT + (size_t)(row0 + ai * HALF + m * 16) * 32 + 8 * fq;
                        *(f32x4*)(rowp) = acc[ai][0][m][0]; *(f32x4*)(rowp + 4) = acc[ai][0][m][1]; }
            }
            return;
        }
        bf16_t* base0; int stride, laneoff, halfstep;
        if (pn < 2) { base0 = Q + pn * 256; stride = 512; laneoff = cl; halfstep = HALF; }
        else if (pn < 5) { const int b = (u.pm * BM) >> 11; base0 = KV + ((size_t)((pn - 2) * 2) << 21) + (size_t)b * 131072; stride = 64; laneoff = (wc >> 1) * 131072 + (wc & 1) * 32 + 8 * fq; halfstep = 1 << 21; }
        else if (pn < 7) { base0 = Z + (pn - 5) * 256; stride = 512; laneoff = cl; halfstep = HALF; }
        else { base0 = XBC + (pn - 7) * 256; stride = 1024; laneoff = cl; halfstep = HALF; }
        const unsigned off0 = (unsigned)(row0 * stride + laneoff);
#pragma unroll
        for (int ai = 0; ai < 2; ++ai)
#pragma unroll
            for (int m = 0; m < 4; ++m) {
                const unsigned off = off0 + (unsigned)((ai * HALF + m * 16) * stride);
                *(u32x4*)(base0 + off) = pack8(acc[ai][0][m][0], acc[ai][0][m][1]);
                *(u32x4*)(base0 + halfstep + off) = pack8(acc[ai][1][m][0], acc[ai][1][m][1]);
                asm volatile("" ::: "memory");
            }
    }
};
struct EpiSwiGLU {
    static constexpr bool PERM = true, AFTER_DRAIN = false;
    bf16_t* T; int ldc;
    __device__ __forceinline__ void operator()(const f32x4 (&acc)[2][2][4][2], const Unit& u, int wr, int wc, int fr, int fq) const {
        const int row0 = u.pm * BM + wr * 64 + fr, col0 = u.pn * HALF + wc * 32 + 8 * fq;
#pragma unroll
        for (int ai = 0; ai < 2; ++ai)
#pragma unroll
            for (int m = 0; m < 4; ++m) {
                f32x4 v0, v1;
#pragma unroll
                for (int j = 0; j < 4; ++j) { v0[j] = silu_f(acc[ai][0][m][0][j]) * acc[ai][1][m][0][j]; v1[j] = silu_f(acc[ai][0][m][1][j]) * acc[ai][1][m][1][j]; }
                *(u32x4*)(T + (size_t)(row0 + ai * HALF + m * 16) * ldc + col0) = pack8(v0, v1);
            }
    }
};
struct EpiGelu {
    static constexpr bool PERM = true, AFTER_DRAIN = false;
    bf16_t* U; bf16_t* V; float* ST;
    __device__ __forceinline__ void operator()(const f32x4 (&acc)[2][2][4][2], const Unit& u, int wr, int wc, int fr, int fq) const {
        const int row0 = u.pm * BM + wr * 64 + fr, pn = u.pn;
        const bool isv = pn >= 8; bf16_t* base = isv ? V : U; const int col0 = (isv ? pn - 8 : pn) * BM + wc * 32 + 8 * fq;
#pragma unroll
        for (int ai = 0; ai < 2; ++ai)
#pragma unroll
            for (int m = 0; m < 4; ++m) {
                const int row = row0 + ai * HALF + m * 16; float s = 0.f, ss = 0.f;
#pragma unroll
                for (int bj = 0; bj < 2; ++bj) {
                    const f32x4 x0 = acc[ai][bj][m][0], x1 = acc[ai][bj][m][1];
                    const f32x2 a = gelu_pk((f32x2){x0[0], x0[1]}), b = gelu_pk((f32x2){x0[2], x0[3]}), c = gelu_pk((f32x2){x1[0], x1[1]}), d = gelu_pk((f32x2){x1[2], x1[3]});
                    s += (a.x + a.y) + (b.x + b.y) + (c.x + c.y) + (d.x + d.y);
                    ss += (a.x * a.x + a.y * a.y) + (b.x * b.x + b.y * b.y) + (c.x * c.x + c.y * c.y) + (d.x * d.x + d.y * d.y);
                    *(u32x4*)(base + (size_t)row * 2048 + col0 + bj * HALF) = pack8((f32x4){a.x, a.y, b.x, b.y}, (f32x4){c.x, c.y, d.x, d.y});
                }
                if (isv) {
                    s += __shfl_xor(s, 16); s += __shfl_xor(s, 32); ss += __shfl_xor(ss, 16); ss += __shfl_xor(ss, 32);
                    if (fq == 0) *(f32x2*)(ST + ((size_t)row * 32 + (pn - 8) * 4 + wc) * 2) = (f32x2){s, ss};
                }
            }
    }
};
struct EpiCmp {
    static constexpr bool PERM = true, AFTER_DRAIN = false;
    bf16_t* H1; const float* bias;
    __device__ __forceinline__ void operator()(const f32x4 (&acc)[2][2][4][2], const Unit& u, int wr, int wc, int fr, int fq) const {
        const int row0 = u.pm * BM + wr * 64 + fr, cl = wc * 32 + 8 * fq; const float* bs = bias + u.pn * 256;
#pragma unroll
        for (int bj = 0; bj < 2; ++bj) {
            const f32x4 b0 = *(const f32x4*)(bs + bj * HALF + cl), b1 = *(const f32x4*)(bs + bj * HALF + cl + 4);
#pragma unroll
            for (int ai = 0; ai < 2; ++ai)
#pragma unroll
                for (int m = 0; m < 4; ++m) {
                    f32x4 v0 = acc[ai][bj][m][0] + b0, v1 = acc[ai][bj][m][1] + b1;
#pragma unroll
                    for (int j = 0; j < 4; ++j) { v0[j] = silu_f(v0[j]); v1[j] = silu_f(v1[j]); }
                    *(u32x4*)(H1 + (size_t)(row0 + ai * HALF + m * 16) * 256 + bj * HALF + cl) = pack8(v0, v1);
                }
        }
    }
};

template <class Epi, class Sched, bool ALIGN_EPI = false, bool SP2 = false>
__device__ __forceinline__ void gemm_phase(PG8_LAS unsigned char* lds, const Gemm g, const Sched& S, const Epi& E, const int tid) {
    const int wid = __builtin_amdgcn_readfirstlane(tid >> 6), lane = tid & 63, wr = wid >> 2, wc = wid & 3, fr = lane & 15, fq = lane >> 4;
    const int K = g.K, nt = K / BK;
    unsigned voffA[2], voffB[2];
#pragma unroll
    for (int i = 0; i < 2; ++i) { int R, C; stage_rc(tid * 16 + i * 8192, R, C); const int Rb = Epi::PERM ? ((R & ~31) + perm32(R & 31)) : R;
        voffA[i] = (unsigned)(R * g.lda + C) * 2u; voffB[i] = (unsigned)(Rb * K + C) * 2u; }
    const size_t kstep = (size_t)(BK * 2);
    const size_t hstepB = (size_t)HALF * K * 2, hstepA = (size_t)HALF * g.lda * 2;
    const size_t tstepA = 2 * hstepA, tstepB = 2 * hstepB;
    const unsigned ldsw = (unsigned)wid * 1024u;
    const int aoff = lds_byte(wr * 64 + fr, fq * 8), boff = lds_byte(wc * 32 + fr, fq * 8);
#define PG8_SA(b, h) (((b) * 2 + (h)) * HTB)
#define PG8_SB(b, h) ((4 + (b) * 2 + (h)) * HTB)
#define PG8_STAGE(bufoff, gbase, voff) do { _Pragma("unroll") for (int _i = 0; _i < 2; ++_i) \
        __builtin_amdgcn_global_load_lds((const unsigned*)((const char*)(gbase) + (voff)[_i]), (PG8_LAS unsigned*)(lds + (bufoff) + ldsw + _i * 8192), 16, 0, 0); } while (0)
#define PG8_LDA(dst, b, h) do { _Pragma("unroll") for (int m = 0; m < 4; ++m) _Pragma("unroll") for (int k = 0; k < 2; ++k) dst[m][k] = *(const PG8_LAS bf16x8*)(lds + PG8_SA(b, h) + aoff + m * 2048 + k * 1024); } while (0)
#define PG8_LDB(dst, b, h) do { _Pragma("unroll") for (int n = 0; n < 2; ++n) _Pragma("unroll") for (int k = 0; k < 2; ++k) dst[n][k] = *(const PG8_LAS bf16x8*)(lds + PG8_SB(b, h) + boff + n * 2048 + k * 1024); } while (0)
#define PG8_MMA(ai, bj, At, Bt) do { __builtin_amdgcn_s_setprio(1); _Pragma("unroll") for (int m = 0; m < 4; ++m) _Pragma("unroll") for (int n = 0; n < 2; ++n) _Pragma("unroll") for (int k = 0; k < 2; ++k) \
        acc[ai][bj][m][n] = __builtin_amdgcn_mfma_f32_16x16x32_bf16(Bt[n][k], At[m][k], acc[ai][bj][m][n], 0, 0, 0); __builtin_amdgcn_s_setprio(0); } while (0)
#define PG8_WAIT_V(n) asm volatile("s_waitcnt vmcnt(" #n ")" ::: "memory")
#define PG8_WAIT_L(n) asm volatile("s_waitcnt lgkmcnt(" #n ")" ::: "memory")
#define PG8_BAR __builtin_amdgcn_s_barrier()
#define PG8_SCHED __builtin_amdgcn_sched_barrier(0)
    Unit cur, nxt; int ui = 0;
    if (!S.next(0, cur)) return;
    f32x4 acc[2][2][4][2];
#pragma unroll
    for (int a = 0; a < 2; ++a)
#pragma unroll
        for (int b = 0; b < 2; ++b)
#pragma unroll
            for (int m = 0; m < 4; ++m)
#pragma unroll
                for (int n = 0; n < 2; ++n) acc[a][b][m][n] = (f32x4){0.f, 0.f, 0.f, 0.f};
    bf16x8 At[4][2], B0[2][2], B1[2][2];
    const char* cA = (const char*)g.A + (size_t)cur.pm * tstepA; const char* cB = (const char*)g.Bt + (size_t)cur.pn * tstepB;
    S.a_ready(cur);
    if constexpr (SP2) {
        PG8_STAGE(PG8_SB(0, 0), cB, voffB); PG8_STAGE(PG8_SB(0, 1), cB + hstepB, voffB); PG8_STAGE(PG8_SA(0, 0), cA, voffA); PG8_STAGE(PG8_SA(0, 1), cA + hstepA, voffA);
        if (wr == 1) PG8_BAR;
        PG8_WAIT_V(2); PG8_BAR;
        PG8_STAGE(PG8_SB(1, 0), cB + kstep, voffB); PG8_STAGE(PG8_SA(1, 0), cA + kstep, voffA); PG8_STAGE(PG8_SB(1, 1), cB + hstepB + kstep, voffB);
        PG8_WAIT_V(6); PG8_BAR;
    } else {
        PG8_STAGE(PG8_SB(0, 0), cB, voffB); PG8_STAGE(PG8_SA(0, 0), cA, voffA); PG8_STAGE(PG8_SB(0, 1), cB + hstepB, voffB); PG8_STAGE(PG8_SA(0, 1), cA + hstepA, voffA);
        if (wr == 1) PG8_BAR;
        PG8_WAIT_V(4); PG8_BAR;
        PG8_STAGE(PG8_SB(1, 0), cB + kstep, voffB); PG8_STAGE(PG8_SA(1, 0), cA + kstep, voffA); PG8_STAGE(PG8_SB(1, 1), cB + hstepB + kstep, voffB);
        PG8_WAIT_V(6); PG8_BAR;
    }
    for (;;) {
        const bool has_next = S.next(ui + 1, nxt);
        const char* nA = has_next ? (const char*)g.A + (size_t)nxt.pm * tstepA : cA; const char* nB = has_next ? (const char*)g.Bt + (size_t)nxt.pn * tstepB : cB;
        for (int t = 0; t < nt; t += 2) {
            const bool last = (t == nt - 2);
            const char* a1 = cA + (size_t)(t + 1) * kstep;
            const char* a2 = last ? nA : cA + (size_t)(t + 2) * kstep; const char* b2 = last ? nB : cB + (size_t)(t + 2) * kstep;
            const char* a3 = a2 + kstep; const char* b3 = b2 + kstep;
            if (last && has_next) S.a_ready(nxt);
            if constexpr (SP2) {
            PG8_LDB(B0, 0, 0); PG8_LDB(B1, 0, 1); PG8_SCHED; PG8_LDA(At, 0, 0); PG8_STAGE(PG8_SA(1, 1), a1 + hstepA, voffA);
            PG8_WAIT_V(8); PG8_WAIT_L(0); PG8_BAR; PG8_MMA(0, 0, At, B0); PG8_MMA(0, 1, At, B1); PG8_BAR; PG8_SCHED;
            PG8_LDA(At, 0, 1); PG8_STAGE(PG8_SB(0, 0), b2, voffB); PG8_STAGE(PG8_SB(0, 1), b2 + hstepB, voffB); PG8_STAGE(PG8_SA(0, 0), a2, voffA);
            PG8_WAIT_V(8); PG8_WAIT_L(0); PG8_BAR; PG8_MMA(1, 0, At, B0); PG8_MMA(1, 1, At, B1); PG8_BAR; PG8_SCHED;
            PG8_LDB(B0, 1, 0); PG8_LDB(B1, 1, 1); PG8_SCHED; PG8_LDA(At, 1, 0); PG8_STAGE(PG8_SA(0, 1), a2 + hstepA, voffA);
            PG8_WAIT_V(8); PG8_WAIT_L(0); PG8_BAR; PG8_MMA(0, 0, At, B0); PG8_MMA(0, 1, At, B1); PG8_BAR; PG8_SCHED;
            PG8_LDA(At, 1, 1); PG8_STAGE(PG8_SB(1, 0), b3, voffB); PG8_STAGE(PG8_SB(1, 1), b3 + hstepB, voffB); PG8_STAGE(PG8_SA(1, 0), a3, voffA);
            PG8_WAIT_V(8); PG8_WAIT_L(0); PG8_BAR; PG8_MMA(1, 0, At, B0); PG8_MMA(1, 1, At, B1); PG8_BAR; PG8_SCHED;
            } else {
            PG8_LDB(B0, 0, 0); PG8_SCHED; PG8_LDA(At, 0, 0); PG8_STAGE(PG8_SA(1, 1), a1 + hstepA, voffA);
            PG8_WAIT_L(8); PG8_BAR; PG8_WAIT_L(0); PG8_MMA(0, 0, At, B0); PG8_BAR; PG8_SCHED;
            PG8_LDB(B1, 0, 1); PG8_STAGE(PG8_SB(0, 0), b2, voffB);
            PG8_BAR; PG8_WAIT_L(0); PG8_MMA(0, 1, At, B1); PG8_BAR;
            PG8_LDA(At, 0, 1); PG8_STAGE(PG8_SA(0, 0), a2, voffA);
            PG8_BAR; PG8_WAIT_L(0); PG8_MMA(1, 0, At, B0); PG8_BAR; PG8_SCHED;
            PG8_STAGE(PG8_SB(0, 1), b2 + hstepB, voffB);
            PG8_WAIT_V(6); PG8_BAR; PG8_MMA(1, 1, At, B1); PG8_BAR;
            PG8_LDB(B0, 1, 0); PG8_SCHED; PG8_LDA(At, 1, 0); PG8_STAGE(PG8_SA(0, 1), a2 + hstepA, voffA);
            PG8_WAIT_L(8); PG8_BAR; PG8_WAIT_L(0); PG8_MMA(0, 0, At, B0); PG8_BAR; PG8_SCHED;
            PG8_LDB(B1, 1, 1); PG8_STAGE(PG8_SB(1, 0), b3, voffB);
            PG8_BAR; PG8_WAIT_L(0); PG8_MMA(0, 1, At, B1); PG8_BAR;
            PG8_LDA(At, 1, 1); PG8_STAGE(PG8_SA(1, 0), a3, voffA);
            PG8_BAR; PG8_WAIT_L(0); PG8_MMA(1, 0, At, B0); PG8_BAR; PG8_SCHED;
            PG8_STAGE(PG8_SB(1, 1), b3 + hstepB, voffB);
            PG8_WAIT_V(6); PG8_BAR; PG8_MMA(1, 1, At, B1); PG8_BAR;
            }
        }
        if constexpr (ALIGN_EPI) { if (wr == 0) PG8_BAR; }
        if constexpr (!Epi::AFTER_DRAIN) { E(acc, cur, wr, wc, fr, fq); S.done(cur); }
        if (!has_next) break;
#pragma unroll
        for (int a = 0; a < 2; ++a)
#pragma unroll
            for (int b = 0; b < 2; ++b)
#pragma unroll
                for (int m = 0; m < 4; ++m)
#pragma unroll
                    for (int n = 0; n < 2; ++n) acc[a][b][m][n] = (f32x4){0.f, 0.f, 0.f, 0.f};
        cur = nxt; cA = nA; cB = nB; ++ui;
        if constexpr (ALIGN_EPI) { if (wr == 1) PG8_BAR; }
    }
    PG8_WAIT_V(0);
    if constexpr (!ALIGN_EPI) { if (wr == 0) PG8_BAR; }
    PG8_BAR;
    if constexpr (Epi::AFTER_DRAIN) { E.fused(acc, cur, wr, wc, fr, fq, lds, wid, lane); S.done(cur); }
#undef PG8_SA
#undef PG8_SB
#undef PG8_STAGE
#undef PG8_LDA
#undef PG8_LDB
#undef PG8_MMA
#undef PG8_WAIT_V
#undef PG8_WAIT_L
#undef PG8_BAR
#undef PG8_SCHED
}
}

constexpr int NWAVES = 8;
constexpr int BATCH = 8, SEQ = 2048, D = 1024, M = BATCH * SEQ, FFH = 2816, DEPTH = 4;
constexpr int EV_IN = 2848, EV_IN_PAD = 3072;
constexpr float RMS_EPS = 1e-6f, LN_EPS = 1e-5f;

constexpr size_t MiB = 1u << 20;
constexpr size_t WS_CTL = 0, CTL_ZERO_BYTES = 64 * 1024;
constexpr size_t WS_SMALL = 1 * MiB;
constexpr size_t WS_WFFN = 2 * MiB, WFFN_STRIDE = 17301504;
constexpr size_t WS_WEV = 68 * MiB, WEV_STRIDE = 10 * MiB;
constexpr size_t WS_WOD = 88 * MiB, WOD_STRIDE = 12 * MiB;
constexpr size_t WS_A = 112 * MiB;
constexpr size_t WS_BIG = 144 * MiB;
constexpr size_t WS_Q = WS_BIG, WS_KV = WS_BIG + 16 * MiB, WS_Z = WS_BIG + 40 * MiB, WS_XBC = WS_BIG + 56 * MiB, WS_GLDT = WS_BIG + 88 * MiB, WS_YD = WS_BIG + 90 * MiB  ,
                 WS_SST = WS_BIG + 106 * MiB  , WS_CCONV = WS_BIG + 122 * MiB  , WS_H1 = WS_BIG + 130 * MiB, WS_KCB = WS_BIG + 132 * MiB, WS_YEV = WS_BIG;
constexpr size_t WS_ACSG = WS_SMALL + 64 * 1024  , WS_ATOT = WS_SMALL + 640 * 1024  ;
constexpr size_t WS_T = WS_BIG, WS_YFF = WS_BIG + 88 * MiB;
constexpr size_t WS_U = WS_BIG, WS_V = WS_BIG + 64 * MiB, WS_ST = WS_BIG + 128 * MiB, WS_YOD = WS_BIG + 64 * MiB;
constexpr size_t WS_END = 280 * MiB;
constexpr int CW_BAR = 4096;

constexpr int SCR_BYTES = 152 * 1024;
constexpr int MISC_OFF = SCR_BYTES;
constexpr int LDS_BYTES = SCR_BYTES + 512;

#define GAS __attribute__((address_space(1)))
#define LAS __attribute__((address_space(3)))
typedef unsigned short bf16;
typedef unsigned v4u __attribute__((ext_vector_type(4)));
typedef unsigned v2u __attribute__((ext_vector_type(2)));
typedef float f32x4 __attribute__((ext_vector_type(4)));
typedef float f32x2 __attribute__((ext_vector_type(2)));
typedef GAS unsigned gu32;
#define RLX_AGENT __ATOMIC_RELAXED, __HIP_MEMORY_SCOPE_AGENT
#define LDS_WAIT() asm volatile("s_waitcnt lgkmcnt(0)" ::: "memory")
#define VM_WAIT() asm volatile("s_waitcnt vmcnt(0)" ::: "memory")
__device__ __forceinline__ unsigned f2bf(float f) { unsigned u = __builtin_bit_cast(unsigned, f); return (u + 0x7fffu + ((u >> 16) & 1u)) >> 16; }
__device__ __forceinline__ unsigned pk2(float lo, float hi) { return f2bf(lo) | (f2bf(hi) << 16); }
__device__ __forceinline__ float bflo(unsigned w) { return __builtin_bit_cast(float, w << 16); }
__device__ __forceinline__ float bfhi(unsigned w) { return __builtin_bit_cast(float, w & 0xffff0000u); }
__device__ __forceinline__ float bf2f(bf16 h) { return __builtin_bit_cast(float, (unsigned)h << 16); }
__device__ __forceinline__ float wave_sum(float v) {
#pragma unroll
    for (int o = 1; o < 64; o <<= 1) v += __shfl_xor(v, o);
    return v;
}
__device__ __forceinline__ float wave_max(float v) {
#pragma unroll
    for (int o = 1; o < 64; o <<= 1) v = fmaxf(v, __shfl_xor(v, o));
    return v;
}
__device__ __forceinline__ float silu_f(float x) { return x / (1.0f + __expf(-x)); }
__device__ __forceinline__ float sigmoid_f(float x) { return 1.0f / (1.0f + __expf(-x)); }

__device__ __forceinline__ int flane() { return (int)__builtin_amdgcn_mbcnt_hi(~0u, __builtin_amdgcn_mbcnt_lo(~0u, 0u)); }
#define XB_TMO      128
#define XB_XCNT(j)  (256  + 64 * (j))
#define XB_XSUB(j)  (1280 + 64 * (j))
#define XB_XGEN(j)  (2304 + 64 * (j))
#define XB_TOP      3328
#define XB_TOPGEN   3392
#define XCD_BAR_WORDS 3456
#define XB_SPIN_CAP (1u << 22)

__device__ __forceinline__ unsigned xb_ld(unsigned* p)              { return __hip_atomic_load(p, __ATOMIC_RELAXED, __HIP_MEMORY_SCOPE_AGENT); }
__device__ __forceinline__ unsigned xb_add(unsigned* p, unsigned v) { return __hip_atomic_fetch_add(p, v, __ATOMIC_RELAXED, __HIP_MEMORY_SCOPE_AGENT); }
__device__ __forceinline__ unsigned xb_xcc_id() { return (unsigned)__builtin_amdgcn_s_getreg((3 << 11) | 20) & 0xFu; }
#define XB_SPIN(cond, bar) do { unsigned _sp = 0; while (cond) { __builtin_amdgcn_s_sleep(1); \
    if ((++_sp & 255u) == 0u) { if (xb_ld(&(bar)[XB_TMO])) break; if (_sp > XB_SPIN_CAP) { atomicAdd(&(bar)[XB_TMO], 1u); break; } } } } while (0)

struct XcdBarrier { unsigned* bar; unsigned x; volatile LAS unsigned* st; };
__device__ __forceinline__ XcdBarrier xcd_barrier_post(unsigned* bar, volatile LAS unsigned* st) {
    XcdBarrier b; b.bar = bar; b.x = xb_xcc_id(); b.st = st;
    if (threadIdx.x == 0) (void)xb_add(&bar[XB_XCNT(b.x)], 1u);
    return b;
}
__device__ __forceinline__ void xcd_barrier_complete(unsigned* bar, unsigned x, unsigned& nloc, unsigned& nx) {
    const unsigned G = gridDim.x * gridDim.y * gridDim.z;
    unsigned sum, cnt, mine, sp = 0u;
    for (;;) {
        sum = 0u; cnt = 0u; mine = 0u;
#pragma unroll
        for (unsigned j = 0; j < 16; ++j) { const unsigned c = xb_ld(&bar[XB_XCNT(j)]); sum += c; cnt += (c > 0u) ? 1u : 0u; mine = (j == x) ? c : mine; }
        if (sum == G) break;
        __builtin_amdgcn_s_sleep(1);
        if ((++sp & 255u) == 0u) { if (xb_ld(&bar[XB_TMO])) break; if (sp > XB_SPIN_CAP) { atomicAdd(&bar[XB_TMO], 1u); break; } }
    }
    nloc = mine > 0u ? mine : 1u; nx = cnt > 0u ? cnt : 1u;
}
__device__ __forceinline__ void xcd_barrier(const XcdBarrier& b, const int wave) {
    asm volatile("s_waitcnt vmcnt(0)" ::: "memory");
    __syncthreads();
    if (wave == 0 && flane() == 0) {
        unsigned* bar = b.bar;
        __builtin_amdgcn_s_waitcnt(0);
        unsigned nloc = b.st[0], nx = b.st[1];
        if (nloc == 0u) { xcd_barrier_complete(bar, b.x, nloc, nx); b.st[0] = nloc; b.st[1] = nx; }
        const unsigned old = xb_add(&bar[XB_XSUB(b.x)], 1u);
        const unsigned gen = old / nloc;
        if (old + 1u == (gen + 1u) * nloc) {
            __builtin_amdgcn_fence(__ATOMIC_RELEASE, "agent");
            asm volatile("s_waitcnt vmcnt(0)" ::: "memory");
            const unsigned og = xb_add(&bar[XB_TOP], 1u);
            const unsigned tg = og / nx;
            if (og + 1u == (tg + 1u) * nx) xb_add(&bar[XB_TOPGEN], 1u);
            else XB_SPIN(xb_ld(&bar[XB_TOPGEN]) == tg, bar);
            __builtin_amdgcn_fence(__ATOMIC_ACQUIRE, "agent");
            xb_add(&bar[XB_XGEN(b.x)], 1u);
            asm volatile("s_waitcnt vmcnt(0)" ::: "memory");
        } else {
            XB_SPIN(xb_ld(&bar[XB_XGEN(b.x)]) == gen, bar);
            __builtin_amdgcn_fence(__ATOMIC_ACQUIRE, "agent");
            asm volatile("s_waitcnt vmcnt(0)" ::: "memory");
        }
    }
    __syncthreads();
}

struct Frame {
    LAS unsigned char* lds;
    unsigned char* ws;
    int tid, lane, wave, G, bid;
    float* out;
};

enum InIdx { I_X = 0, I_GAINS, I_WG, I_WU, I_WD, I_EVIN, I_EVOUT, I_PE, I_CW1, I_CW2, I_CONVW, I_CONVB, I_DTB, I_ALOG, I_DSKIP, I_SNORM, I_ODIN, I_LNW, I_LNB, I_WS, I_BS, I_ODOUT };

__device__ __forceinline__ const float* inp(const Frame& F, int i) {
    volatile LAS unsigned* t = (volatile LAS unsigned*)(F.lds + MISC_OFF) + 32 + 2 * i;
    const unsigned lo = __builtin_amdgcn_readfirstlane(t[0]), hi = __builtin_amdgcn_readfirstlane(t[1]);
    return (const float*)(((unsigned long long)hi << 32) | lo);
}
struct TJob { const float* W; int K, N; bf16* dst; int mode; const float* gain; int gain_lo; int row_off; };
__device__ __forceinline__ int evin_row(int n) {
    if (n < 1280) return n;
    if (n < 1304) return 2816 + (n - 1280);
    if (n < 1816) return 1280 + (n - 1304);
    if (n < 2840) return 1792 + (n - 1816);
    return 2840 + (n - 2840);
}
__device__ __forceinline__ void transpose_item(const TJob& J, int local, LAS float* scr, int lane) {
    const int nblk = J.N / 32, kb = local / nblk, nb = local % nblk, k0 = 64 * kb, n0 = 32 * nb;
#pragma unroll 8
    for (int i = 0; i < 32; ++i) { const int kk = 2 * i + (lane >> 5), k = k0 + kk; float g = 1.0f; if (J.gain != nullptr && k >= J.gain_lo) g = J.gain[k];
        scr[kk * 33 + (lane & 31)] = J.W[(size_t)k * J.N + n0 + (lane & 31)] * g; }
    LDS_WAIT(); asm volatile("" ::: "memory");
    const int c = lane & 7;
#pragma unroll
    for (int j = 0; j < 4; ++j) { const int n = (lane >> 3) + 8 * j, nn = n0 + n; const LAS float* s = scr + (8 * c) * 33 + n;
        int dr; float sc = 1.0f;
        if (J.mode == 0) dr = J.row_off + nn; else if (J.mode == 1) dr = 256 * (nn >> 7) + (nn & 127) + J.row_off; else { dr = evin_row(nn); if (nn < 512) sc = 0.125f; }
        v4u o; o.x = pk2(s[0 * 33] * sc, s[1 * 33] * sc); o.y = pk2(s[2 * 33] * sc, s[3 * 33] * sc); o.z = pk2(s[4 * 33] * sc, s[5 * 33] * sc); o.w = pk2(s[6 * 33] * sc, s[7 * 33] * sc);
        *(v4u*)(J.dst + (size_t)dr * J.K + k0 + 8 * c) = o; }
    LDS_WAIT(); asm volatile("" ::: "memory");
}
constexpr int IT_FFN = 16 * 88, IT_EVIN = 16 * 89, IT_EVOUT = 16 * 32, IT_W1 = 32 * 8, IT_ODIN = 16 * 128, IT_ODOUT = 32 * 32;
constexpr int IT_EV = IT_EVIN + IT_EVOUT + 2 * IT_W1, IT_OD = IT_ODIN + IT_ODOUT;
constexpr int N_TRANS = 12 * IT_FFN + 2 * IT_EV + 2 * IT_OD;
__device__ __forceinline__ void get_job(Frame& F, int it, TJob& J, int& local) {
    if (it < 12 * IT_FFN) { const int L = it / (3 * IT_FFN), r = it % (3 * IT_FFN), w = r / IT_FFN; local = r % IT_FFN;
        bf16* base = (bf16*)(F.ws + WS_WFFN + (size_t)L * WFFN_STRIDE);
        if (w == 0) J = TJob{inp(F, I_WG) + (size_t)L * D * FFH, D, FFH, base, 1, inp(F, I_GAINS) + (L * 4 + 2) * D, 0, 0};
        else if (w == 1) J = TJob{inp(F, I_WU) + (size_t)L * D * FFH, D, FFH, base, 1, inp(F, I_GAINS) + (L * 4 + 2) * D, 0, 128};
        else J = TJob{inp(F, I_WD) + (size_t)L * FFH * D, FFH, D, base + (size_t)5632 * 1024, 0, nullptr, 0, 0};
        return; }
    it -= 12 * IT_FFN;
    if (it < 2 * IT_EV) { const int i = it / IT_EV; int r = it % IT_EV; unsigned char* base = F.ws + WS_WEV + (size_t)i * WEV_STRIDE;
        if (r < IT_EVIN) { local = r; J = TJob{inp(F, I_EVIN) + (size_t)i * D * EV_IN, D, EV_IN, (bf16*)base, 2, inp(F, I_GAINS) + (2 * i * 4 + 0) * D, 0, 0}; return; } r -= IT_EVIN;
        if (r < IT_EVOUT) { local = r; J = TJob{inp(F, I_EVOUT) + (size_t)i * D * D, D, D, (bf16*)(base + 6 * MiB), 0, inp(F, I_SNORM) + i * 512 - 512, 512, 0}; return; } r -= IT_EVOUT;
        const int kv = r / IT_W1; local = r % IT_W1;
        J = TJob{inp(F, I_CW1) + (size_t)(i * 2 + kv) * 2048 * 256, 2048, 256, (bf16*)(base + 8 * MiB), 0, nullptr, 0, kv * 256}; return; }
    it -= 2 * IT_EV;
    { const int i = it / IT_OD; int r = it % IT_OD; unsigned char* base = F.ws + WS_WOD + (size_t)i * WOD_STRIDE;
        if (r < IT_ODIN) { local = r; J = TJob{inp(F, I_ODIN) + (size_t)i * D * 4096, D, 4096, (bf16*)base, 0, inp(F, I_GAINS) + ((2 * i + 1) * 4 + 0) * D, 0, 0}; return; } r -= IT_ODIN;
        local = r; J = TJob{inp(F, I_ODOUT) + (size_t)i * 2048 * D, 2048, D, (bf16*)(base + 8 * MiB), 0, nullptr, 0, 0}; }
}
__device__ __forceinline__ void rms_row_to_bf16(const float* xrow, bf16* orow, int lane) {
    const f32x4* xr = (const f32x4*)xrow + lane;
    f32x4 v[4]; float s = 0.f;
#pragma unroll
    for (int j = 0; j < 4; ++j) { v[j] = xr[64 * j]; s += (v[j].x * v[j].x + v[j].y * v[j].y) + (v[j].z * v[j].z + v[j].w * v[j].w); }
    const float rstd = 1.0f / sqrtf(wave_sum(s) * (1.f / D) + RMS_EPS);
    v2u* o8 = (v2u*)orow + lane;
#pragma unroll
    for (int j = 0; j < 4; ++j) o8[64 * j] = (v2u){pk2(v[j].x * rstd, v[j].y * rstd), pk2(v[j].z * rstd, v[j].w * rstd)};
}
__device__ __forceinline__ void p0_prologue(Frame& F) {
    LAS float* scr = (LAS float*)(F.lds + F.wave * 16384);
    const int gw = F.bid * NWAVES + F.wave, NGW = F.G * NWAVES;
    for (int it = gw; it < N_TRANS; it += NGW) { TJob J; int local; get_job(F, it, J, local); transpose_item(J, local, scr, F.lane); }
    float* bias1 = (float*)(F.ws + WS_SMALL);
    for (int o = gw; o < 1024; o += NGW) { const int ik = o >> 8, j = o & 255; const float* pe = inp(F, I_PE) + (size_t)ik * 2048; const float* w1 = inp(F, I_CW1) + (size_t)ik * 2048 * 256 + j;
        float s = 0.f;
        for (int t = 0; t < 32; ++t) { const int k = t * 64 + F.lane; s += pe[k] * w1[(size_t)k * 256]; }
        s = wave_sum(s); if (F.lane == 0) bias1[o] = s; }
    for (int m = gw; m < M; m += NGW) rms_row_to_bf16(inp(F, I_X) + (size_t)m * D, (bf16*)(F.ws + WS_A) + (size_t)m * D, F.lane);
}

__device__ __forceinline__ void rowpass(Frame& F, const bf16* Y, const float* hin, float* hout, bf16* aout, const float* gain) {
    const int gw = F.bid * NWAVES + F.wave, NGW = F.G * NWAVES, lane = F.lane;
    f32x4 gv[4];
#pragma unroll
    for (int j = 0; j < 4; ++j) gv[j] = ((const f32x4*)gain)[lane + 64 * j];
    for (int m = gw; m < M; m += NGW) {
        const v2u* yr = (const v2u*)(Y + (size_t)m * D) + lane; const f32x4* hr = (const f32x4*)(hin + (size_t)m * D) + lane;
        f32x4 y[4], h[4]; float s = 0.f;
#pragma unroll
        for (int j = 0; j < 4; ++j) { const v2u w = yr[64 * j]; y[j] = (f32x4){bflo(w.x), bfhi(w.x), bflo(w.y), bfhi(w.y)}; h[j] = hr[64 * j];
            s += (y[j].x * y[j].x + y[j].y * y[j].y) + (y[j].z * y[j].z + y[j].w * y[j].w); }
        const float rstd = 1.0f / sqrtf(wave_sum(s) * (1.f / D) + RMS_EPS);
        float s2 = 0.f;
#pragma unroll
        for (int j = 0; j < 4; ++j) { h[j] = h[j] + y[j] * rstd * gv[j]; s2 += (h[j].x * h[j].x + h[j].y * h[j].y) + (h[j].z * h[j].z + h[j].w * h[j].w); }
        f32x4* ho = (f32x4*)(hout + (size_t)m * D) + lane;
#pragma unroll
        for (int j = 0; j < 4; ++j) ho[64 * j] = h[j];
        if (aout != nullptr) {
            const float r2 = 1.0f / sqrtf(wave_sum(s2) * (1.f / D) + RMS_EPS);
            v2u* o8 = (v2u*)(aout + (size_t)m * D) + lane;
#pragma unroll
            for (int j = 0; j < 4; ++j) o8[64 * j] = (v2u){pk2(h[j].x * r2, h[j].y * r2), pk2(h[j].z * r2, h[j].w * r2)};
        }
    }
}

__device__ __forceinline__ void compress2(Frame& F, int ie, int b0) {
    const bf16* H1 = (const bf16*)(F.ws + WS_H1); float* KCB = (float*)(F.ws + WS_KCB);
    const int nb = F.G - b0; if (F.bid < b0) return;
    for (int idx = (F.bid - b0) * 512 + F.tid; idx < 4096 * 64; idx += nb * 512) {
        const int r = idx >> 6, d = idx & 63, kv = r >> 11; const float* w2 = inp(F, I_CW2) + (size_t)(ie * 2 + kv) * 256 * 64 + d; const bf16* h = H1 + (size_t)r * 256;
        float s = 0.f;
        for (int j = 0; j < 256; j += 2) { const unsigned w = *(const unsigned*)(h + j); s += bflo(w) * w2[(size_t)j * 64]; s += bfhi(w) * w2[(size_t)(j + 1) * 64]; }
        KCB[idx] = s;
    }
}
typedef short bf16x8v __attribute__((ext_vector_type(8)));
typedef float f32x16 __attribute__((ext_vector_type(16)));
__device__ __forceinline__ int crow(int r, int hi) { return (r & 3) + 8 * (r >> 2) + 4 * hi; }
template <int KS> __device__ __forceinline__ f32x16 mma_rows(const LAS unsigned char* arow, const LAS unsigned char* brow, f32x16 acc) {
#pragma unroll
    for (int ks = 0; ks < KS; ++ks) { const bf16x8v a = *(const LAS bf16x8v*)(arow + ks * 32), b = *(const LAS bf16x8v*)(brow + ks * 32); acc = __builtin_amdgcn_mfma_f32_32x32x16_bf16(a, b, acc, 0, 0, 0); }
    return acc;
}
constexpr int SP = 272;
constexpr int S1_BC = 0, S1_BT = 34816, S1_CM = 69632, S1_XD = 104448, S1_XE = 121856, S1_DT = 139264, S1_ACS = 141312;
static_assert(S1_ACS + 2048 <= SCR_BYTES, "SSM S1 LDS map");
__device__ __forceinline__ float softplus_f(float x) { return fmaxf(x, 0.f) + log1pf(__expf(-fabsf(x))); }

__device__ __forceinline__ void ssm_s1_item(Frame& F, int ie, int item) {
    const int tid = F.tid, lane = F.lane, w = F.wave, r32 = lane & 31, hi = lane >> 5;
    const int g = item & 1, bc = item >> 1, c = bc & 15, b = bc >> 4; const size_t R0 = (size_t)b * SEQ + c * 128;
    LAS unsigned char* L = F.lds;
    LAS float* DT = (LAS float*)(L + S1_DT); LAS float* ACS = (LAS float*)(L + S1_ACS);
    const bf16* X = (const bf16*)(F.ws + WS_XBC); const float* GLDT = (const float*)(F.ws + WS_GLDT);
    bf16* YD = (bf16*)(F.ws + WS_YD); bf16* STg = (bf16*)(F.ws + WS_SST); bf16* CCONV = (bf16*)(F.ws + WS_CCONV); float* ACSG = (float*)(F.ws + WS_ACSG); float* ATOT = (float*)(F.ws + WS_ATOT);
    const float* cw = inp(F, I_CONVW) + (size_t)ie * 4 * 1024; const float* cb = inp(F, I_CONVB) + (size_t)ie * 1024;
    __syncthreads();
    if (w < 4) { const int h = 4 * g + w; const float Ah = -__expf(inp(F, I_ALOG)[ie * 8 + h]), dtb = inp(F, I_DTB)[ie * 8 + h];
        const float d0 = softplus_f(GLDT[(R0 + 2 * lane) * 32 + 24 + h] + dtb), d1 = softplus_f(GLDT[(R0 + 2 * lane + 1) * 32 + 24 + h] + dtb);
        const float a0 = d0 * Ah, a1 = d1 * Ah; float s = a0 + a1;
#pragma unroll
        for (int o = 1; o < 64; o <<= 1) { const float t = __shfl_up(s, o); if (lane >= o) s += t; }
        DT[w * 128 + 2 * lane] = d0; DT[w * 128 + 2 * lane + 1] = d1; ACS[w * 128 + 2 * lane] = s - a1; ACS[w * 128 + 2 * lane + 1] = s;
        ACSG[(R0 + 2 * lane) * 8 + h] = s - a1; ACSG[(R0 + 2 * lane + 1) * 8 + h] = s;
        if (lane == 63) ATOT[(size_t)bc * 8 + h] = s; }
    { const int grp = tid & 31, seg = tid >> 5, isC = grp >> 4, n8 = (grp & 15) * 8, ch = 512 + 256 * isC + 128 * g + n8;
      float wk[4][8], bias[8], xr[4][8];
#pragma unroll
      for (int e = 0; e < 8; ++e) { bias[e] = cb[ch + e];
#pragma unroll
          for (int k = 0; k < 4; ++k) wk[k][e] = cw[k * 1024 + ch + e]; }
#pragma unroll
      for (int j = 0; j < 11; ++j) {
          const int l = 8 * seg - 3 + j; const bool ok = (c * 128 + l) >= 0;
          v4u x = (v4u){0u, 0u, 0u, 0u}; if (ok) x = *(const v4u*)(X + (size_t)((long)R0 + l) * 1024 + ch);
          const int sl = j & 3;
          xr[sl][0] = bflo(x.x); xr[sl][1] = bfhi(x.x); xr[sl][2] = bflo(x.y); xr[sl][3] = bfhi(x.y); xr[sl][4] = bflo(x.z); xr[sl][5] = bfhi(x.z); xr[sl][6] = bflo(x.w); xr[sl][7] = bfhi(x.w);
          if (j >= 3) { float o[8];
#pragma unroll
              for (int e = 0; e < 8; ++e) { float a = bias[e];
#pragma unroll
                  for (int k = 0; k < 4; ++k) a += wk[k][e] * xr[(j - 3 + k) & 3][e];
                  o[e] = silu_f(a); }
              const v4u pk = (v4u){pk2(o[0], o[1]), pk2(o[2], o[3]), pk2(o[4], o[5]), pk2(o[6], o[7])};
              if (isC) { *(LAS v4u*)(L + S1_CM + l * SP + n8 * 2) = pk; *(v4u*)(CCONV + ((size_t)R0 + l) * 256 + g * 128 + n8) = pk; }
              else { *(LAS v4u*)(L + S1_BC + l * SP + n8 * 2) = pk;
#pragma unroll
                  for (int e = 0; e < 8; ++e) *(LAS bf16*)(L + S1_BT + (n8 + e) * SP + l * 2) = (bf16)f2bf(o[e]); } } } }
    __syncthreads();
    const int l0 = 32 * (w >> 1), s0 = 64 * (w & 1);
    f32x16 cb0, cb1;
    { const f32x16 z = {0.f, 0.f, 0.f, 0.f, 0.f, 0.f, 0.f, 0.f, 0.f, 0.f, 0.f, 0.f, 0.f, 0.f, 0.f, 0.f};
      const LAS unsigned char* ar = L + S1_CM + (l0 + r32) * SP + hi * 16;
      cb0 = mma_rows<8>(ar, L + S1_BC + (s0 + r32) * SP + hi * 16, z); cb1 = mma_rows<8>(ar, L + S1_BC + (s0 + 32 + r32) * SP + hi * 16, z); }
    __syncthreads();
#pragma unroll 1
    for (int hh = 0; hh < 4; ++hh) {
        const int h = 4 * g + hh; const float Dk = inp(F, I_DSKIP)[ie * 8 + h];
        { const int cg = tid & 7, seg = tid >> 3, ch = h * 64 + 8 * cg, la = 2 * seg;
          float xv[5][8];
#pragma unroll
          for (int j = 0; j < 5; ++j) { const int l = la - 3 + j; v4u x = (v4u){0u, 0u, 0u, 0u}; if ((c * 128 + l) >= 0) x = *(const v4u*)(X + (size_t)((long)R0 + l) * 1024 + ch);
              xv[j][0] = bflo(x.x); xv[j][1] = bfhi(x.x); xv[j][2] = bflo(x.y); xv[j][3] = bfhi(x.y); xv[j][4] = bflo(x.z); xv[j][5] = bfhi(x.z); xv[j][6] = bflo(x.w); xv[j][7] = bfhi(x.w); }
          const float alast = ACS[hh * 128 + 127], d0 = DT[hh * 128 + la], d1 = DT[hh * 128 + la + 1], e0 = __expf(alast - ACS[hh * 128 + la]), e1 = __expf(alast - ACS[hh * 128 + la + 1]);
#pragma unroll
          for (int e = 0; e < 8; ++e) { float a0 = cb[ch + e], a1 = a0;
#pragma unroll
              for (int k = 0; k < 4; ++k) { const float wv = cw[k * 1024 + ch + e]; a0 += wv * xv[k][e]; a1 += wv * xv[k + 1][e]; }
              const float x0 = silu_f(a0) * d0, x1 = silu_f(a1) * d1;
              *(LAS unsigned*)(L + S1_XD + (8 * cg + e) * SP + la * 2) = pk2(x0, x1); *(LAS unsigned*)(L + S1_XE + (8 * cg + e) * SP + la * 2) = pk2(x0 * e0, x1 * e1); } }
#pragma unroll
        for (int t = 0; t < 2; ++t) { const f32x16 cbv = t == 0 ? cb0 : cb1; const int s = s0 + 32 * t + r32; const float as = ACS[hh * 128 + s];
#pragma unroll
            for (int i = 0; i < 16; ++i) { const int l = l0 + crow(i, hi); float v = 0.f; if (s <= l) v = cbv[i] * __expf(ACS[hh * 128 + l] - as); if (s == l) v += Dk / DT[hh * 128 + l];
                *(LAS bf16*)(L + S1_CM + l * SP + s * 2) = (bf16)f2bf(v); } }
        __syncthreads();
        { const f32x16 z = {0.f, 0.f, 0.f, 0.f, 0.f, 0.f, 0.f, 0.f, 0.f, 0.f, 0.f, 0.f, 0.f, 0.f, 0.f, 0.f};
          const int p0 = 32 * (w & 1);
          const f32x16 y = mma_rows<8>(L + S1_CM + (l0 + r32) * SP + hi * 16, L + S1_XD + (p0 + r32) * SP + hi * 16, z);
#pragma unroll
          for (int i = 0; i < 16; ++i) YD[((size_t)R0 + l0 + crow(i, hi)) * 512 + h * 64 + p0 + r32] = (bf16)f2bf(y[i]);
          const int ps = 32 * (w >> 2), n0 = 32 * (w & 3);
          const f32x16 st = mma_rows<8>(L + S1_XE + (ps + r32) * SP + hi * 16, L + S1_BT + (n0 + r32) * SP + hi * 16, z);
#pragma unroll
          for (int i = 0; i < 16; ++i) STg[(((size_t)bc * 8 + h) * 64 + ps + crow(i, hi)) * 128 + n0 + r32] = (bf16)f2bf(st[i]); }
        __syncthreads();
    }
}

constexpr int S3_PV = 0, S3_CC = 69632, S3_RS = 104448, S3_WT = 105472, S3_EA = 105728;
__device__ __forceinline__ void ssm_s3_item(Frame& F, int item) {
    const int tid = F.tid, lane = F.lane, w = F.wave, r32 = lane & 31, hi = lane >> 5;
    const int g = item & 1, bc = item >> 1, c = bc & 15, b = bc >> 4; const size_t R0 = (size_t)b * SEQ + c * 128;
    LAS unsigned char* L = F.lds; LAS float* RS = (LAS float*)(L + S3_RS); LAS float* WT = (LAS float*)(L + S3_WT); LAS float* EA = (LAS float*)(L + S3_EA);
    const bf16* YD = (const bf16*)(F.ws + WS_YD); const bf16* STg = (const bf16*)(F.ws + WS_SST); const bf16* CCONV = (const bf16*)(F.ws + WS_CCONV); const float* ACSG = (const float*)(F.ws + WS_ACSG); const float* ATOT = (const float*)(F.ws + WS_ATOT);
    const bf16* Z = (const bf16*)(F.ws + WS_Z); bf16* O = (bf16*)(F.ws + WS_A);
    __syncthreads();
    { const int hh = tid >> 7, l = tid & 127; EA[tid] = __expf(ACSG[(R0 + l) * 8 + 4 * g + hh]); }
    if (tid < 64) { const int hh = tid >> 4, cp = tid & 15, h = 4 * g + hh; float s = 0.f; for (int c2 = cp + 1; c2 < c; ++c2) s += ATOT[((size_t)(b * 16 + c2)) * 8 + h]; WT[tid] = cp < c ? __expf(s) : 0.f; }
    for (int idx = tid; idx < 128 * 16; idx += 512) { const int l = idx >> 4, n8 = (idx & 15) * 8; *(LAS v4u*)(L + S3_CC + l * SP + n8 * 2) = *(const v4u*)(CCONV + ((size_t)R0 + l) * 256 + g * 128 + n8); }
    __syncthreads();
    for (int idx = tid; idx < 4 * 64 * 16; idx += 512) { const int hh = idx >> 10, p = (idx >> 4) & 63, n8 = (idx & 15) * 8, h = 4 * g + hh;
        float a[8] = {0.f, 0.f, 0.f, 0.f, 0.f, 0.f, 0.f, 0.f};
        for (int c2 = 0; c2 < c; ++c2) { const float wv = WT[hh * 16 + c2]; const v4u x = *(const v4u*)(STg + ((((size_t)(b * 16 + c2)) * 8 + h) * 64 + p) * 128 + n8);
            a[0] += wv * bflo(x.x); a[1] += wv * bfhi(x.x); a[2] += wv * bflo(x.y); a[3] += wv * bfhi(x.y); a[4] += wv * bflo(x.z); a[5] += wv * bfhi(x.z); a[6] += wv * bflo(x.w); a[7] += wv * bfhi(x.w); }
        *(LAS v4u*)(L + S3_PV + (hh * 64 + p) * SP + n8 * 2) = (v4u){pk2(a[0], a[1]), pk2(a[2], a[3]), pk2(a[4], a[5]), pk2(a[6], a[7])}; }
    __syncthreads();
    const int l0 = 32 * (w >> 1), p0 = 32 * (w & 1);
#pragma unroll 1
    for (int pass = 0; pass < 2; ++pass) {
        float ss[16];
#pragma unroll
        for (int i = 0; i < 16; ++i) ss[i] = pass == 0 ? 0.f : 1.0f / sqrtf((RS[(l0 + crow(i, hi)) * 2] + RS[(l0 + crow(i, hi)) * 2 + 1]) * (1.f / 256.f) + RMS_EPS);
#pragma unroll 1
        for (int hh = 0; hh < 4; ++hh) { const int h = 4 * g + hh; const f32x16 z = {0.f, 0.f, 0.f, 0.f, 0.f, 0.f, 0.f, 0.f, 0.f, 0.f, 0.f, 0.f, 0.f, 0.f, 0.f, 0.f};
            const f32x16 yo = mma_rows<8>(L + S3_CC + (l0 + r32) * SP + hi * 16, L + S3_PV + (hh * 64 + p0 + r32) * SP + hi * 16, z);
            const size_t base = (R0 + l0 + 4 * hi) * 512 + h * 64 + p0 + r32; const bf16* ydp = YD + base; const bf16* zp = Z + base; const LAS float* eap = EA + hh * 128 + l0 + 4 * hi;
            bf16* op = O + (R0 + l0 + 4 * hi) * 1024 + 512 + g * 256 + hh * 64 + p0 + r32;
#pragma unroll
            for (int i = 0; i < 16; ++i) { const int ro = (i & 3) + 8 * (i >> 2);
                const float y = bf2f(ydp[ro * 512]) + yo[i] * eap[ro]; const float t = y * silu_f(bf2f(zp[ro * 512]));
                if (pass == 0) ss[i] += t * t; else op[ro * 1024] = (bf16)f2bf(t * ss[i]); }
        }
        if (pass == 0) {
#pragma unroll
            for (int i = 0; i < 16; ++i) { float s = ss[i]; s += __shfl_xor(s, 1); s += __shfl_xor(s, 2); s += __shfl_xor(s, 4); s += __shfl_xor(s, 8); s += __shfl_xor(s, 16); if (r32 == 0) RS[(l0 + crow(i, hi)) * 2 + (w & 1)] = s; }
            __syncthreads();
        }
    }
}

constexpr int AT_QS = 0, AT_KT = 32768, AT_VT = AT_KT + 64 * 65 * 4, AT_VT1 = AT_VT + 16384, AT_PW = AT_VT1 + 16384, AT_OR = AT_PW + 2048, AT_FIN = AT_OR + 32768, AT_ML = AT_FIN + 32768, AT_GT = AT_ML + 1024, AT_SELM = AT_GT + 1536;
static_assert(AT_SELM + 128 <= SCR_BYTES, "attention LDS map");
constexpr float NEGF = -1e30f;
__device__ __forceinline__ void at_load_tile_f32(LAS float* dst, int stride, const float* src, int tid) {
    const int key = tid >> 3, part = (tid & 7) * 8; const f32x4 a = *(const f32x4*)(src + key * 64 + part), b = *(const f32x4*)(src + key * 64 + part + 4);
    LAS float* p = dst + key * stride + part; p[0] = a.x; p[1] = a.y; p[2] = a.z; p[3] = a.w; p[4] = b.x; p[5] = b.y; p[6] = b.z; p[7] = b.w;
}
__device__ __forceinline__ void at_load_tile_bf16(LAS float* dst, int stride, const bf16* src, int tid) {
    const int key = tid >> 3, part = (tid & 7) * 8; const v4u a = *(const v4u*)(src + key * 64 + part);
    LAS float* p = dst + key * stride + part; p[0] = bflo(a.x); p[1] = bfhi(a.x); p[2] = bflo(a.y); p[3] = bfhi(a.y); p[4] = bflo(a.z); p[5] = bfhi(a.z); p[6] = bflo(a.w); p[7] = bfhi(a.w);
}
__device__ __forceinline__ float at_dot(const LAS float* q, const LAS float* krow) {
    float s = 0.f;
#pragma unroll 1
    for (int d4 = 0; d4 < 16; ++d4) { const f32x4 qv = *(const LAS f32x4*)(q + 4 * d4); s += qv.x * krow[4 * d4] + qv.y * krow[4 * d4 + 1] + qv.z * krow[4 * d4 + 2] + qv.w * krow[4 * d4 + 3]; }
    return s;
}
__device__ __forceinline__ float at_pv(LAS float* pw, int lane, float p, const LAS float* vt) {
    asm volatile("" ::: "memory"); *(volatile LAS float*)(pw + lane) = p; asm volatile("s_waitcnt lgkmcnt(0)" ::: "memory");
    float o = 0.f; const LAS float* vb = vt + lane;
#pragma unroll 1
    for (int k4 = 0; k4 < 16; ++k4) { const f32x4 pv = *(const volatile LAS f32x4*)(pw + 4 * k4);
        o += pv.x * vb[(4 * k4) * 64] + pv.y * vb[(4 * k4 + 1) * 64] + pv.z * vb[(4 * k4 + 2) * 64] + pv.w * vb[(4 * k4 + 3) * 64]; }
    asm volatile("s_waitcnt lgkmcnt(0)" ::: "memory");
    return o;
}
__device__ __forceinline__ void attn_item(Frame& F, int item) {
    const int tid = F.tid, lane = F.lane, w = F.wave;
    const int qblk = 63 - (item >> 4), bg = item & 15, b = bg >> 1, g = bg & 1, t0 = qblk * 32, cur = t0 >> 6;
    LAS float* QS = (LAS float*)(F.lds + AT_QS); LAS float* KT = (LAS float*)(F.lds + AT_KT); LAS float* VT = (LAS float*)(F.lds + AT_VT); LAS float* VT1 = (LAS float*)(F.lds + AT_VT1);
    LAS float* PW = (LAS float*)(F.lds + AT_PW) + w * 64; volatile LAS float* OR = (volatile LAS float*)(F.lds + AT_OR) + w * 1024; volatile LAS float* FIN = (volatile LAS float*)(F.lds + AT_FIN) + w * 1024;
    volatile LAS float* ML = (volatile LAS float*)(F.lds + AT_ML) + w * 32; LAS float* GT = (LAS float*)(F.lds + AT_GT); volatile LAS unsigned* SELM = (volatile LAS unsigned*)(F.lds + AT_SELM) + w * 4;
    const bf16* Qg = (const bf16*)(F.ws + WS_Q); const bf16* KVg = (const bf16*)(F.ws + WS_KV); const float* KCB = (const float*)(F.ws + WS_KCB); const float* GLDT = (const float*)(F.ws + WS_GLDT);
    __syncthreads();
    { const int row = tid >> 2, part = tid & 3, qi = row >> 2, r = row & 3; const bf16* src = Qg + (size_t)(b * SEQ + t0 + qi) * 512 + (g * 4 + r) * 64 + part * 16;
      const v4u a = *(const v4u*)src, c = *(const v4u*)(src + 8); LAS float* p = QS + row * 64 + part * 16;
      p[0] = bflo(a.x); p[1] = bfhi(a.x); p[2] = bflo(a.y); p[3] = bfhi(a.y); p[4] = bflo(a.z); p[5] = bfhi(a.z); p[6] = bflo(a.w); p[7] = bfhi(a.w);
      p[8] = bflo(c.x); p[9] = bfhi(c.x); p[10] = bflo(c.y); p[11] = bfhi(c.y); p[12] = bflo(c.z); p[13] = bfhi(c.z); p[14] = bflo(c.w); p[15] = bfhi(c.w);
      if (tid < 128) { const int qi2 = tid >> 2, r2 = tid & 3; const float* gl = GLDT + (size_t)(b * SEQ + t0 + qi2) * 32 + (g * 4 + r2) * 3;
          GT[tid * 3 + 0] = sigmoid_f(gl[0]); GT[tid * 3 + 1] = sigmoid_f(gl[1]); GT[tid * 3 + 2] = sigmoid_f(gl[2]); } }
    const LAS float* krow = KT + lane * 65;
    {
        at_load_tile_f32(KT, 65, KCB + (size_t)(bg * 128) * 64, tid); at_load_tile_f32(VT, 64, KCB + (size_t)(2048 + bg * 128) * 64, tid); at_load_tile_f32(VT1, 64, KCB + (size_t)(2048 + bg * 128 + 64) * 64, tid);
        __syncthreads();
#pragma unroll 1
        for (int i = 0; i < 16; ++i) {
            const int t = t0 + 4 * w + (i >> 2); const float slope = exp2f(-(float)(4 * g + (i & 3) + 1)); const int dc0 = t - (16 * lane + 31);
            const float d0 = at_dot(QS + (16 * w + i) * 64, krow); FIN[i * 64 + lane] = dc0 >= 0 ? d0 - slope * (float)dc0 : NEGF; }
        __syncthreads();
        at_load_tile_f32(KT, 65, KCB + (size_t)(bg * 128 + 64) * 64, tid);
        __syncthreads();
        float ps0 = 0.f, ps1 = 0.f;
#pragma unroll 1
        for (int i = 0; i < 16; ++i) {
            const int ql = i >> 2, r = i & 3, t = t0 + 4 * w + ql; const float slope = exp2f(-(float)(4 * g + r + 1));
            const LAS float* q = QS + (16 * w + i) * 64;
            const int dc0 = t - (16 * lane + 31), c1 = 64 + lane, dc1 = t - (16 * c1 + 31);
            const bool v0 = dc0 >= 0, v1 = dc1 >= 0 && c1 <= 126;
            const float d1 = at_dot(q, krow);
            const float s0 = FIN[i * 64 + lane], s1 = v1 ? d1 - slope * (float)dc1 : NEGF;
            const float m = wave_max(fmaxf(s0, s1));
            const float e0 = v0 ? __expf(s0 - m) : 0.f, e1 = v1 ? __expf(s1 - m) : 0.f;
            const float l = wave_sum(e0 + e1), inv = l > 0.f ? 1.0f / l : 0.f, p0 = e0 * inv, p1 = e1 * inv;
            float o = at_pv(PW, lane, p0, VT); o += at_pv(PW, lane, p1, VT1);
            FIN[i * 64 + lane] = GT[(16 * w + i) * 3 + 0] * o;
            if (r == 0) { ps0 = 0.f; ps1 = 0.f; }
            ps0 += p0; ps1 += p1;
            if (r == 3) {
                volatile LAS float* ps = OR;
                ps[lane] = ps0; ps[64 + lane] = ps1; LDS_WAIT();
                const int j = lane & 31;
                float imp = ps[4 * j] + ps[4 * j + 1] + ps[4 * j + 2] + 0.5f * ps[4 * j + 3] + (j > 0 ? 0.5f * ps[4 * j - 1] : 0.f);
                const bool forced = (j == 0) || (j == cur) || (j == cur - 1); if (forced) imp += 1e4f;
                const float v = (j <= cur) ? imp : -1.0f;
                int rank = 0;
#pragma unroll 1
                for (int o2 = 0; o2 < 32; ++o2) { const float vo = __shfl(v, o2); rank += (vo > v || (vo == v && o2 < j)) ? 1 : 0; }
                const unsigned long long bal = __ballot(rank < 16 && lane < 32);
                if (lane == 0) SELM[ql] = (unsigned)bal;
                LDS_WAIT();
            }
        }
        __syncthreads();
    }
#pragma unroll 1
    for (int mode = 0; mode < 2; ++mode) {
        const bf16* Kg = KVg + ((size_t)(2 + 2 * mode) << 21) + (size_t)bg * SEQ * 64; const bf16* Vg = KVg + ((size_t)(3 + 2 * mode) << 21) + (size_t)bg * SEQ * 64;
        const int jlo = mode == 0 ? 0 : ((t0 - 511) > 0 ? (t0 - 511) >> 6 : 0);
#pragma unroll 1
        for (int i = 0; i < 16; ++i) { OR[i * 64 + lane] = 0.f; if (lane < 2) ML[i * 2 + lane] = lane == 0 ? NEGF : 0.f; }
        LDS_WAIT();
        const unsigned anymask = mode == 0 ? (SELM[0] | SELM[1] | SELM[2] | SELM[3]) : 0xffffffffu;
#pragma unroll 1
        for (int j = jlo; j <= cur; ++j) {
            at_load_tile_bf16(KT, 65, Kg + (size_t)j * 64 * 64, tid); at_load_tile_bf16(VT, 64, Vg + (size_t)j * 64 * 64, tid);
            __syncthreads();
            if ((anymask >> j) & 1u) {
#pragma unroll 1
                for (int i = 0; i < 16; ++i) { const int ql = i >> 2, t = t0 + 4 * w + ql; const float slope = exp2f(-(float)(4 * g + (i & 3) + 1)); const int dist = t - (64 * j + lane);
                    const bool valid = mode == 0 ? (((SELM[ql] >> j) & 1u) != 0u && dist >= 0) : (dist >= 0 && dist < 512);
                    float s = at_dot(QS + (16 * w + i) * 64, krow); s = valid ? s - slope * (float)dist : NEGF;
                    const float tm = wave_max(s);
                    if (tm > 0.5f * NEGF) { const float mo = ML[i * 2], lo = ML[i * 2 + 1], mn = fmaxf(mo, tm), p = valid ? __expf(s - mn) : 0.f, sc = __expf(mo - mn);
                        const float ln = lo * sc + wave_sum(p); const float on = OR[i * 64 + lane] * sc + at_pv(PW, lane, p, VT);
                        OR[i * 64 + lane] = on; if (lane == 0) { ML[i * 2] = mn; ML[i * 2 + 1] = ln; } LDS_WAIT(); } }
            }
            __syncthreads();
        }
#pragma unroll 1
        for (int i = 0; i < 16; ++i) { const float l = ML[i * 2 + 1]; FIN[i * 64 + lane] += GT[(16 * w + i) * 3 + 1 + mode] * (l > 0.f ? OR[i * 64 + lane] / l : 0.f); }
        LDS_WAIT();
    }
    bf16* O = (bf16*)(F.ws + WS_A);
#pragma unroll 1
    for (int i = 0; i < 16; ++i) { const int t = t0 + 4 * w + (i >> 2), r = i & 3; O[(size_t)(b * SEQ + t) * 1024 + (g * 4 + r) * 64 + lane] = (bf16)f2bf(FIN[i * 64 + lane]); }
}


__device__ __attribute__((noinline)) void attn_phase_simple(unsigned char* ws, int wave, int bid, int G) {
    Frame F; F.lds = (LAS unsigned char*)(uintptr_t)0u; F.ws = ws; F.out = nullptr; F.wave = wave; F.lane = flane(); F.tid = (wave << 6) | F.lane; F.G = G; F.bid = bid;
    for (int it = bid; it < 1024; it += G) attn_item(F, it);
}

constexpr int GM_V = 0, GM_W = 65536, GM_ST = 131072;
__device__ __forceinline__ void gmlp_item(Frame& F, int io, int item) {
    const int tid = F.tid; const int g = item & 7, bc = item >> 3; const size_t row0 = (size_t)bc * 128;
    LAS bf16* Vs = (LAS bf16*)(F.lds + GM_V); LAS float* Wt = (LAS float*)(F.lds + GM_W); LAS float* ST = (LAS float*)(F.lds + GM_ST);
    bf16* U = (bf16*)(F.ws + WS_U); const bf16* V = (const bf16*)(F.ws + WS_V); const float* STg = (const float*)(F.ws + WS_ST);
    const float* lnw = inp(F, I_LNW) + (size_t)io * 2048 + g * 256; const float* lnb = inp(F, I_LNB) + (size_t)io * 2048 + g * 256;
    const float* wsg = inp(F, I_WS) + ((size_t)io * 8 + g) * 128 * 128; const float* bsg = inp(F, I_BS) + ((size_t)io * 8 + g) * 128;
    __syncthreads();
    if (tid < 128) { const float* p = STg + (row0 + tid) * 64; float s = 0.f, ss = 0.f;
        for (int k = 0; k < 32; ++k) { s += p[2 * k]; ss += p[2 * k + 1]; }
        const float mean = s * (1.f / 2048.f), var = ss * (1.f / 2048.f) - mean * mean; ST[2 * tid] = mean; ST[2 * tid + 1] = 1.0f / sqrtf(fmaxf(var, 0.f) + LN_EPS); }
    for (int idx = tid; idx < 128 * 128; idx += 512) { const int t = idx >> 7, s = idx & 127; Wt[s * 128 + t] = (s <= t) ? wsg[idx] : 0.f; }
    __syncthreads();
    for (int idx = tid; idx < 128 * 32; idx += 512) { const int s = idx >> 5, c8 = (idx & 31) * 8; const v4u x = *(const v4u*)(V + (row0 + s) * 2048 + g * 256 + c8);
        const float mean = ST[2 * s], rstd = ST[2 * s + 1]; const float* lw = lnw + c8; const float* lb = lnb + c8;
        float f[8] = {bflo(x.x), bfhi(x.x), bflo(x.y), bfhi(x.y), bflo(x.z), bfhi(x.z), bflo(x.w), bfhi(x.w)};
#pragma unroll
        for (int e = 0; e < 8; ++e) f[e] = (f[e] - mean) * rstd * lw[e] + lb[e];
        *(LAS v4u*)(Vs + s * 256 + c8) = (v4u){pk2(f[0], f[1]), pk2(f[2], f[3]), pk2(f[4], f[5]), pk2(f[6], f[7])}; }
    __syncthreads();
    const int d = tid & 255, th = tid >> 8;
    for (int t4 = th * 64; t4 < th * 64 + 64; t4 += 4) {
        float a0 = 0.f, a1 = 0.f, a2 = 0.f, a3 = 0.f;
        for (int s = 0; s <= t4 + 3; ++s) { const float v = bf2f(Vs[s * 256 + d]); const f32x4 wv = *(const LAS f32x4*)(Wt + s * 128 + t4); a0 += wv.x * v; a1 += wv.y * v; a2 += wv.z * v; a3 += wv.w * v; }
        const float acc[4] = {a0, a1, a2, a3};
#pragma unroll
        for (int e = 0; e < 4; ++e) { const size_t o = (row0 + t4 + e) * 2048 + g * 256 + d; U[o] = (bf16)f2bf(bf2f(U[o]) * (acc[e] + bsg[t4 + e])); }
    }
}

enum Kind { K_PREP = 0, K_G1, K_E3, K_E4, K_E5, K_GY, K_RP, K_G3, K_G5, K_O2 };
constexpr int N_PHASES = 33;
struct Args { const float* in[22]; float* out; unsigned char* ws; int ph_lo, ph_hi; };

__global__ void __launch_bounds__(NWAVES * 64, 2) mk_fwd(Args args) {
    extern __shared__ __attribute__((aligned(16))) unsigned char lds_raw[];
    Frame F;
    F.lds = (LAS unsigned char*)(uintptr_t)0u  ; F.ws = args.ws; F.out = args.out;
    F.wave = __builtin_amdgcn_readfirstlane(threadIdx.x >> 6); F.G = gridDim.x; F.bid = blockIdx.x;
    volatile LAS unsigned* MISC = (volatile LAS unsigned*)((LAS unsigned char*)lds_raw + MISC_OFF);
    { const int t0 = threadIdx.x; if (t0 < 32) MISC[t0] = 0u;
      if (t0 >= 64 && t0 < 64 + 22) { const unsigned long long pv = (unsigned long long)args.in[t0 - 64]; MISC[32 + 2 * (t0 - 64)] = (unsigned)pv; MISC[33 + 2 * (t0 - 64)] = (unsigned)(pv >> 32); } }
    __syncthreads();
    const int wave0 = __builtin_amdgcn_readfirstlane(threadIdx.x >> 6);
    XcdBarrier bar = xcd_barrier_post((unsigned*)(F.ws + WS_CTL) + CW_BAR, MISC + 8);

    for (int p = args.ph_lo; p < args.ph_hi; ++p) {
        int L = 0, k = 0, kind = K_PREP, var = 0;
        if (p > 0) { const int q = p - 1; if (q < 9) { L = 0; k = q; } else if (q < 16) { L = 1; k = q - 9; } else if (q < 25) { L = 2; k = q - 16; } else { L = 3; k = q - 25; }
            if ((L & 1) == 0) { kind = (int)((0x657654321ull >> (4 * k)) & 15ull); var = (int)((0x110000000ull >> (4 * k)) & 15ull); }
            else { kind = (int)((0x6576598ull >> (4 * k)) & 15ull); var = (int)((0x1102200ull >> (4 * k)) & 15ull); } }
        { unsigned long long wsv = (unsigned long long)args.ws, outv = (unsigned long long)args.out; int wv = wave0, bidv = blockIdx.x, gv = gridDim.x;
          asm volatile("" : "+s"(wsv), "+s"(outv), "+s"(bidv), "+s"(gv), "+s"(wv));
          int tidv = (wv << 6) | flane(); asm volatile("" : "+v"(tidv));
          F.ws = (unsigned char*)wsv; F.out = (float*)outv; F.tid = tidv; F.lane = tidv & 63; F.wave = wv; F.G = gv; F.bid = bidv; }
        const int ie = L >> 1;
        unsigned char* wev = F.ws + WS_WEV + (size_t)ie * WEV_STRIDE; unsigned char* wod = F.ws + WS_WOD + (size_t)ie * WOD_STRIDE; unsigned char* wff = F.ws + WS_WFFN + (size_t)L * WFFN_STRIDE;
        switch (kind) {
        case K_PREP:
#ifndef NO_P0
            p0_prologue(F);
#endif
            break;
        case K_G1: {
#ifndef NO_K_G1
            pg8::Gemm g{(const bf16*)(F.ws + WS_A), (const bf16*)wev, M, EV_IN_PAD, D, D}; pg8::StaticOrder S; S.init(M, EV_IN_PAD, F.G, F.bid);
            pg8::EpiProj E{(bf16*)(F.ws + WS_Q), (bf16*)(F.ws + WS_KV), (bf16*)(F.ws + WS_Z), (bf16*)(F.ws + WS_XBC), (float*)(F.ws + WS_GLDT)};
            pg8::gemm_phase<pg8::EpiProj, pg8::StaticOrder, true, true>(F.lds, g, S, E, F.tid);
#endif
            } break;
        case K_E3: {
#ifndef NO_K_E3
            pg8::Gemm g{(const bf16*)(F.ws + WS_KV), (const bf16*)(wev + 8 * MiB), 4096, 512, 2048, 1024}; pg8::CmpOrder S{F.bid};
            pg8::EpiCmp E{(bf16*)(F.ws + WS_H1), (const float*)(F.ws + WS_SMALL) + ie * 512};
            pg8::gemm_phase<pg8::EpiCmp, pg8::CmpOrder, true, true>(F.lds, g, S, E, F.tid);
            for (int it = F.bid; it < 256; it += F.G) ssm_s1_item(F, ie, it);
#endif
            } break;
        case K_E4:
#ifndef NO_E4
            compress2(F, ie, 0);
#endif
            break;
        case K_E5: {
#ifndef NO_S3
            for (int it = F.bid; it < 256; it += F.G) ssm_s3_item(F, it);
#endif
#ifndef NO_E5
            for (int it = F.bid; it < 1024; it += F.G) attn_item(F, it);
#endif
            } break;
        case K_GY: {
#ifndef NO_K_GY
            const bf16* A = var == 0 ? (const bf16*)(F.ws + WS_A) : var == 1 ? (const bf16*)(F.ws + WS_T) : (const bf16*)(F.ws + WS_U);
            const bf16* W = var == 0 ? (const bf16*)(wev + 6 * MiB) : var == 1 ? (const bf16*)(wff + (size_t)5632 * 1024 * 2) : (const bf16*)(wod + 8 * MiB);
            const int K = var == 0 ? 1024 : var == 1 ? FFH : 2048; bf16* Y = (bf16*)(F.ws + (var == 0 ? WS_YEV : var == 1 ? WS_YFF : WS_YOD));
            pg8::Gemm g{A, W, M, D, K, K}; pg8::StaticOrder S; S.init(M, D, F.G, F.bid); pg8::EpiBf16Plain E{Y, D};
            pg8::gemm_phase<pg8::EpiBf16Plain, pg8::StaticOrder, true, true>(F.lds, g, S, E, F.tid);
#endif
            } break;
        case K_RP: {
            const bf16* Y = (const bf16*)(F.ws + (var == 0 ? WS_YEV : var == 1 ? WS_YFF : WS_YOD)); const bool mixer = (var != 1);
            const float* hin = (L == 0 && mixer) ? inp(F, I_X) : F.out; bf16* aout = (L == DEPTH - 1 && !mixer) ? nullptr : (bf16*)(F.ws + WS_A);
            rowpass(F, Y, hin, F.out, aout, inp(F, I_GAINS) + (L * 4 + (mixer ? 1 : 3)) * D); } break;
        case K_G3: {
#ifndef NO_K_G3
            pg8::Gemm g{(const bf16*)(F.ws + WS_A), (const bf16*)wff, M, 2 * FFH, D, D}; pg8::StaticOrder S; S.init(M, 2 * FFH, F.G, F.bid);
            pg8::EpiSwiGLU E{(bf16*)(F.ws + WS_T), FFH};
            pg8::gemm_phase<pg8::EpiSwiGLU, pg8::StaticOrder, true, true>(F.lds, g, S, E, F.tid);
#endif
            } break;
        case K_G5: {
#ifndef NO_K_G5
            pg8::Gemm g{(const bf16*)(F.ws + WS_A), (const bf16*)wod, M, 4096, D, D}; pg8::StaticOrder S; S.init(M, 4096, F.G, F.bid);
            pg8::EpiGelu E{(bf16*)(F.ws + WS_U), (bf16*)(F.ws + WS_V), (float*)(F.ws + WS_ST)};
            pg8::gemm_phase<pg8::EpiGelu, pg8::StaticOrder, true, true>(F.lds, g, S, E, F.tid);
#endif
            } break;
        case K_O2: {
#ifndef NO_O2
            for (int it = F.bid; it < 1024; it += F.G) gmlp_item(F, ie, it);
#endif
            } break;
        default: break;
        }
        if (p + 1 < args.ph_hi) xcd_barrier(bar, F.wave);
    }
}

#ifndef MK_PER_PHASE
#define MK_PER_PHASE 0
#endif
extern "C" void kernel_launch(void* const* d_in, const int* in_sizes, int n_in, void* d_out, int out_size, void* d_ws, size_t ws_size, hipStream_t stream) {
    static int grid = 0;
    if (grid == 0) {
        if (n_in != 22 || in_sizes[0] != M * D || out_size != M * D || ws_size < WS_END) { fprintf(stderr, "kernel_launch: unexpected shapes (n_in %d, in0 %d, out %d, ws %zu)\n", n_in, n_in > 0 ? in_sizes[0] : -1, out_size, ws_size); grid = -1; return; }
        int dev = 0, cus = 0, per_cu = 0;
        if (hipGetDevice(&dev) != hipSuccess || hipDeviceGetAttribute(&cus, hipDeviceAttributeMultiprocessorCount, dev) != hipSuccess) { grid = -1; return; }
        if (hipFuncSetAttribute((const void*)mk_fwd, hipFuncAttributeMaxDynamicSharedMemorySize, LDS_BYTES) != hipSuccess) { fprintf(stderr, "kernel_launch: hipFuncSetAttribute failed\n"); grid = -1; return; }
        if (hipOccupancyMaxActiveBlocksPerMultiprocessor(&per_cu, (const void*)mk_fwd, NWAVES * 64, LDS_BYTES) != hipSuccess || per_cu < 1) { fprintf(stderr, "kernel_launch: occupancy query says %d\n", per_cu); per_cu = 1; }
        (void)hipGetLastError();
        grid = cus;
        if (grid != 256) fprintf(stderr, "kernel_launch: %d CUs (built for 256)\n", grid);
    }
    if (grid < 0) return;
    Args a{};
    for (int i = 0; i < 22; ++i) a.in[i] = (const float*)d_in[i];
    a.out = (float*)d_out; a.ws = (unsigned char*)d_ws;
#if MK_PER_PHASE
    for (int p = 0; p < N_PHASES; ++p) { a.ph_lo = p; a.ph_hi = p + 1; hipLaunchKernelGGL(mk_fwd, dim3(grid), dim3(NWAVES * 64), LDS_BYTES, stream, a); }
#else
    (void)hipMemsetAsync((char*)d_ws + WS_CTL, 0, CTL_ZERO_BYTES, stream);
    a.ph_lo = 0; a.ph_hi = N_PHASES;
    hipLaunchKernelGGL(mk_fwd, dim3(grid), dim3(NWAVES * 64), LDS_BYTES, stream, a);
#endif
}
```

```cpp
#include <hip/hip_runtime.h>
#include <cstdio>
#include <cstdint>

namespace pg8 {
#define PG8_LAS __attribute__((address_space(3)))
typedef unsigned short bf16_t;
typedef short bf16x8 __attribute__((ext_vector_type(8)));
typedef float f32x4 __attribute__((ext_vector_type(4)));
typedef unsigned u32x4 __attribute__((ext_vector_type(4)));
typedef float f32x2 __attribute__((ext_vector_type(2)));
constexpr int BM = 256, BK = 64, HALF = 128, HTB = HALF * BK * 2  , STAGE_BYTES = 8 * HTB, NXCD = 8, WGM = 8;

__host__ __device__ __forceinline__ int lds_byte(int r, int c) { const int st = (r >> 4) * 2 + (c >> 5), rr = r & 15, cc = c & 31, ob = rr * 64 + cc * 2; return st * 1024 + (ob ^ (((ob >> 9) & 1) << 5)); }
__host__ __device__ __forceinline__ void stage_rc(int b, int& R, int& C) { const int st = b / 1024, sb = b % 1024, swz = sb ^ (((sb >> 9) & 1) << 5); R = (st >> 1) * 16 + swz / 64; C = (st & 1) * 32 + (swz % 64) / 2; }
__host__ __device__ __forceinline__ int perm32(int rho) { const int n = rho >> 4, i = rho & 15; return 8 * (i >> 2) + 4 * n + (i & 3); }

struct Unit { int pm, pn; };
struct Gemm { const bf16_t* A; const bf16_t* Bt; int M, N, K, lda; };

struct StaticOrder {
    int nM, nN, nwg, G, c;
    __host__ __device__ void init(int M, int N, int G_, int c_) { nM = M / BM; nN = N / BM; nwg = nM * nN; G = G_; c = c_; }
    __host__ __device__ bool next(int i, Unit& u) const {
        const long L = (long)i * G + c; if (L >= nwg) return false;
        int wgid = (int)L; { const int q = nwg / NXCD, r = nwg % NXCD, xcd = wgid % NXCD, off = wgid / NXCD; wgid = (xcd < r ? xcd * (q + 1) : r * (q + 1) + (xcd - r) * q) + off; }
        const int nig = WGM * nN, gid = wgid / nig, fm = gid * WGM, gsz = (nM - fm) < WGM ? (nM - fm) : WGM;
        u.pm = fm + ((wgid % nig) % gsz); u.pn = (wgid % nig) / gsz; return true;
    }
    __device__ __forceinline__ void a_ready(const Unit&) const {}
    __device__ __forceinline__ void done(const Unit&) const {}
};
struct CmpOrder {
    int c;
    __device__ bool next(int i, Unit& u) const { if (i > 0 || c >= 16) return false; u.pm = c; u.pn = c >> 3; return true; }
    __device__ __forceinline__ void a_ready(const Unit&) const {}
    __device__ __forceinline__ void done(const Unit&) const {}
};

__device__ __forceinline__ unsigned cvt_pk_bf16(float lo, float hi) { unsigned r; asm volatile("v_cvt_pk_bf16_f32 %0, %1, %2" : "=v"(r) : "v"(lo), "v"(hi)); return r; }
__device__ __forceinline__ f32x2 gelu_pk(f32x2 v) {
    const f32x2 av = __builtin_elementwise_abs(v), d = av * 0.2316418882f + 1.0f;
    f32x2 t; t.x = __builtin_amdgcn_rcpf(d.x); t.y = __builtin_amdgcn_rcpf(d.y);
    f32x2 q = t * 0.5307027145f + (-0.7265760135f); q = q * t + 0.7107068705f; q = q * t + (-0.142248368f); q = q * t + 0.127414796f; q = q * t;
    const f32x2 s = (v * v) * (-0.72134752044f);
    f32x2 e; e.x = __builtin_amdgcn_exp2f(s.x); e.y = __builtin_amdgcn_exp2f(s.y);
    const f32x2 m = v * (q * e), r = v - m;
    f32x2 o; o.x = v.x < 0.f ? m.x : r.x; o.y = v.y < 0.f ? m.y : r.y; return o;
}
__device__ __forceinline__ float silu_f(float x) { return x * __builtin_amdgcn_rcpf(1.0f + __builtin_amdgcn_exp2f(-1.4426950408889634f * x)); }
__device__ __forceinline__ u32x4 pack8(const f32x4 v0, const f32x4 v1) { u32x4 w; w.x = cvt_pk_bf16(v0[0], v0[1]); w.y = cvt_pk_bf16(v0[2], v0[3]); w.z = cvt_pk_bf16(v1[0], v1[1]); w.w = cvt_pk_bf16(v1[2], v1[3]); return w; }

struct EpiBf16Plain {
    static constexpr bool PERM = true, AFTER_DRAIN = false;
    bf16_t* O; int ldc;
    __device__ __forceinline__ void operator()(const f32x4 (&acc)[2][2][4][2], const Unit& u, int wr, int wc, int fr, int fq) const {
        const int row0 = u.pm * BM + wr * 64 + fr, col0 = u.pn * BM + wc * 32 + 8 * fq;
#pragma unroll
        for (int ai = 0; ai < 2; ++ai)
#pragma unroll
            for (int m = 0; m < 4; ++m) { bf16_t* rowp = O + (size_t)(row0 + ai * HALF + m * 16) * ldc + col0;
#pragma unroll
                for (int bj = 0; bj < 2; ++bj) *(u32x4*)(rowp + bj * HALF) = pack8(acc[ai][bj][m][0], acc[ai][bj][m][1]); }
    }
};
struct EpiProj {
    static constexpr bool PERM = true, AFTER_DRAIN = false;
    bf16_t* Q; bf16_t* KV; bf16_t* Z; bf16_t* XBC; float* GLDT;
    __device__ __forceinline__ void operator()(const f32x4 (&acc)[2][2][4][2], const Unit& u, int wr, int wc, int fr, int fq) const {
        const int row0 = u.pm * BM + wr * 64 + fr, pn = u.pn, cl = wc * 32 + 8 * fq;
        if (pn == 11) {
            if (wc == 0) {
#pragma unroll
                for (int ai = 0; ai < 2; ++ai)
#pragma unroll
                    for (int m = 0; m < 4; ++m) { float* rowp = GLDT + (size_t)(row0 + ai * HALF + m * 16) * 32 + 8 * fq;
                        *(f32x4*)(rowp) = acc[ai][0][m][0]; *(f32x4*)(rowp + 4) = acc[ai][0][m][1]; }
            }
            return;
        }
        bf16_t* base0; int stride, laneoff, halfstep;
        if (pn < 2) { base0 = Q + pn * 256; stride = 512; laneoff = cl; halfstep = HALF; }
        else if (pn < 5) { const int b = (u.pm * BM) >> 11; base0 = KV + ((size_t)((pn - 2) * 2) << 21) + (size_t)b * 131072; stride = 64; laneoff = (wc >> 1) * 131072 + (wc & 1) * 32 + 8 * fq; halfstep = 1 << 21; }
        else if (pn < 7) { base0 = Z + (pn - 5) * 256; stride = 512; laneoff = cl; halfstep = HALF; }
        else { base0 = XBC + (pn - 7) * 256; stride = 1024; laneoff = cl; halfstep = HALF; }
        const unsigned off0 = (unsigned)(row0 * stride + laneoff);
#pragma unroll
        for (int ai = 0; ai < 2; ++ai)
#pragma unroll
            for (int m = 0; m < 4; ++m) {
                const unsigned off = off0 + (unsigned)((ai * HALF + m * 16) * stride);
                *(u32x4*)(base0 + off) = pack8(acc[ai][0][m][0], acc[ai][0][m][1]);
                *(u32x4*)(base0 + halfstep + off) = pack8(acc[ai][1][m][0], acc[ai][1][m][1]);
                asm volatile("" ::: "memory");
            }
    }
};
struct EpiSwiGLU {
    static constexpr bool PERM = true, AFTER_DRAIN = false;
    bf16_t* T; int ldc;
    __device__ __forceinline__ void operator()(const f32x4 (&acc)[2][2][4][2], const Unit& u, int wr, int wc, int fr, int fq) const {
        const int row0 = u.pm * BM + wr * 64 + fr, col0 = u.pn * HALF + wc * 32 + 8 * fq;
#pragma unroll
        for (int ai = 0; ai < 2; ++ai)
#pragma unroll
            for (int m = 0; m < 4; ++m) {
                f32x4 v0, v1;
#pragma unroll
                for (int j = 0; j < 4; ++j) { v0[j] = silu_f(acc[ai][0][m][0][j]) * acc[ai][1][m][0][j]; v1[j] = silu_f(acc[ai][0][m][1][j]) * acc[ai][1][m][1][j]; }
                *(u32x4*)(T + (size_t)(row0 + ai * HALF + m * 16) * ldc + col0) = pack8(v0, v1);
            }
    }
};
struct EpiGelu {
    static constexpr bool PERM = true, AFTER_DRAIN = false;
    bf16_t* U; bf16_t* V; float* ST;
    __device__ __forceinline__ void operator()(const f32x4 (&acc)[2][2][4][2], const Unit& u, int wr, int wc, int fr, int fq) const {
        const int row0 = u.pm * BM + wr * 64 + fr, pn = u.pn;
        const bool isv = pn >= 8; bf16_t* base = isv ? V : U; const int col0 = (isv ? pn - 8 : pn) * BM + wc * 32 + 8 * fq;
#pragma unroll
        for (int ai = 0; ai < 2; ++ai)
#pragma unroll
            for (int m = 0; m < 4; ++m) {
                const int row = row0 + ai * HALF + m * 16; float s = 0.f, ss = 0.f;
#pragma unroll
                for (int bj = 0; bj < 2; ++bj) {
                    const f32x4 x0 = acc[ai][bj][m][0], x1 = acc[ai][bj][m][1];
                    const f32x2 a = gelu_pk((f32x2){x0[0], x0[1]}), b = gelu_pk((f32x2){x0[2], x0[3]}), c = gelu_pk((f32x2){x1[0], x1[1]}), d = gelu_pk((f32x2){x1[2], x1[3]});
                    s += (a.x + a.y) + (b.x + b.y) + (c.x + c.y) + (d.x + d.y);
                    ss += (a.x * a.x + a.y * a.y) + (b.x * b.x + b.y * b.y) + (c.x * c.x + c.y * c.y) + (d.x * d.x + d.y * d.y);
                    *(u32x4*)(base + (size_t)row * 2048 + col0 + bj * HALF) = pack8((f32x4){a.x, a.y, b.x, b.y}, (f32x4){c.x, c.y, d.x, d.y});
                }
                if (isv) {
                    s += __shfl_xor(s, 16); s += __shfl_xor(s, 32); ss += __shfl_xor(ss, 16); ss += __shfl_xor(ss, 32);
                    if (fq == 0) *(f32x2*)(ST + ((size_t)row * 32 + (pn - 8) * 4 + wc) * 2) = (f32x2){s, ss};
                }
            }
    }
};
struct EpiCmp {
    static constexpr bool PERM = true, AFTER_DRAIN = false;
    bf16_t* H1; const float* bias;
    __device__ __forceinline__ void operator()(const f32x4 (&acc)[2][2][4][2], const Unit& u, int wr, int wc, int fr, int fq) const {
        const int row0 = u.pm * BM + wr * 64 + fr, cl = wc * 32 + 8 * fq; const float* bs = bias + u.pn * 256;
#pragma unroll
        for (int bj = 0; bj < 2; ++bj) {
            const f32x4 b0 = *(const f32x4*)(bs + bj * HALF + cl), b1 = *(const f32x4*)(bs + bj * HALF + cl + 4);
#pragma unroll
            for (int ai = 0; ai < 2; ++ai)
#pragma unroll
                for (int m = 0; m < 4; ++m) {
                    f32x4 v0 = acc[ai][bj][m][0] + b0, v1 = acc[ai][bj][m][1] + b1;
#pragma unroll
                    for (int j = 0; j < 4; ++j) { v0[j] = silu_f(v0[j]); v1[j] = silu_f(v1[j]); }
                    *(u32x4*)(H1 + (size_t)(row0 + ai * HALF + m * 16) * 256 + bj * HALF + cl) = pack8(v0, v1);
                }
        }
    }
};

template <class Epi, class Sched, bool ALIGN_EPI = false, bool SP2 = false>
__device__ __forceinline__ void gemm_phase(PG8_LAS unsigned char* lds, const Gemm g, const Sched& S, const Epi& E, const int tid) {
    const int wid = __builtin_amdgcn_readfirstlane(tid >> 6), lane = tid & 63, wr = wid >> 2, wc = wid & 3, fr = lane & 15, fq = lane >> 4;
    const int K = g.K, nt = K / BK;
    unsigned voffA[2], voffB[2];
#pragma unroll
    for (int i = 0; i < 2; ++i) { int R, C; stage_rc(tid * 16 + i * 8192, R, C); const int Rb = Epi::PERM ? ((R & ~31) + perm32(R & 31)) : R;
        voffA[i] = (unsigned)(R * g.lda + C) * 2u; voffB[i] = (unsigned)(Rb * K + C) * 2u; }
    const size_t kstep = (size_t)(BK * 2);
    const size_t hstepB = (size_t)HALF * K * 2, hstepA = (size_t)HALF * g.lda * 2;
    const size_t tstepA = 2 * hstepA, tstepB = 2 * hstepB;
    const unsigned ldsw = (unsigned)wid * 1024u;
    const int aoff = lds_byte(wr * 64 + fr, fq * 8), boff = lds_byte(wc * 32 + fr, fq * 8);
#define PG8_SA(b, h) (((b) * 2 + (h)) * HTB)
#define PG8_SB(b, h) ((4 + (b) * 2 + (h)) * HTB)
#define PG8_STAGE(bufoff, gbase, voff) do { _Pragma("unroll") for (int _i = 0; _i < 2; ++_i) \
        __builtin_amdgcn_global_load_lds((const unsigned*)((const char*)(gbase) + (voff)[_i]), (PG8_LAS unsigned*)(lds + (bufoff) + ldsw + _i * 8192), 16, 0, 0); } while (0)
#define PG8_LDA(dst, b, h) do { _Pragma("unroll") for (int m = 0; m < 4; ++m) _Pragma("unroll") for (int k = 0; k < 2; ++k) dst[m][k] = *(const PG8_LAS bf16x8*)(lds + PG8_SA(b, h) + aoff + m * 2048 + k * 1024); } while (0)
#define PG8_LDB(dst, b, h) do { _Pragma("unroll") for (int n = 0; n < 2; ++n) _Pragma("unroll") for (int k = 0; k < 2; ++k) dst[n][k] = *(const PG8_LAS bf16x8*)(lds + PG8_SB(b, h) + boff + n * 2048 + k * 1024); } while (0)
#define PG8_MMA(ai, bj, At, Bt) do { __builtin_amdgcn_s_setprio(1); _Pragma("unroll") for (int m = 0; m < 4; ++m) _Pragma("unroll") for (int n = 0; n < 2; ++n) _Pragma("unroll") for (int k = 0; k < 2; ++k) \
        acc[ai][bj][m][n] = __builtin_amdgcn_mfma_f32_16x16x32_bf16(Bt[n][k], At[m][k], acc[ai][bj][m][n], 0, 0, 0); __builtin_amdgcn_s_setprio(0); } while (0)
#define PG8_WAIT_V(n) asm volatile("s_waitcnt vmcnt(" #n ")" ::: "memory")
#define PG8_WAIT_L(n) asm volatile("s_waitcnt lgkmcnt(" #n ")" ::: "memory")
#define PG8_BAR __builtin_amdgcn_s_barrier()
#define PG8_SCHED __builtin_amdgcn_sched_barrier(0)
    Unit cur, nxt; int ui = 0;
    if (!S.next(0, cur)) return;
    f32x4 acc[2][2][4][2];
#pragma unroll
    for (int a = 0; a < 2; ++a)
#pragma unroll
        for (int b = 0; b < 2; ++b)
#pragma unroll
            for (int m = 0; m < 4; ++m)
#pragma unroll
                for (int n = 0; n < 2; ++n) acc[a][b][m][n] = (f32x4){0.f, 0.f, 0.f, 0.f};
    bf16x8 At[4][2], B0[2][2], B1[2][2];
    const char* cA = (const char*)g.A + (size_t)cur.pm * tstepA; const char* cB = (const char*)g.Bt + (size_t)cur.pn * tstepB;
    S.a_ready(cur);
    if constexpr (SP2) {
        PG8_STAGE(PG8_SB(0, 0), cB, voffB); PG8_STAGE(PG8_SB(0, 1), cB + hstepB, voffB); PG8_STAGE(PG8_SA(0, 0), cA, voffA); PG8_STAGE(PG8_SA(0, 1), cA + hstepA, voffA);
        if (wr == 1) PG8_BAR;
        PG8_WAIT_V(2); PG8_BAR;
        PG8_STAGE(PG8_SB(1, 0), cB + kstep, voffB); PG8_STAGE(PG8_SA(1, 0), cA + kstep, voffA); PG8_STAGE(PG8_SB(1, 1), cB + hstepB + kstep, voffB);
        PG8_WAIT_V(6); PG8_BAR;
    } else {
        PG8_STAGE(PG8_SB(0, 0), cB, voffB); PG8_STAGE(PG8_SA(0, 0), cA, voffA); PG8_STAGE(PG8_SB(0, 1), cB + hstepB, voffB); PG8_STAGE(PG8_SA(0, 1), cA + hstepA, voffA);
        if (wr == 1) PG8_BAR;
        PG8_WAIT_V(4); PG8_BAR;
        PG8_STAGE(PG8_SB(1, 0), cB + kstep, voffB); PG8_STAGE(PG8_SA(1, 0), cA + kstep, voffA); PG8_STAGE(PG8_SB(1, 1), cB + hstepB + kstep, voffB);
        PG8_WAIT_V(6); PG8_BAR;
    }
    for (;;) {
        const bool has_next = S.next(ui + 1, nxt);
        const char* nA = has_next ? (const char*)g.A + (size_t)nxt.pm * tstepA : cA; const char* nB = has_next ? (const char*)g.Bt + (size_t)nxt.pn * tstepB : cB;
        for (int t = 0; t < nt; t += 2) {
            const bool last = (t == nt - 2);
            const char* a1 = cA + (size_t)(t + 1) * kstep;
            const char* a2 = last ? nA : cA + (size_t)(t + 2) * kstep; const char* b2 = last ? nB : cB + (size_t)(t + 2) * kstep;
            const char* a3 = a2 + kstep; const char* b3 = b2 + kstep;
            if (last && has_next) S.a_ready(nxt);
            if constexpr (SP2) {
            PG8_LDB(B0, 0, 0); PG8_LDB(B1, 0, 1); PG8_SCHED; PG8_LDA(At, 0, 0); PG8_STAGE(PG8_SA(1, 1), a1 + hstepA, voffA);
            PG8_WAIT_V(8); PG8_WAIT_L(0); PG8_BAR; PG8_MMA(0, 0, At, B0); PG8_MMA(0, 1, At, B1); PG8_BAR; PG8_SCHED;
            PG8_LDA(At, 0, 1); PG8_STAGE(PG8_SB(0, 0), b2, voffB); PG8_STAGE(PG8_SB(0, 1), b2 + hstepB, voffB); PG8_STAGE(PG8_SA(0, 0), a2, voffA);
            PG8_WAIT_V(8); PG8_WAIT_L(0); PG8_BAR; PG8_MMA(1, 0, At, B0); PG8_MMA(1, 1, At, B1); PG8_BAR; PG8_SCHED;
            PG8_LDB(B0, 1, 0); PG8_LDB(B1, 1, 1); PG8_SCHED; PG8_LDA(At, 1, 0); PG8_STAGE(PG8_SA(0, 1), a2 + hstepA, voffA);
            PG8_WAIT_V(8); PG8_WAIT_L(0); PG8_BAR; PG8_MMA(0, 0, At, B0); PG8_MMA(0, 1, At, B1); PG8_BAR; PG8_SCHED;
            PG8_LDA(At, 1, 1); PG8_STAGE(PG8_SB(1, 0), b3, voffB); PG8_STAGE(PG8_SB(1, 1), b3 + hstepB, voffB); PG8_STAGE(PG8_SA(1, 0), a3, voffA);
            PG8_WAIT_V(8); PG8_WAIT_L(0); PG8_BAR; PG8_MMA(1, 0, At, B0); PG8_MMA(1, 1, At, B1); PG8_BAR; PG8_SCHED;
            } else {
            PG8_LDB(B0, 0, 0); PG8_SCHED; PG8_LDA(At, 0, 0); PG8_STAGE(PG8_SA(1, 1), a1 + hstepA, voffA);
            PG8_WAIT_L(8); PG8_BAR; PG8_WAIT_L(0); PG8_MMA(0, 0, At, B0); PG8_BAR; PG8_SCHED;
            PG8_LDB(B1, 0, 1); PG8_STAGE(PG8_SB(0, 0), b2, voffB);
            PG8_BAR; PG8_WAIT_L(0); PG8_MMA(0, 1, At, B1); PG8_BAR;
            PG8_LDA(At, 0, 1); PG8_STAGE(PG8_SA(0, 0), a2, voffA);
            PG8_BAR; PG8_WAIT_L(0); PG8_MMA(1, 0, At, B0); PG8_BAR; PG8_SCHED;
            PG8_STAGE(PG8_SB(0, 1), b2 + hstepB, voffB);
            PG8_WAIT_V(6); PG8_BAR; PG8_MMA(1, 1, At, B1); PG8_BAR;
            PG8_LDB(B0, 1, 0); PG8_SCHED; PG8_LDA(At, 1, 0); PG8_STAGE(PG8_SA(0, 1), a2 + hstepA, voffA);
            PG8_WAIT_L(8); PG8_BAR; PG8_WAIT_L(0); PG8_MMA(0, 0, At, B0); PG8_BAR; PG8_SCHED;
            PG8_LDB(B1, 1, 1); PG8_STAGE(PG8_SB(1, 0), b3, voffB);
            PG8_BAR; PG8_WAIT_L(0); PG8_MMA(0, 1, At, B1); PG8_BAR;
            PG8_LDA(At, 1, 1); PG8_STAGE(PG8_SA(1, 0), a3, voffA);
            PG8_BAR; PG8_WAIT_L(0); PG8_MMA(1, 0, At, B0); PG8_BAR; PG8_SCHED;
            PG8_STAGE(PG8_SB(1, 1), b3 + hstepB, voffB);
            PG8_WAIT_V(6); PG8_BAR; PG8_MMA(1, 1, At, B1); PG8_BAR;
            }
        }
        if constexpr (ALIGN_EPI) { if (wr == 0) PG8_BAR; }
        if constexpr (!Epi::AFTER_DRAIN) { E(acc, cur, wr, wc, fr, fq); S.done(cur); }
        if (!has_next) break;
#pragma unroll
        for (int a = 0; a < 2; ++a)
#pragma unroll
            for (int b = 0; b < 2; ++b)
#pragma unroll
                for (int m = 0; m < 4; ++m)
#pragma unroll
                    for (int n = 0; n < 2; ++n) acc[a][b][m][n] = (f32x4){0.f, 0.f, 0.f, 0.f};
        cur = nxt; cA = nA; cB = nB; ++ui;
        if constexpr (ALIGN_EPI) { if (wr == 1) PG8_BAR; }
    }
    PG8_WAIT_V(0);
    if constexpr (!ALIGN_EPI) { if (wr == 0) PG8_BAR; }
    PG8_BAR;
    if constexpr (Epi::AFTER_DRAIN) { E.fused(acc, cur, wr, wc, fr, fq, lds, wid, lane); S.done(cur); }
#undef PG8_SA
#undef PG8_SB
#undef PG8_STAGE
#undef PG8_LDA
#undef PG8_LDB
#undef PG8_MMA
#undef PG8_WAIT_V
#undef PG8_WAIT_L
#undef PG8_BAR
#undef PG8_SCHED
}
}

constexpr int NWAVES = 8;
constexpr int BATCH = 8, SEQ = 2048, D = 1024, M = BATCH * SEQ, FFH = 2816, DEPTH = 4;
constexpr int EV_IN = 2848, EV_IN_PAD = 3072;
constexpr float RMS_EPS = 1e-6f, LN_EPS = 1e-5f;

constexpr size_t MiB = 1u << 20;
constexpr size_t WS_CTL = 0, CTL_ZERO_BYTES = 64 * 1024;
constexpr size_t WS_SMALL = 1 * MiB;
constexpr size_t WS_WFFN = 2 * MiB, WFFN_STRIDE = 17301504;
constexpr size_t WS_WEV = 68 * MiB, WEV_STRIDE = 10 * MiB;
constexpr size_t WS_WOD = 88 * MiB, WOD_STRIDE = 12 * MiB;
constexpr size_t WS_A = 112 * MiB;
constexpr size_t WS_BIG = 144 * MiB;
constexpr size_t WS_Q = WS_BIG, WS_KV = WS_BIG + 16 * MiB, WS_Z = WS_BIG + 40 * MiB, WS_XBC = WS_BIG + 56 * MiB, WS_GLDT = WS_BIG + 88 * MiB, WS_YD = WS_BIG + 90 * MiB  ,
                 WS_SST = WS_BIG + 106 * MiB  , WS_CCONV = WS_BIG + 122 * MiB  , WS_H1 = WS_BIG + 130 * MiB, WS_KCB = WS_BIG + 132 * MiB, WS_YEV = WS_BIG;
constexpr size_t WS_ACSG = WS_SMALL + 64 * 1024  , WS_ATOT = WS_SMALL + 640 * 1024  ;
constexpr size_t WS_T = WS_BIG, WS_YFF = WS_BIG + 88 * MiB;
constexpr size_t WS_U = WS_BIG, WS_V = WS_BIG + 64 * MiB, WS_ST = WS_BIG + 128 * MiB, WS_YOD = WS_BIG + 64 * MiB;
constexpr size_t WS_END = 280 * MiB;
constexpr int CW_BAR = 4096;

constexpr int SCR_BYTES = 152 * 1024;
constexpr int MISC_OFF = SCR_BYTES;
constexpr int LDS_BYTES = SCR_BYTES + 512;

#define GAS __attribute__((address_space(1)))
#define LAS __attribute__((address_space(3)))
typedef unsigned short bf16;
typedef unsigned v4u __attribute__((ext_vector_type(4)));
typedef unsigned v2u __attribute__((ext_vector_type(2)));
typedef float f32x4 __attribute__((ext_vector_type(4)));
typedef float f32x2 __attribute__((ext_vector_type(2)));
typedef GAS unsigned gu32;
#define RLX_AGENT __ATOMIC_RELAXED, __HIP_MEMORY_SCOPE_AGENT
#define LDS_WAIT() asm volatile("s_waitcnt lgkmcnt(0)" ::: "memory")
#define VM_WAIT() asm volatile("s_waitcnt vmcnt(0)" ::: "memory")
__device__ __forceinline__ unsigned f2bf(float f) { unsigned u = __builtin_bit_cast(unsigned, f); return (u + 0x7fffu + ((u >> 16) & 1u)) >> 16; }
__device__ __forceinline__ unsigned pk2(float lo, float hi) { return f2bf(lo) | (f2bf(hi) << 16); }
__device__ __forceinline__ float bflo(unsigned w) { return __builtin_bit_cast(float, w << 16); }
__device__ __forceinline__ float bfhi(unsigned w) { return __builtin_bit_cast(float, w & 0xffff0000u); }
__device__ __forceinline__ float bf2f(bf16 h) { return __builtin_bit_cast(float, (unsigned)h << 16); }
__device__ __forceinline__ float wave_sum(float v) {
#pragma unroll
    for (int o = 1; o < 64; o <<= 1) v += __shfl_xor(v, o);
    return v;
}
__device__ __forceinline__ float wave_max(float v) {
#pragma unroll
    for (int o = 1; o < 64; o <<= 1) v = fmaxf(v, __shfl_xor(v, o));
    return v;
}
__device__ __forceinline__ float silu_f(float x) { return x / (1.0f + __expf(-x)); }
__device__ __forceinline__ float sigmoid_f(float x) { return 1.0f / (1.0f + __expf(-x)); }

__device__ __forceinline__ int flane() { return (int)__builtin_amdgcn_mbcnt_hi(~0u, __builtin_amdgcn_mbcnt_lo(~0u, 0u)); }
#define XB_TMO      128
#define XB_XCNT(j)  (256  + 64 * (j))
#define XB_XSUB(j)  (1280 + 64 * (j))
#define XB_XGEN(j)  (2304 + 64 * (j))
#define XB_TOP      3328
#define XB_TOPGEN   3392
#define XCD_BAR_WORDS 3456
#define XB_SPIN_CAP (1u << 22)

__device__ __forceinline__ unsigned xb_ld(unsigned* p)              { return __hip_atomic_load(p, __ATOMIC_RELAXED, __HIP_MEMORY_SCOPE_AGENT); }
__device__ __forceinline__ unsigned xb_add(unsigned* p, unsigned v) { return __hip_atomic_fetch_add(p, v, __ATOMIC_RELAXED, __HIP_MEMORY_SCOPE_AGENT); }
__device__ __forceinline__ unsigned xb_xcc_id() { return (unsigned)__builtin_amdgcn_s_getreg((3 << 11) | 20) & 0xFu; }
#define XB_SPIN(cond, bar) do { unsigned _sp = 0; while (cond) { __builtin_amdgcn_s_sleep(1); \
    if ((++_sp & 255u) == 0u) { if (xb_ld(&(bar)[XB_TMO])) break; if (_sp > XB_SPIN_CAP) { atomicAdd(&(bar)[XB_TMO], 1u); break; } } } } while (0)

struct XcdBarrier { unsigned* bar; unsigned x; volatile LAS unsigned* st; };
__device__ __forceinline__ XcdBarrier xcd_barrier_post(unsigned* bar, volatile LAS unsigned* st) {
    XcdBarrier b; b.bar = bar; b.x = xb_xcc_id(); b.st = st;
    if (threadIdx.x == 0) (void)xb_add(&bar[XB_XCNT(b.x)], 1u);
    return b;
}
__device__ __forceinline__ void xcd_barrier_complete(unsigned* bar, unsigned x, unsigned& nloc, unsigned& nx) {
    const unsigned G = gridDim.x * gridDim.y * gridDim.z;
    unsigned sum, cnt, mine, sp = 0u;
    for (;;) {
        sum = 0u; cnt = 0u; mine = 0u;
#pragma unroll
        for (unsigned j = 0; j < 16; ++j) { const unsigned c = xb_ld(&bar[XB_XCNT(j)]); sum += c; cnt += (c > 0u) ? 1u : 0u; mine = (j == x) ? c : mine; }
        if (sum == G) break;
        __builtin_amdgcn_s_sleep(1);
        if ((++sp & 255u) == 0u) { if (xb_ld(&bar[XB_TMO])) break; if (sp > XB_SPIN_CAP) { atomicAdd(&bar[XB_TMO], 1u); break; } }
    }
    nloc = mine > 0u ? mine : 1u; nx = cnt > 0u ? cnt : 1u;
}
__device__ __forceinline__ void xcd_barrier(const XcdBarrier& b, const int wave) {
    asm volatile("s_waitcnt vmcnt(0)" ::: "memory");
    __syncthreads();
    if (wave == 0 && flane() == 0) {
        unsigned* bar = b.bar;
        __builtin_amdgcn_s_waitcnt(0);
        unsigned nloc = b.st[0], nx = b.st[1];
        if (nloc == 0u) { xcd_barrier_complete(bar, b.x, nloc, nx); b.st[0] = nloc; b.st[1] = nx; }
        const unsigned old = xb_add(&bar[XB_XSUB(b.x)], 1u);
        const unsigned gen = old / nloc;
        if (old + 1u == (gen + 1u) * nloc) {
            __builtin_amdgcn_fence(__ATOMIC_RELEASE, "agent");
            asm volatile("s_waitcnt vmcnt(0)" ::: "memory");
            const unsigned og = xb_add(&bar[XB_TOP], 1u);
            const unsigned tg = og / nx;
            if (og + 1u == (tg + 1u) * nx) xb_add(&bar[XB_TOPGEN], 1u);
            else XB_SPIN(xb_ld(&bar[XB_TOPGEN]) == tg, bar);
            __builtin_amdgcn_fence(__ATOMIC_ACQUIRE, "agent");
            xb_add(&bar[XB_XGEN(b.x)], 1u);
            asm volatile("s_waitcnt vmcnt(0)" ::: "memory");
        } else {
            XB_SPIN(xb_ld(&bar[XB_XGEN(b.x)]) == gen, bar);
            __builtin_amdgcn_fence(__ATOMIC_ACQUIRE, "agent");
            asm volatile("s_waitcnt vmcnt(0)" ::: "memory");
        }
    }
    __syncthreads();
}

struct Frame {
    LAS unsigned char* lds;
    unsigned char* ws;
    int tid, lane, wave, G, bid;
    float* out;
};

enum InIdx { I_X = 0, I_GAINS, I_WG, I_WU, I_WD, I_EVIN, I_EVOUT, I_PE, I_CW1, I_CW2, I_CONVW, I_CONVB, I_DTB, I_ALOG, I_DSKIP, I_SNORM, I_ODIN, I_LNW, I_LNB, I_WS, I_BS, I_ODOUT };

__device__ __forceinline__ const float* inp(const Frame& F, int i) {
    volatile LAS unsigned* t = (volatile LAS unsigned*)(F.lds + MISC_OFF) + 32 + 2 * i;
    const unsigned lo = __builtin_amdgcn_readfirstlane(t[0]), hi = __builtin_amdgcn_readfirstlane(t[1]);
    return (const float*)(((unsigned long long)hi << 32) | lo);
}
struct TJob { const float* W; int K, N; bf16* dst; int mode; const float* gain; int gain_lo; int row_off; };
__device__ __forceinline__ int evin_row(int n) {
    if (n < 1280) return n;
    if (n < 1304) return 2816 + (n - 1280);
    if (n < 1816) return 1280 + (n - 1304);
    if (n < 2840) return 1792 + (n - 1816);
    return 2840 + (n - 2840);
}
__device__ __forceinline__ void transpose_item(const TJob& J, int local, LAS float* scr, int lane) {
    const int nblk = J.N / 32, kb = local / nblk, nb = local % nblk, k0 = 64 * kb, n0 = 32 * nb;
#pragma unroll 8
    for (int i = 0; i < 32; ++i) { const int kk = 2 * i + (lane >> 5), k = k0 + kk; float g = 1.0f; if (J.gain != nullptr && k >= J.gain_lo) g = J.gain[k];
        scr[kk * 33 + (lane & 31)] = J.W[(size_t)k * J.N + n0 + (lane & 31)] * g; }
    LDS_WAIT(); asm volatile("" ::: "memory");
    const int c = lane & 7;
#pragma unroll
    for (int j = 0; j < 4; ++j) { const int n = (lane >> 3) + 8 * j, nn = n0 + n; const LAS float* s = scr + (8 * c) * 33 + n;
        int dr; float sc = 1.0f;
        if (J.mode == 0) dr = J.row_off + nn; else if (J.mode == 1) dr = 256 * (nn >> 7) + (nn & 127) + J.row_off; else { dr = evin_row(nn); if (nn < 512) sc = 0.125f * 1.4426950408889634f; }
        v4u o; o.x = pk2(s[0 * 33] * sc, s[1 * 33] * sc); o.y = pk2(s[2 * 33] * sc, s[3 * 33] * sc); o.z = pk2(s[4 * 33] * sc, s[5 * 33] * sc); o.w = pk2(s[6 * 33] * sc, s[7 * 33] * sc);
        *(v4u*)(J.dst + (size_t)dr * J.K + k0 + 8 * c) = o; }
    LDS_WAIT(); asm volatile("" ::: "memory");
}
constexpr int IT_FFN = 16 * 88, IT_EVIN = 16 * 89, IT_EVOUT = 16 * 32, IT_W1 = 32 * 8, IT_ODIN = 16 * 128, IT_ODOUT = 32 * 32;
constexpr int IT_EV = IT_EVIN + IT_EVOUT + 2 * IT_W1, IT_OD = IT_ODIN + IT_ODOUT;
constexpr int N_TRANS = 12 * IT_FFN + 2 * IT_EV + 2 * IT_OD;
__device__ __forceinline__ void get_job(Frame& F, int it, TJob& J, int& local) {
    if (it < 12 * IT_FFN) { const int L = it / (3 * IT_FFN), r = it % (3 * IT_FFN), w = r / IT_FFN; local = r % IT_FFN;
        bf16* base = (bf16*)(F.ws + WS_WFFN + (size_t)L * WFFN_STRIDE);
        if (w == 0) J = TJob{inp(F, I_WG) + (size_t)L * D * FFH, D, FFH, base, 1, inp(F, I_GAINS) + (L * 4 + 2) * D, 0, 0};
        else if (w == 1) J = TJob{inp(F, I_WU) + (size_t)L * D * FFH, D, FFH, base, 1, inp(F, I_GAINS) + (L * 4 + 2) * D, 0, 128};
        else J = TJob{inp(F, I_WD) + (size_t)L * FFH * D, FFH, D, base + (size_t)5632 * 1024, 0, nullptr, 0, 0};
        return; }
    it -= 12 * IT_FFN;
    if (it < 2 * IT_EV) { const int i = it / IT_EV; int r = it % IT_EV; unsigned char* base = F.ws + WS_WEV + (size_t)i * WEV_STRIDE;
        if (r < IT_EVIN) { local = r; J = TJob{inp(F, I_EVIN) + (size_t)i * D * EV_IN, D, EV_IN, (bf16*)base, 2, inp(F, I_GAINS) + (2 * i * 4 + 0) * D, 0, 0}; return; } r -= IT_EVIN;
        if (r < IT_EVOUT) { local = r; J = TJob{inp(F, I_EVOUT) + (size_t)i * D * D, D, D, (bf16*)(base + 6 * MiB), 0, inp(F, I_SNORM) + i * 512 - 512, 512, 0}; return; } r -= IT_EVOUT;
        const int kv = r / IT_W1; local = r % IT_W1;
        J = TJob{inp(F, I_CW1) + (size_t)(i * 2 + kv) * 2048 * 256, 2048, 256, (bf16*)(base + 8 * MiB), 0, nullptr, 0, kv * 256}; return; }
    it -= 2 * IT_EV;
    { const int i = it / IT_OD; int r = it % IT_OD; unsigned char* base = F.ws + WS_WOD + (size_t)i * WOD_STRIDE;
        if (r < IT_ODIN) { local = r; J = TJob{inp(F, I_ODIN) + (size_t)i * D * 4096, D, 4096, (bf16*)base, 0, inp(F, I_GAINS) + ((2 * i + 1) * 4 + 0) * D, 0, 0}; return; } r -= IT_ODIN;
        local = r; J = TJob{inp(F, I_ODOUT) + (size_t)i * 2048 * D, 2048, D, (bf16*)(base + 8 * MiB), 0, nullptr, 0, 0}; }
}
__device__ __forceinline__ void rms_row_to_bf16(const float* xrow, bf16* orow, int lane) {
    const f32x4* xr = (const f32x4*)xrow + lane;
    f32x4 v[4]; float s = 0.f;
#pragma unroll
    for (int j = 0; j < 4; ++j) { v[j] = xr[64 * j]; s += (v[j].x * v[j].x + v[j].y * v[j].y) + (v[j].z * v[j].z + v[j].w * v[j].w); }
    const float rstd = 1.0f / sqrtf(wave_sum(s) * (1.f / D) + RMS_EPS);
    v2u* o8 = (v2u*)orow + lane;
#pragma unroll
    for (int j = 0; j < 4; ++j) o8[64 * j] = (v2u){pk2(v[j].x * rstd, v[j].y * rstd), pk2(v[j].z * rstd, v[j].w * rstd)};
}
__device__ __forceinline__ void p0_prologue(Frame& F) {
    LAS float* scr = (LAS float*)(F.lds + F.wave * 16384);
    const int gw = F.bid * NWAVES + F.wave, NGW = F.G * NWAVES;
    for (int it = gw; it < N_TRANS; it += NGW) { TJob J; int local; get_job(F, it, J, local); transpose_item(J, local, scr, F.lane); }
    float* bias1 = (float*)(F.ws + WS_SMALL);
    for (int o = gw; o < 1024; o += NGW) { const int ik = o >> 8, j = o & 255; const float* pe = inp(F, I_PE) + (size_t)ik * 2048; const float* w1 = inp(F, I_CW1) + (size_t)ik * 2048 * 256 + j;
        float s = 0.f;
        for (int t = 0; t < 32; ++t) { const int k = t * 64 + F.lane; s += pe[k] * w1[(size_t)k * 256]; }
        s = wave_sum(s); if (F.lane == 0) bias1[o] = s; }
    for (int m = gw; m < M; m += NGW) rms_row_to_bf16(inp(F, I_X) + (size_t)m * D, (bf16*)(F.ws + WS_A) + (size_t)m * D, F.lane);
}

__device__ __forceinline__ void rowpass(Frame& F, const bf16* Y, const float* hin, float* hout, bf16* aout, const float* gain) {
    const int gw = F.bid * NWAVES + F.wave, NGW = F.G * NWAVES, lane = F.lane;
    f32x4 gv[4];
#pragma unroll
    for (int j = 0; j < 4; ++j) gv[j] = ((const f32x4*)gain)[lane + 64 * j];
    for (int m = gw; m < M; m += NGW) {
        const v2u* yr = (const v2u*)(Y + (size_t)m * D) + lane; const f32x4* hr = (const f32x4*)(hin + (size_t)m * D) + lane;
        f32x4 y[4], h[4]; float s = 0.f;
#pragma unroll
        for (int j = 0; j < 4; ++j) { const v2u w = yr[64 * j]; y[j] = (f32x4){bflo(w.x), bfhi(w.x), bflo(w.y), bfhi(w.y)}; h[j] = hr[64 * j];
            s += (y[j].x * y[j].x + y[j].y * y[j].y) + (y[j].z * y[j].z + y[j].w * y[j].w); }
        const float rstd = 1.0f / sqrtf(wave_sum(s) * (1.f / D) + RMS_EPS);
        float s2 = 0.f;
#pragma unroll
        for (int j = 0; j < 4; ++j) { h[j] = h[j] + y[j] * rstd * gv[j]; s2 += (h[j].x * h[j].x + h[j].y * h[j].y) + (h[j].z * h[j].z + h[j].w * h[j].w); }
        f32x4* ho = (f32x4*)(hout + (size_t)m * D) + lane;
#pragma unroll
        for (int j = 0; j < 4; ++j) ho[64 * j] = h[j];
        if (aout != nullptr) {
            const float r2 = 1.0f / sqrtf(wave_sum(s2) * (1.f / D) + RMS_EPS);
            v2u* o8 = (v2u*)(aout + (size_t)m * D) + lane;
#pragma unroll
            for (int j = 0; j < 4; ++j) o8[64 * j] = (v2u){pk2(h[j].x * r2, h[j].y * r2), pk2(h[j].z * r2, h[j].w * r2)};
        }
    }
}

__device__ __forceinline__ void compress2(Frame& F, int ie, int b0) {
    const bf16* H1 = (const bf16*)(F.ws + WS_H1); bf16* KCB = (bf16*)(F.ws + WS_KCB);
    const int nb = F.G - b0; if (F.bid < b0) return;
    for (int idx = (F.bid - b0) * 512 + F.tid; idx < 4096 * 64; idx += nb * 512) {
        const int r = idx >> 6, d = idx & 63, kv = r >> 11; const float* w2 = inp(F, I_CW2) + (size_t)(ie * 2 + kv) * 256 * 64 + d; const bf16* h = H1 + (size_t)r * 256;
        float s = 0.f;
        for (int j = 0; j < 256; j += 2) { const unsigned w = *(const unsigned*)(h + j); s += bflo(w) * w2[(size_t)j * 64]; s += bfhi(w) * w2[(size_t)(j + 1) * 64]; }
        KCB[idx] = (bf16)f2bf(s);
    }
}
typedef short bf16x8v __attribute__((ext_vector_type(8)));
typedef float f32x16 __attribute__((ext_vector_type(16)));
__device__ __forceinline__ int crow(int r, int hi) { return (r & 3) + 8 * (r >> 2) + 4 * hi; }
template <int KS> __device__ __forceinline__ f32x16 mma_rows(const LAS unsigned char* arow, const LAS unsigned char* brow, f32x16 acc) {
#pragma unroll
    for (int ks = 0; ks < KS; ++ks) { const bf16x8v a = *(const LAS bf16x8v*)(arow + ks * 32), b = *(const LAS bf16x8v*)(brow + ks * 32); acc = __builtin_amdgcn_mfma_f32_32x32x16_bf16(a, b, acc, 0, 0, 0); }
    return acc;
}
constexpr int SP = 272;
constexpr int S1_BC = 0, S1_BT = 34816, S1_CM = 69632, S1_XD = 104448, S1_XE = 121856, S1_DT = 139264, S1_ACS = 141312;
static_assert(S1_ACS + 2048 <= SCR_BYTES, "SSM S1 LDS map");
__device__ __forceinline__ float softplus_f(float x) { return fmaxf(x, 0.f) + log1pf(__expf(-fabsf(x))); }

__device__ __forceinline__ void ssm_s1_item(Frame& F, int ie, int item) {
    const int tid = F.tid, lane = F.lane, w = F.wave, r32 = lane & 31, hi = lane >> 5;
    const int g = item & 1, bc = item >> 1, c = bc & 15, b = bc >> 4; const size_t R0 = (size_t)b * SEQ + c * 128;
    LAS unsigned char* L = F.lds;
    LAS float* DT = (LAS float*)(L + S1_DT); LAS float* ACS = (LAS float*)(L + S1_ACS);
    const bf16* X = (const bf16*)(F.ws + WS_XBC); const float* GLDT = (const float*)(F.ws + WS_GLDT);
    bf16* YD = (bf16*)(F.ws + WS_YD); bf16* STg = (bf16*)(F.ws + WS_SST); bf16* CCONV = (bf16*)(F.ws + WS_CCONV); float* ACSG = (float*)(F.ws + WS_ACSG); float* ATOT = (float*)(F.ws + WS_ATOT);
    const float* cw = inp(F, I_CONVW) + (size_t)ie * 4 * 1024; const float* cb = inp(F, I_CONVB) + (size_t)ie * 1024;
    __syncthreads();
    if (w < 4) { const int h = 4 * g + w; const float Ah = -__expf(inp(F, I_ALOG)[ie * 8 + h]), dtb = inp(F, I_DTB)[ie * 8 + h];
        const float d0 = softplus_f(GLDT[(R0 + 2 * lane) * 32 + 24 + h] + dtb), d1 = softplus_f(GLDT[(R0 + 2 * lane + 1) * 32 + 24 + h] + dtb);
        const float a0 = d0 * Ah, a1 = d1 * Ah; float s = a0 + a1;
#pragma unroll
        for (int o = 1; o < 64; o <<= 1) { const float t = __shfl_up(s, o); if (lane >= o) s += t; }
        DT[w * 128 + 2 * lane] = d0; DT[w * 128 + 2 * lane + 1] = d1; ACS[w * 128 + 2 * lane] = s - a1; ACS[w * 128 + 2 * lane + 1] = s;
        ACSG[(R0 + 2 * lane) * 8 + h] = s - a1; ACSG[(R0 + 2 * lane + 1) * 8 + h] = s;
        if (lane == 63) ATOT[(size_t)bc * 8 + h] = s; }
    { const int grp = tid & 31, seg = tid >> 5, isC = grp >> 4, n8 = (grp & 15) * 8, ch = 512 + 256 * isC + 128 * g + n8;
      float wk[4][8], bias[8], xr[4][8];
#pragma unroll
      for (int e = 0; e < 8; ++e) { bias[e] = cb[ch + e];
#pragma unroll
          for (int k = 0; k < 4; ++k) wk[k][e] = cw[k * 1024 + ch + e]; }
#pragma unroll
      for (int j = 0; j < 11; ++j) {
          const int l = 8 * seg - 3 + j; const bool ok = (c * 128 + l) >= 0;
          v4u x = (v4u){0u, 0u, 0u, 0u}; if (ok) x = *(const v4u*)(X + (size_t)((long)R0 + l) * 1024 + ch);
          const int sl = j & 3;
          xr[sl][0] = bflo(x.x); xr[sl][1] = bfhi(x.x); xr[sl][2] = bflo(x.y); xr[sl][3] = bfhi(x.y); xr[sl][4] = bflo(x.z); xr[sl][5] = bfhi(x.z); xr[sl][6] = bflo(x.w); xr[sl][7] = bfhi(x.w);
          if (j >= 3) { float o[8];
#pragma unroll
              for (int e = 0; e < 8; ++e) { float a = bias[e];
#pragma unroll
                  for (int k = 0; k < 4; ++k) a += wk[k][e] * xr[(j - 3 + k) & 3][e];
                  o[e] = silu_f(a); }
              const v4u pk = (v4u){pk2(o[0], o[1]), pk2(o[2], o[3]), pk2(o[4], o[5]), pk2(o[6], o[7])};
              if (isC) { *(LAS v4u*)(L + S1_CM + l * SP + n8 * 2) = pk; *(v4u*)(CCONV + ((size_t)R0 + l) * 256 + g * 128 + n8) = pk; }
              else { *(LAS v4u*)(L + S1_BC + l * SP + n8 * 2) = pk;
#pragma unroll
                  for (int e = 0; e < 8; ++e) *(LAS bf16*)(L + S1_BT + (n8 + e) * SP + l * 2) = (bf16)f2bf(o[e]); } } } }
    __syncthreads();
    const int l0 = 32 * (w >> 1), s0 = 64 * (w & 1);
    f32x16 cb0, cb1;
    { const f32x16 z = {0.f, 0.f, 0.f, 0.f, 0.f, 0.f, 0.f, 0.f, 0.f, 0.f, 0.f, 0.f, 0.f, 0.f, 0.f, 0.f};
      const LAS unsigned char* ar = L + S1_CM + (l0 + r32) * SP + hi * 16;
      cb0 = mma_rows<8>(ar, L + S1_BC + (s0 + r32) * SP + hi * 16, z); cb1 = mma_rows<8>(ar, L + S1_BC + (s0 + 32 + r32) * SP + hi * 16, z); }
    __syncthreads();
#pragma unroll 1
    for (int hh = 0; hh < 4; ++hh) {
        const int h = 4 * g + hh; const float Dk = inp(F, I_DSKIP)[ie * 8 + h];
        { const int cg = tid & 7, seg = tid >> 3, ch = h * 64 + 8 * cg, la = 2 * seg;
          float xv[5][8];
#pragma unroll
          for (int j = 0; j < 5; ++j) { const int l = la - 3 + j; v4u x = (v4u){0u, 0u, 0u, 0u}; if ((c * 128 + l) >= 0) x = *(const v4u*)(X + (size_t)((long)R0 + l) * 1024 + ch);
              xv[j][0] = bflo(x.x); xv[j][1] = bfhi(x.x); xv[j][2] = bflo(x.y); xv[j][3] = bfhi(x.y); xv[j][4] = bflo(x.z); xv[j][5] = bfhi(x.z); xv[j][6] = bflo(x.w); xv[j][7] = bfhi(x.w); }
          const float alast = ACS[hh * 128 + 127], d0 = DT[hh * 128 + la], d1 = DT[hh * 128 + la + 1], e0 = __expf(alast - ACS[hh * 128 + la]), e1 = __expf(alast - ACS[hh * 128 + la + 1]);
#pragma unroll
          for (int e = 0; e < 8; ++e) { float a0 = cb[ch + e], a1 = a0;
#pragma unroll
              for (int k = 0; k < 4; ++k) { const float wv = cw[k * 1024 + ch + e]; a0 += wv * xv[k][e]; a1 += wv * xv[k + 1][e]; }
              const float x0 = silu_f(a0) * d0, x1 = silu_f(a1) * d1;
              *(LAS unsigned*)(L + S1_XD + (8 * cg + e) * SP + la * 2) = pk2(x0, x1); *(LAS unsigned*)(L + S1_XE + (8 * cg + e) * SP + la * 2) = pk2(x0 * e0, x1 * e1); } }
#pragma unroll
        for (int t = 0; t < 2; ++t) { const f32x16 cbv = t == 0 ? cb0 : cb1; const int s = s0 + 32 * t + r32; const float as = ACS[hh * 128 + s];
#pragma unroll
            for (int i = 0; i < 16; ++i) { const int l = l0 + crow(i, hi); float v = 0.f; if (s <= l) v = cbv[i] * __expf(ACS[hh * 128 + l] - as); if (s == l) v += Dk / DT[hh * 128 + l];
                *(LAS bf16*)(L + S1_CM + l * SP + s * 2) = (bf16)f2bf(v); } }
        __syncthreads();
        { const f32x16 z = {0.f, 0.f, 0.f, 0.f, 0.f, 0.f, 0.f, 0.f, 0.f, 0.f, 0.f, 0.f, 0.f, 0.f, 0.f, 0.f};
          const int p0 = 32 * (w & 1);
          const f32x16 y = mma_rows<8>(L + S1_CM + (l0 + r32) * SP + hi * 16, L + S1_XD + (p0 + r32) * SP + hi * 16, z);
#pragma unroll
          for (int i = 0; i < 16; ++i) YD[((size_t)R0 + l0 + crow(i, hi)) * 512 + h * 64 + p0 + r32] = (bf16)f2bf(y[i]);
          const int ps = 32 * (w >> 2), n0 = 32 * (w & 3);
          const f32x16 st = mma_rows<8>(L + S1_XE + (ps + r32) * SP + hi * 16, L + S1_BT + (n0 + r32) * SP + hi * 16, z);
#pragma unroll
          for (int i = 0; i < 16; ++i) STg[(((size_t)bc * 8 + h) * 64 + ps + crow(i, hi)) * 128 + n0 + r32] = (bf16)f2bf(st[i]); }
        __syncthreads();
    }
}

constexpr int S3_PV = 0, S3_CC = 69632, S3_RS = 104448, S3_WT = 105472, S3_EA = 105728;
__device__ __forceinline__ void ssm_s3_item(Frame& F, int item) {
    const int tid = F.tid, lane = F.lane, w = F.wave, r32 = lane & 31, hi = lane >> 5;
    const int g = item & 1, bc = item >> 1, c = bc & 15, b = bc >> 4; const size_t R0 = (size_t)b * SEQ + c * 128;
    LAS unsigned char* L = F.lds; LAS float* RS = (LAS float*)(L + S3_RS); LAS float* WT = (LAS float*)(L + S3_WT); LAS float* EA = (LAS float*)(L + S3_EA);
    const bf16* YD = (const bf16*)(F.ws + WS_YD); const bf16* STg = (const bf16*)(F.ws + WS_SST); const bf16* CCONV = (const bf16*)(F.ws + WS_CCONV); const float* ACSG = (const float*)(F.ws + WS_ACSG); const float* ATOT = (const float*)(F.ws + WS_ATOT);
    const bf16* Z = (const bf16*)(F.ws + WS_Z); bf16* O = (bf16*)(F.ws + WS_A);
    __syncthreads();
    { const int hh = tid >> 7, l = tid & 127; EA[tid] = __expf(ACSG[(R0 + l) * 8 + 4 * g + hh]); }
    if (tid < 64) { const int hh = tid >> 4, cp = tid & 15, h = 4 * g + hh; float s = 0.f; for (int c2 = cp + 1; c2 < c; ++c2) s += ATOT[((size_t)(b * 16 + c2)) * 8 + h]; WT[tid] = cp < c ? __expf(s) : 0.f; }
    for (int idx = tid; idx < 128 * 16; idx += 512) { const int l = idx >> 4, n8 = (idx & 15) * 8; *(LAS v4u*)(L + S3_CC + l * SP + n8 * 2) = *(const v4u*)(CCONV + ((size_t)R0 + l) * 256 + g * 128 + n8); }
    __syncthreads();
    for (int idx = tid; idx < 4 * 64 * 16; idx += 512) { const int hh = idx >> 10, p = (idx >> 4) & 63, n8 = (idx & 15) * 8, h = 4 * g + hh;
        float a[8] = {0.f, 0.f, 0.f, 0.f, 0.f, 0.f, 0.f, 0.f};
        for (int c2 = 0; c2 < c; ++c2) { const float wv = WT[hh * 16 + c2]; const v4u x = *(const v4u*)(STg + ((((size_t)(b * 16 + c2)) * 8 + h) * 64 + p) * 128 + n8);
            a[0] += wv * bflo(x.x); a[1] += wv * bfhi(x.x); a[2] += wv * bflo(x.y); a[3] += wv * bfhi(x.y); a[4] += wv * bflo(x.z); a[5] += wv * bfhi(x.z); a[6] += wv * bflo(x.w); a[7] += wv * bfhi(x.w); }
        *(LAS v4u*)(L + S3_PV + (hh * 64 + p) * SP + n8 * 2) = (v4u){pk2(a[0], a[1]), pk2(a[2], a[3]), pk2(a[4], a[5]), pk2(a[6], a[7])}; }
    __syncthreads();
    const int l0 = 32 * (w >> 1), p0 = 32 * (w & 1);
#pragma unroll 1
    for (int pass = 0; pass < 2; ++pass) {
        float ss[16];
#pragma unroll
        for (int i = 0; i < 16; ++i) ss[i] = pass == 0 ? 0.f : 1.0f / sqrtf((RS[(l0 + crow(i, hi)) * 2] + RS[(l0 + crow(i, hi)) * 2 + 1]) * (1.f / 256.f) + RMS_EPS);
#pragma unroll 1
        for (int hh = 0; hh < 4; ++hh) { const int h = 4 * g + hh; const f32x16 z = {0.f, 0.f, 0.f, 0.f, 0.f, 0.f, 0.f, 0.f, 0.f, 0.f, 0.f, 0.f, 0.f, 0.f, 0.f, 0.f};
            const f32x16 yo = mma_rows<8>(L + S3_CC + (l0 + r32) * SP + hi * 16, L + S3_PV + (hh * 64 + p0 + r32) * SP + hi * 16, z);
            const size_t base = (R0 + l0 + 4 * hi) * 512 + h * 64 + p0 + r32; const bf16* ydp = YD + base; const bf16* zp = Z + base; const LAS float* eap = EA + hh * 128 + l0 + 4 * hi;
            bf16* op = O + (R0 + l0 + 4 * hi) * 1024 + 512 + g * 256 + hh * 64 + p0 + r32;
#pragma unroll
            for (int i = 0; i < 16; ++i) { const int ro = (i & 3) + 8 * (i >> 2);
                const float y = bf2f(ydp[ro * 512]) + yo[i] * eap[ro]; const float t = y * silu_f(bf2f(zp[ro * 512]));
                if (pass == 0) ss[i] += t * t; else op[ro * 1024] = (bf16)f2bf(t * ss[i]); }
        }
        if (pass == 0) {
#pragma unroll
            for (int i = 0; i < 16; ++i) { float s = ss[i]; s += __shfl_xor(s, 1); s += __shfl_xor(s, 2); s += __shfl_xor(s, 4); s += __shfl_xor(s, 8); s += __shfl_xor(s, 16); if (r32 == 0) RS[(l0 + crow(i, hi)) * 2 + (w & 1)] = s; }
            __syncthreads();
        }
    }
}

typedef __attribute__((address_space(3))) const unsigned char* lds_cp;
typedef short v4i16_t __attribute__((ext_vector_type(4)));
__device__ __forceinline__ v4i16_t vtr(lds_cp p) { return __builtin_amdgcn_ds_read_tr16_b64_v4i16((__attribute__((address_space(3))) v4i16_t*)p); }
constexpr int AM_K = 0, AM_V = 16384, AM_PS = 32768, AM_IMP = 65536, AM_RS = 73728;
constexpr float LOG2E = 1.4426950408889634f;
__device__ __forceinline__ unsigned pkbf(float lo, float hi) { return pk2(lo, hi); }

struct AttnStage { v4u k, v; };
__device__ __forceinline__ void am_stage_load(AttnStage& s, const bf16* kb, const bf16* vb, int j, int wid, int lane) {
    s.k = *(const v4u*)(kb + (size_t)(64 * j + lane) * 64 + wid * 8);
    s.v = *(const v4u*)(vb + (size_t)(64 * j + 16 * (wid & 3) + (lane >> 2)) * 64 + (wid >> 2) * 32 + (lane & 3) * 8);
}
__device__ __forceinline__ void am_stage_write(const AttnStage& s, LAS unsigned char* L, int slot, int wid, int lane) {
    *(LAS v4u*)(L + AM_K + slot * 8192 + wid * 1024 + lane * 16) = s.k; *(LAS v4u*)(L + AM_V + slot * 8192 + wid * 1024 + lane * 16) = s.v;
}
__device__ __forceinline__ void am_qkt(f32x16& p0, f32x16& p1, lds_cp kslot, const bf16x8v (&qr)[5], bf16x8v kaug0, bf16x8v kaug1, int r32, int hi) {
    const f32x16 z = {0.f, 0.f, 0.f, 0.f, 0.f, 0.f, 0.f, 0.f, 0.f, 0.f, 0.f, 0.f, 0.f, 0.f, 0.f, 0.f};
    lds_cp kb = kslot + hi * 1024 + r32 * 16;
    p0 = __builtin_amdgcn_mfma_f32_32x32x16_bf16(kaug0, qr[4], z, 0, 0, 0); p1 = __builtin_amdgcn_mfma_f32_32x32x16_bf16(kaug1, qr[4], z, 0, 0, 0);
#pragma unroll
    for (int d0 = 0; d0 < 4; ++d0) { const bf16x8v b0 = *(const LAS bf16x8v*)(kb + d0 * 2048), b1 = *(const LAS bf16x8v*)(kb + d0 * 2048 + 512);
        p0 = __builtin_amdgcn_mfma_f32_32x32x16_bf16(b0, qr[d0], p0, 0, 0, 0); p1 = __builtin_amdgcn_mfma_f32_32x32x16_bf16(b1, qr[d0], p1, 0, 0, 0); }
}
__device__ __forceinline__ void am_pv(f32x16 (&o)[2], lds_cp vb, bf16x8v pa0, bf16x8v pa1, bf16x8v pa2, bf16x8v pa3) {
#pragma unroll
    for (int d0 = 0; d0 < 2; ++d0) {
        v4i16_t lo[4], hh[4];
#pragma unroll
        for (int ks = 0; ks < 4; ++ks) { lo[ks] = vtr(vb + d0 * 4096 + ks * 1024); hh[ks] = vtr(vb + d0 * 4096 + ks * 1024 + 512); }
#define AM_PK(k) (bf16x8v){lo[k][0], lo[k][1], lo[k][2], lo[k][3], hh[k][0], hh[k][1], hh[k][2], hh[k][3]}
        o[d0] = __builtin_amdgcn_mfma_f32_32x32x16_bf16(pa0, AM_PK(0), o[d0], 0, 0, 0); o[d0] = __builtin_amdgcn_mfma_f32_32x32x16_bf16(pa1, AM_PK(1), o[d0], 0, 0, 0);
        o[d0] = __builtin_amdgcn_mfma_f32_32x32x16_bf16(pa2, AM_PK(2), o[d0], 0, 0, 0); o[d0] = __builtin_amdgcn_mfma_f32_32x32x16_bf16(pa3, AM_PK(3), o[d0], 0, 0, 0);
#undef AM_PK
    }
}
__device__ __forceinline__ bf16x8v am_pack8(const f32x16& p, int b) { const v4u w = (v4u){pkbf(p[b], p[b + 1]), pkbf(p[b + 2], p[b + 3]), pkbf(p[b + 4], p[b + 5]), pkbf(p[b + 6], p[b + 7])}; return __builtin_bit_cast(bf16x8v, w); }
__device__ __forceinline__ bf16x8v am_kaug(unsigned w0, unsigned w1, unsigned w2) { const v4u w = (v4u){w0, w1, w2, 0u}; return __builtin_bit_cast(bf16x8v, w); }
__device__ __forceinline__ void am_fold(f32x16 (&fin)[2], const f32x16 (&o)[2], float rowscale, volatile LAS float* rsw, int r32, int hi) {
    asm volatile("" ::: "memory"); if (hi == 0) rsw[r32] = rowscale; asm volatile("s_waitcnt lgkmcnt(0)" ::: "memory");
#pragma unroll
    for (int i = 0; i < 16; ++i) { const float s = rsw[crow(i, hi)]; fin[0][i] += o[0][i] * s; fin[1][i] += o[1][i] * s; }
    asm volatile("s_waitcnt lgkmcnt(0)" ::: "memory");
}

__device__ __forceinline__ void attn_unit(Frame& F, int bg, int jq) {
    const int lane = F.lane, w = F.wave, r32 = lane & 31, hi = lane >> 5, b = bg >> 1, g = bg & 1;
    LAS unsigned char* L = F.lds;
    const bf16* Qg = (const bf16*)(F.ws + WS_Q); const bf16* KVg = (const bf16*)(F.ws + WS_KV); const bf16* KCBb = (const bf16*)(F.ws + WS_KCB); const float* GLDT = (const float*)(F.ws + WS_GLDT);
    const int qloc = r32 >> 2, rh = r32 & 3, tl = 8 * w + qloc, t = 64 * jq + tl, head = 4 * g + rh; const size_t row = (size_t)b * SEQ + t;
    bf16x8v qr[5];
#pragma unroll
    for (int d0 = 0; d0 < 4; ++d0) qr[d0] = *(const bf16x8v*)(Qg + row * 512 + head * 64 + d0 * 16 + hi * 8);
    const float sl2 = exp2f(-(float)(head + 1)) * LOG2E; const float hs = bf2f((bf16)f2bf(sl2)), ls = sl2 - hs;
    const unsigned qa0 = pkbf(hs, ls), qa1 = pkbf(64.f * hs, 64.f * ls), qa2_on = pkbf(-sl2 * (float)tl, 0.f), qa2_off = pkbf(-sl2 * (float)tl, -30000.f);
    qr[4] = hi == 0 ? am_kaug(qa0, qa1, qa2_on) : am_kaug(0u, 0u, 0u);
    const float* gl = GLDT + row * 32 + head * 3; const float g_cmp = sigmoid_f(gl[0]), g_sel = sigmoid_f(gl[1]), g_win = sigmoid_f(gl[2]);
    const unsigned kw0a = hi == 0 ? pkbf((float)r32, (float)r32) : 0u, kw0b = hi == 0 ? pkbf((float)(r32 + 32), (float)(r32 + 32)) : 0u, kw2 = hi == 0 ? pkbf(1.f, 1.f) : 0u;
    volatile LAS float* rsw = (volatile LAS float*)(L + AM_RS) + w * 32;
    lds_cp vb0 = (lds_cp)(L + AM_V) + ((lane >> 4) & 1) * 32 + (lane & 3) * 8 + (4 * hi + ((lane & 15) >> 2)) * 64;
    f32x16 fin[2], o[2];
    const f32x16 zz = {0.f, 0.f, 0.f, 0.f, 0.f, 0.f, 0.f, 0.f, 0.f, 0.f, 0.f, 0.f, 0.f, 0.f, 0.f, 0.f};
    o[0] = zz; o[1] = zz;
    AttnStage st;
    __syncthreads();
    unsigned selm;
    {
        const bf16* kc = KCBb + (size_t)(bg * 128) * 64; const bf16* vc = KCBb + (size_t)(2048 + bg * 128) * 64;
        am_stage_load(st, kc, vc, 0, w, lane); am_stage_write(st, L, 0, w, lane); am_stage_load(st, kc, vc, 1, w, lane); am_stage_write(st, L, 1, w, lane);
        __syncthreads();
        const int cmax = (t - 31) >> 4;
        LAS float* PS = (LAS float*)(L + AM_PS) + (w * 8) * 128; LAS float* IMP = (LAS float*)(L + AM_IMP) + (w * 8) * 32;
        float l = 0.f, inv = 0.f;
#pragma unroll 1
        for (int pass = 0; pass < 2; ++pass) {
#pragma unroll 1
            for (int tile = 0; tile < 2; ++tile) {
                const int c0 = 64 * tile + r32, c1 = c0 + 32, e0 = 16 * c0 + 31, e1 = 16 * c1 + 31;
                const bf16x8v ka0 = am_kaug(hi == 0 ? pkbf((float)(e0 & 63), (float)(e0 & 63)) : 0u, hi == 0 ? pkbf((float)((e0 >> 6) - jq), (float)((e0 >> 6) - jq)) : 0u, kw2);
                const bf16x8v ka1 = am_kaug(hi == 0 ? pkbf((float)(e1 & 63), (float)(e1 & 63)) : 0u, hi == 0 ? pkbf((float)((e1 >> 6) - jq), (float)((e1 >> 6) - jq)) : 0u, kw2);
                f32x16 p0, p1;
                am_qkt(p0, p1, (lds_cp)(L + AM_K + tile * 8192), qr, ka0, ka1, r32, hi);
#pragma unroll
                for (int i = 0; i < 16; ++i) { const int ca = 64 * tile + crow(i, hi), cb2 = ca + 32;
                    p0[i] = (ca <= cmax && ca <= 126) ? __builtin_amdgcn_exp2f(p0[i]) : 0.f; p1[i] = (cb2 <= cmax && cb2 <= 126) ? __builtin_amdgcn_exp2f(p1[i]) : 0.f; }
                if (pass == 0) {
#pragma unroll
                    for (int i = 0; i < 16; ++i) l += p0[i] + p1[i];
                } else {
#pragma unroll
                    for (int i = 0; i < 16; ++i) { p0[i] *= inv; p1[i] *= inv; }
#pragma unroll
                    for (int half = 0; half < 2; ++half)
#pragma unroll
                        for (int k = 0; k < 4; ++k) { f32x4 s4;
#pragma unroll
                            for (int e = 0; e < 4; ++e) { float x = half == 0 ? p0[4 * k + e] : p1[4 * k + e]; x += __shfl_xor(x, 1); x += __shfl_xor(x, 2); s4[e] = x; }
                            if (rh == 0) *(LAS f32x4*)(PS + qloc * 128 + 64 * tile + 32 * half + 8 * k + 4 * hi) = s4; }
                    am_pv(o, vb0 + tile * 8192, am_pack8(p0, 0), am_pack8(p0, 8), am_pack8(p1, 0), am_pack8(p1, 8));
                }
            }
            if (pass == 0) { l += __shfl_xor(l, 32); inv = l > 0.f ? 1.0f / l : 0.f; }
        }
        fin[0] = zz; fin[1] = zz; am_fold(fin, o, g_cmp, rsw, r32, hi); o[0] = zz; o[1] = zz;
        asm volatile("s_waitcnt lgkmcnt(0)" ::: "memory");
        {
            const int q2 = lane >> 3, jb = (lane & 7) * 4; const volatile LAS float* ps = PS + q2 * 128; volatile LAS float* im = IMP + q2 * 32;
#pragma unroll
            for (int jj = 0; jj < 4; ++jj) { const int j = jb + jj; float imp = ps[4 * j] + ps[4 * j + 1] + ps[4 * j + 2] + 0.5f * ps[4 * j + 3] + (j > 0 ? 0.5f * ps[4 * j - 1] : 0.f);
                if (j == 0 || j == jq || j == jq - 1) imp += 1e4f; im[j] = j <= jq ? imp : -1.0f; }
            asm volatile("s_waitcnt lgkmcnt(0)" ::: "memory");
            unsigned m = 0u;
#pragma unroll
            for (int jj = 0; jj < 4; ++jj) { const int j = jb + jj; const float v = im[j]; int rank = 0;
#pragma unroll 8
                for (int o2 = 0; o2 < 32; ++o2) { const float vo = im[o2]; rank += (vo > v || (vo == v && o2 < j)) ? 1 : 0; }
                if (rank < 16) m |= 1u << j; }
            m |= __shfl_xor(m, 1); m |= __shfl_xor(m, 2); m |= __shfl_xor(m, 4);
            selm = __shfl(m, 8 * qloc);
        }
        __syncthreads();
    }
    unsigned anysel = selm; anysel |= __shfl_xor(anysel, 4); anysel |= __shfl_xor(anysel, 8); anysel |= __shfl_xor(anysel, 16); anysel = __builtin_amdgcn_readfirstlane(anysel);
    const bf16* ks = KVg + ((size_t)2 << 21) + (size_t)bg * SEQ * 64; const bf16* vs = KVg + ((size_t)3 << 21) + (size_t)bg * SEQ * 64;
    const bf16* kwn = KVg + ((size_t)4 << 21) + (size_t)bg * SEQ * 64; const bf16* vwn = KVg + ((size_t)5 << 21) + (size_t)bg * SEQ * 64;
    const int nsel = jq + 1, jw0 = jq >= 8 ? jq - 8 : 0, nwin = jq - jw0 + 1, nst = nsel + nwin;
    float l = 0.f;
    am_stage_load(st, ks, vs, 0, w, lane); am_stage_write(st, L, 0, w, lane);
    if (nst > 1) { if (1 < nsel) am_stage_load(st, ks, vs, 1, w, lane); else am_stage_load(st, kwn, vwn, jw0, w, lane); }
    __syncthreads();
#pragma unroll 1
    for (int s = 0; s < nst; ++s) {
        const bool win = s >= nsel; const int j = win ? jw0 + (s - nsel) : s; const int slot = s & 1;
        if (win && s == nsel) { am_fold(fin, o, (l + __shfl_xor(l, 32)) > 0.f ? g_sel / (l + __shfl_xor(l, 32)) : 0.f, rsw, r32, hi); o[0] = zz; o[1] = zz; l = 0.f; }
        if (win || ((anysel >> j) & 1u)) {
            const float wr = (float)(j - jq); const unsigned kw1 = hi == 0 ? pkbf(wr, wr) : 0u;
            if (hi == 0) { v4u qa = (v4u){qa0, qa1, (win || ((selm >> j) & 1u)) ? qa2_on : qa2_off, 0u}; qr[4] = __builtin_bit_cast(bf16x8v, qa); }
            f32x16 p0, p1;
            am_qkt(p0, p1, (lds_cp)(L + AM_K + slot * 8192), qr, am_kaug(kw0a, kw1, kw2), am_kaug(kw0b, kw1, kw2), r32, hi);
            const bool diag = (j == jq), edge = win && (jq >= 8) && (j == jw0);
            if (diag || edge) {
#pragma unroll
                for (int i = 0; i < 16; ++i) { const int kv0 = crow(i, hi), kv1 = kv0 + 32;
                    const bool bad0 = diag ? (kv0 > tl) : (kv0 <= tl), bad1 = diag ? (kv1 > tl) : (kv1 <= tl);
                    if (bad0) p0[i] = -1e30f; if (bad1) p1[i] = -1e30f; } }
#pragma unroll
            for (int i = 0; i < 16; ++i) { p0[i] = __builtin_amdgcn_exp2f(p0[i]); p1[i] = __builtin_amdgcn_exp2f(p1[i]); l += p0[i] + p1[i]; }
            am_pv(o, vb0 + slot * 8192, am_pack8(p0, 0), am_pack8(p0, 8), am_pack8(p1, 0), am_pack8(p1, 8));
        }
        if (s + 1 < nst) am_stage_write(st, L, slot ^ 1, w, lane);
        __syncthreads();
        if (s + 2 < nst) { if (s + 2 < nsel) am_stage_load(st, ks, vs, s + 2, w, lane); else am_stage_load(st, kwn, vwn, jw0 + (s + 2 - nsel), w, lane); }
    }
    { const float lt = l + __shfl_xor(l, 32); am_fold(fin, o, lt > 0.f ? g_win / lt : 0.f, rsw, r32, hi); }
    bf16* O = (bf16*)(F.ws + WS_A);
#pragma unroll
    for (int i = 0; i < 16; ++i) { const int rho = crow(i, hi); const size_t orow = (size_t)b * SEQ + 64 * jq + 8 * w + (rho >> 2); bf16* op = O + orow * 1024 + (4 * g + (rho & 3)) * 64 + r32;
        op[0] = (bf16)f2bf(fin[0][i]); op[32] = (bf16)f2bf(fin[1][i]); }
}

constexpr int GM_V = 0, GM_W = 65536, GM_ST = 131072;
__device__ __forceinline__ void gmlp_item(Frame& F, int io, int item) {
    const int tid = F.tid; const int g = item & 7, bc = item >> 3; const size_t row0 = (size_t)bc * 128;
    LAS bf16* Vs = (LAS bf16*)(F.lds + GM_V); LAS float* Wt = (LAS float*)(F.lds + GM_W); LAS float* ST = (LAS float*)(F.lds + GM_ST);
    bf16* U = (bf16*)(F.ws + WS_U); const bf16* V = (const bf16*)(F.ws + WS_V); const float* STg = (const float*)(F.ws + WS_ST);
    const float* lnw = inp(F, I_LNW) + (size_t)io * 2048 + g * 256; const float* lnb = inp(F, I_LNB) + (size_t)io * 2048 + g * 256;
    const float* wsg = inp(F, I_WS) + ((size_t)io * 8 + g) * 128 * 128; const float* bsg = inp(F, I_BS) + ((size_t)io * 8 + g) * 128;
    __syncthreads();
    if (tid < 128) { const float* p = STg + (row0 + tid) * 64; float s = 0.f, ss = 0.f;
        for (int k = 0; k < 32; ++k) { s += p[2 * k]; ss += p[2 * k + 1]; }
        const float mean = s * (1.f / 2048.f), var = ss * (1.f / 2048.f) - mean * mean; ST[2 * tid] = mean; ST[2 * tid + 1] = 1.0f / sqrtf(fmaxf(var, 0.f) + LN_EPS); }
    for (int idx = tid; idx < 128 * 128; idx += 512) { const int t = idx >> 7, s = idx & 127; Wt[s * 128 + t] = (s <= t) ? wsg[idx] : 0.f; }
    __syncthreads();
    for (int idx = tid; idx < 128 * 32; idx += 512) { const int s = idx >> 5, c8 = (idx & 31) * 8; const v4u x = *(const v4u*)(V + (row0 + s) * 2048 + g * 256 + c8);
        const float mean = ST[2 * s], rstd = ST[2 * s + 1]; const float* lw = lnw + c8; const float* lb = lnb + c8;
        float f[8] = {bflo(x.x), bfhi(x.x), bflo(x.y), bfhi(x.y), bflo(x.z), bfhi(x.z), bflo(x.w), bfhi(x.w)};
#pragma unroll
        for (int e = 0; e < 8; ++e) f[e] = (f[e] - mean) * rstd * lw[e] + lb[e];
        *(LAS v4u*)(Vs + s * 256 + c8) = (v4u){pk2(f[0], f[1]), pk2(f[2], f[3]), pk2(f[4], f[5]), pk2(f[6], f[7])}; }
    __syncthreads();
    const int d = tid & 255, th = tid >> 8;
    for (int t4 = th * 64; t4 < th * 64 + 64; t4 += 4) {
        float a0 = 0.f, a1 = 0.f, a2 = 0.f, a3 = 0.f;
        for (int s = 0; s <= t4 + 3; ++s) { const float v = bf2f(Vs[s * 256 + d]); const f32x4 wv = *(const LAS f32x4*)(Wt + s * 128 + t4); a0 += wv.x * v; a1 += wv.y * v; a2 += wv.z * v; a3 += wv.w * v; }
        const float acc[4] = {a0, a1, a2, a3};
#pragma unroll
        for (int e = 0; e < 4; ++e) { const size_t o = (row0 + t4 + e) * 2048 + g * 256 + d; U[o] = (bf16)f2bf(bf2f(U[o]) * (acc[e] + bsg[t4 + e])); }
    }
}

enum Kind { K_PREP = 0, K_G1, K_E3, K_E4, K_E5, K_GY, K_RP, K_G3, K_G5, K_O2 };
constexpr int N_PHASES = 33;
struct Args { const float* in[22]; float* out; unsigned char* ws; int ph_lo, ph_hi; };

__global__ void __launch_bounds__(NWAVES * 64, 2) mk_fwd(Args args) {
    extern __shared__ __attribute__((aligned(16))) unsigned char lds_raw[];
    Frame F;
    F.lds = (LAS unsigned char*)(uintptr_t)0u  ; F.ws = args.ws; F.out = args.out;
    F.wave = __builtin_amdgcn_readfirstlane(threadIdx.x >> 6); F.G = gridDim.x; F.bid = blockIdx.x;
    volatile LAS unsigned* MISC = (volatile LAS unsigned*)((LAS unsigned char*)lds_raw + MISC_OFF);
    { const int t0 = threadIdx.x; if (t0 < 32) MISC[t0] = 0u;
      if (t0 >= 64 && t0 < 64 + 22) { const unsigned long long pv = (unsigned long long)args.in[t0 - 64]; MISC[32 + 2 * (t0 - 64)] = (unsigned)pv; MISC[33 + 2 * (t0 - 64)] = (unsigned)(pv >> 32); } }
    __syncthreads();
    const int wave0 = __builtin_amdgcn_readfirstlane(threadIdx.x >> 6);
    XcdBarrier bar = xcd_barrier_post((unsigned*)(F.ws + WS_CTL) + CW_BAR, MISC + 8);

    for (int p = args.ph_lo; p < args.ph_hi; ++p) {
        int L = 0, k = 0, kind = K_PREP, var = 0;
        if (p > 0) { const int q = p - 1; if (q < 9) { L = 0; k = q; } else if (q < 16) { L = 1; k = q - 9; } else if (q < 25) { L = 2; k = q - 16; } else { L = 3; k = q - 25; }
            if ((L & 1) == 0) { kind = (int)((0x657654321ull >> (4 * k)) & 15ull); var = (int)((0x110000000ull >> (4 * k)) & 15ull); }
            else { kind = (int)((0x6576598ull >> (4 * k)) & 15ull); var = (int)((0x1102200ull >> (4 * k)) & 15ull); } }
        { unsigned long long wsv = (unsigned long long)args.ws, outv = (unsigned long long)args.out; int wv = wave0, bidv = blockIdx.x, gv = gridDim.x;
          asm volatile("" : "+s"(wsv), "+s"(outv), "+s"(bidv), "+s"(gv), "+s"(wv));
          int tidv = (wv << 6) | flane(); asm volatile("" : "+v"(tidv));
          F.ws = (unsigned char*)wsv; F.out = (float*)outv; F.tid = tidv; F.lane = tidv & 63; F.wave = wv; F.G = gv; F.bid = bidv; }
        const int ie = L >> 1;
        unsigned char* wev = F.ws + WS_WEV + (size_t)ie * WEV_STRIDE; unsigned char* wod = F.ws + WS_WOD + (size_t)ie * WOD_STRIDE; unsigned char* wff = F.ws + WS_WFFN + (size_t)L * WFFN_STRIDE;
        switch (kind) {
        case K_PREP:
#ifndef NO_P0
            p0_prologue(F);
#endif
            break;
        case K_G1: {
#ifndef NO_K_G1
            pg8::Gemm g{(const bf16*)(F.ws + WS_A), (const bf16*)wev, M, EV_IN_PAD, D, D}; pg8::StaticOrder S; S.init(M, EV_IN_PAD, F.G, F.bid);
            pg8::EpiProj E{(bf16*)(F.ws + WS_Q), (bf16*)(F.ws + WS_KV), (bf16*)(F.ws + WS_Z), (bf16*)(F.ws + WS_XBC), (float*)(F.ws + WS_GLDT)};
            pg8::gemm_phase<pg8::EpiProj, pg8::StaticOrder, true, true>(F.lds, g, S, E, F.tid);
#endif
            } break;
        case K_E3: {
#ifndef NO_K_E3
            pg8::Gemm g{(const bf16*)(F.ws + WS_KV), (const bf16*)(wev + 8 * MiB), 4096, 512, 2048, 1024}; pg8::CmpOrder S{F.bid};
            pg8::EpiCmp E{(bf16*)(F.ws + WS_H1), (const float*)(F.ws + WS_SMALL) + ie * 512};
            pg8::gemm_phase<pg8::EpiCmp, pg8::CmpOrder, true, true>(F.lds, g, S, E, F.tid);
            for (int it = F.bid; it < 256; it += F.G) ssm_s1_item(F, ie, it);
#endif
            } break;
        case K_E4:
#ifndef NO_E4
            compress2(F, ie, 0);
#endif
            break;
        case K_E5: {
#ifndef NO_S3
            for (int it = F.bid; it < 256; it += F.G) ssm_s3_item(F, it);
#endif
#ifndef NO_E5
            for (int u = F.bid; u < 256; u += F.G) { const int bg = u & 15, s = u >> 4; attn_unit(F, bg, 31 - s); attn_unit(F, bg, s); }
#endif
            } break;
        case K_GY: {
#ifndef NO_K_GY
            const bf16* A = var == 0 ? (const bf16*)(F.ws + WS_A) : var == 1 ? (const bf16*)(F.ws + WS_T) : (const bf16*)(F.ws + WS_U);
            const bf16* W = var == 0 ? (const bf16*)(wev + 6 * MiB) : var == 1 ? (const bf16*)(wff + (size_t)5632 * 1024 * 2) : (const bf16*)(wod + 8 * MiB);
            const int K = var == 0 ? 1024 : var == 1 ? FFH : 2048; bf16* Y = (bf16*)(F.ws + (var == 0 ? WS_YEV : var == 1 ? WS_YFF : WS_YOD));
            pg8::Gemm g{A, W, M, D, K, K}; pg8::StaticOrder S; S.init(M, D, F.G, F.bid); pg8::EpiBf16Plain E{Y, D};
            pg8::gemm_phase<pg8::EpiBf16Plain, pg8::StaticOrder, true, true>(F.lds, g, S, E, F.tid);
#endif
            } break;
        case K_RP: {
            const bf16* Y = (const bf16*)(F.ws + (var == 0 ? WS_YEV : var == 1 ? WS_YFF : WS_YOD)); const bool mixer = (var != 1);
            const float* hin = (L == 0 && mixer) ? inp(F, I_X) : F.out; bf16* aout = (L == DEPTH - 1 && !mixer) ? nullptr : (bf16*)(F.ws + WS_A);
            rowpass(F, Y, hin, F.out, aout, inp(F, I_GAINS) + (L * 4 + (mixer ? 1 : 3)) * D); } break;
        case K_G3: {
#ifndef NO_K_G3
            pg8::Gemm g{(const bf16*)(F.ws + WS_A), (const bf16*)wff, M, 2 * FFH, D, D}; pg8::StaticOrder S; S.init(M, 2 * FFH, F.G, F.bid);
            pg8::EpiSwiGLU E{(bf16*)(F.ws + WS_T), FFH};
            pg8::gemm_phase<pg8::EpiSwiGLU, pg8::StaticOrder, true, true>(F.lds, g, S, E, F.tid);
#endif
            } break;
        case K_G5: {
#ifndef NO_K_G5
            pg8::Gemm g{(const bf16*)(F.ws + WS_A), (const bf16*)wod, M, 4096, D, D}; pg8::StaticOrder S; S.init(M, 4096, F.G, F.bid);
            pg8::EpiGelu E{(bf16*)(F.ws + WS_U), (bf16*)(F.ws + WS_V), (float*)(F.ws + WS_ST)};
            pg8::gemm_phase<pg8::EpiGelu, pg8::StaticOrder, true, true>(F.lds, g, S, E, F.tid);
#endif
            } break;
        case K_O2: {
#ifndef NO_O2
            for (int it = F.bid; it < 1024; it += F.G) gmlp_item(F, ie, it);
#endif
            } break;
        default: break;
        }
        if (p + 1 < args.ph_hi) xcd_barrier(bar, F.wave);
    }
}

#ifndef MK_PER_PHASE
#define MK_PER_PHASE 0
#endif
extern "C" void kernel_launch(void* const* d_in, const int* in_sizes, int n_in, void* d_out, int out_size, void* d_ws, size_t ws_size, hipStream_t stream) {
    static int grid = 0;
    if (grid == 0) {
        if (n_in != 22 || in_sizes[0] != M * D || out_size != M * D || ws_size < WS_END) { fprintf(stderr, "kernel_launch: unexpected shapes (n_in %d, in0 %d, out %d, ws %zu)\n", n_in, n_in > 0 ? in_sizes[0] : -1, out_size, ws_size); grid = -1; return; }
        int dev = 0, cus = 0, per_cu = 0;
        if (hipGetDevice(&dev) != hipSuccess || hipDeviceGetAttribute(&cus, hipDeviceAttributeMultiprocessorCount, dev) != hipSuccess) { grid = -1; return; }
        if (hipFuncSetAttribute((const void*)mk_fwd, hipFuncAttributeMaxDynamicSharedMemorySize, LDS_BYTES) != hipSuccess) { fprintf(stderr, "kernel_launch: hipFuncSetAttribute failed\n"); grid = -1; return; }
        if (hipOccupancyMaxActiveBlocksPerMultiprocessor(&per_cu, (const void*)mk_fwd, NWAVES * 64, LDS_BYTES) != hipSuccess || per_cu < 1) { fprintf(stderr, "kernel_launch: occupancy query says %d\n", per_cu); per_cu = 1; }
        (void)hipGetLastError();
        grid = cus;
        if (grid != 256) fprintf(stderr, "kernel_launch: %d CUs (built for 256)\n", grid);
    }
    if (grid < 0) return;
    Args a{};
    for (int i = 0; i < 22; ++i) a.in[i] = (const float*)d_in[i];
    a.out = (float*)d_out; a.ws = (unsigned char*)d_ws;
#if MK_PER_PHASE
    for (int p = 0; p < N_PHASES; ++p) { a.ph_lo = p; a.ph_hi = p + 1; hipLaunchKernelGGL(mk_fwd, dim3(grid), dim3(NWAVES * 64), LDS_BYTES, stream, a); }
#else
    (void)hipMemsetAsync((char*)d_ws + WS_CTL, 0, CTL_ZERO_BYTES, stream);
    a.ph_lo = 0; a.ph_hi = N_PHASES;
    hipLaunchKernelGGL(mk_fwd, dim3(grid), dim3(NWAVES * 64), LDS_BYTES, stream, a);
#endif
}
```

```cpp
#include <hip/hip_runtime.h>
#include <cstdio>
#include <cstdint>

namespace pg8 {
#define PG8_LAS __attribute__((address_space(3)))
typedef unsigned short bf16_t;
typedef short bf16x8 __attribute__((ext_vector_type(8)));
typedef float f32x4 __attribute__((ext_vector_type(4)));
typedef unsigned u32x4 __attribute__((ext_vector_type(4)));
typedef float f32x2 __attribute__((ext_vector_type(2)));
constexpr int BM = 256, BK = 64, HALF = 128, HTB = HALF * BK * 2  , STAGE_BYTES = 8 * HTB, NXCD = 8, WGM = 8;

__host__ __device__ __forceinline__ int lds_byte(int r, int c) { const int st = (r >> 4) * 2 + (c >> 5), rr = r & 15, cc = c & 31, ob = rr * 64 + cc * 2; return st * 1024 + (ob ^ (((ob >> 9) & 1) << 5)); }
__host__ __device__ __forceinline__ void stage_rc(int b, int& R, int& C) { const int st = b / 1024, sb = b % 1024, swz = sb ^ (((sb >> 9) & 1) << 5); R = (st >> 1) * 16 + swz / 64; C = (st & 1) * 32 + (swz % 64) / 2; }
__host__ __device__ __forceinline__ int perm32(int rho) { const int n = rho >> 4, i = rho & 15; return 8 * (i >> 2) + 4 * n + (i & 3); }

struct Unit { int pm, pn; };
struct Gemm { const bf16_t* A; const bf16_t* Bt; int M, N, K, lda; };

struct StaticOrder {
    int nM, nN, nwg, G, c;
    __host__ __device__ void init(int M, int N, int G_, int c_) { nM = M / BM; nN = N / BM; nwg = nM * nN; G = G_; c = c_; }
    __host__ __device__ bool next(int i, Unit& u) const {
        const long L = (long)i * G + c; if (L >= nwg) return false;
        int wgid = (int)L; { const int q = nwg / NXCD, r = nwg % NXCD, xcd = wgid % NXCD, off = wgid / NXCD; wgid = (xcd < r ? xcd * (q + 1) : r * (q + 1) + (xcd - r) * q) + off; }
        const int nig = WGM * nN, gid = wgid / nig, fm = gid * WGM, gsz = (nM - fm) < WGM ? (nM - fm) : WGM;
        u.pm = fm + ((wgid % nig) % gsz); u.pn = (wgid % nig) / gsz; return true;
    }
    __device__ __forceinline__ void a_ready(const Unit&) const {}
    __device__ __forceinline__ void done(const Unit&) const {}
};
struct CmpOrder {
    int c;
    __device__ bool next(int i, Unit& u) const { if (i > 0 || c >= 16) return false; u.pm = c; u.pn = c >> 3; return true; }
    __device__ __forceinline__ void a_ready(const Unit&) const {}
    __device__ __forceinline__ void done(const Unit&) const {}
};

__device__ __forceinline__ unsigned cvt_pk_bf16(float lo, float hi) { unsigned r; asm volatile("v_cvt_pk_bf16_f32 %0, %1, %2" : "=v"(r) : "v"(lo), "v"(hi)); return r; }
__device__ __forceinline__ f32x2 gelu_pk(f32x2 v) {
    const f32x2 av = __builtin_elementwise_abs(v), d = av * 0.2316418882f + 1.0f;
    f32x2 t; t.x = __builtin_amdgcn_rcpf(d.x); t.y = __builtin_amdgcn_rcpf(d.y);
    f32x2 q = t * 0.5307027145f + (-0.7265760135f); q = q * t + 0.7107068705f; q = q * t + (-0.142248368f); q = q * t + 0.127414796f; q = q * t;
    const f32x2 s = (v * v) * (-0.72134752044f);
    f32x2 e; e.x = __builtin_amdgcn_exp2f(s.x); e.y = __builtin_amdgcn_exp2f(s.y);
    const f32x2 m = v * (q * e), r = v - m;
    f32x2 o; o.x = v.x < 0.f ? m.x : r.x; o.y = v.y < 0.f ? m.y : r.y; return o;
}
__device__ __forceinline__ float silu_f(float x) { return x * __builtin_amdgcn_rcpf(1.0f + __builtin_amdgcn_exp2f(-1.4426950408889634f * x)); }
__device__ __forceinline__ u32x4 pack8(const f32x4 v0, const f32x4 v1) { u32x4 w; w.x = cvt_pk_bf16(v0[0], v0[1]); w.y = cvt_pk_bf16(v0[2], v0[3]); w.z = cvt_pk_bf16(v1[0], v1[1]); w.w = cvt_pk_bf16(v1[2], v1[3]); return w; }

struct EpiBf16Plain {
    static constexpr bool PERM = true, AFTER_DRAIN = false;
    bf16_t* O; int ldc;
    __device__ __forceinline__ void operator()(const f32x4 (&acc)[2][2][4][2], const Unit& u, int wr, int wc, int fr, int fq) const {
        const int row0 = u.pm * BM + wr * 64 + fr, col0 = u.pn * BM + wc * 32 + 8 * fq;
#pragma unroll
        for (int ai = 0; ai < 2; ++ai)
#pragma unroll
            for (int m = 0; m < 4; ++m) { bf16_t* rowp = O + (size_t)(row0 + ai * HALF + m * 16) * ldc + col0;
#pragma unroll
                for (int bj = 0; bj < 2; ++bj) *(u32x4*)(rowp + bj * HALF) = pack8(acc[ai][bj][m][0], acc[ai][bj][m][1]); }
    }
};
struct EpiProj {
    static constexpr bool PERM = true, AFTER_DRAIN = false;
    bf16_t* Q; bf16_t* KV; bf16_t* Z; bf16_t* XBC; float* GLDT;
    __device__ __forceinline__ void operator()(const f32x4 (&acc)[2][2][4][2], const Unit& u, int wr, int wc, int fr, int fq) const {
        const int row0 = u.pm * BM + wr * 64 + fr, pn = u.pn, cl = wc * 32 + 8 * fq;
        if (pn == 11) {
            if (wc == 0) {
#pragma unroll
                for (int ai = 0; ai < 2; ++ai)
#pragma unroll
                    for (int m = 0; m < 4; ++m) { float* rowp = GLDT + (size_t)(row0 + ai * HALF + m * 16) * 32 + 8 * fq;
                        *(f32x4*)(rowp) = acc[ai][0][m][0]; *(f32x4*)(rowp + 4) = acc[ai][0][m][1]; }
            }
            return;
        }
        bf16_t* base0; int stride, laneoff, halfstep;
        if (pn < 2) { base0 = Q + pn * 256; stride = 512; laneoff = cl; halfstep = HALF; }
        else if (pn < 5) { const int b = (u.pm * BM) >> 11; base0 = KV + ((size_t)((pn - 2) * 2) << 21) + (size_t)b * 131072; stride = 64; laneoff = (wc >> 1) * 131072 + (wc & 1) * 32 + 8 * fq; halfstep = 1 << 21; }
        else if (pn < 7) { base0 = Z + (pn - 5) * 256; stride = 512; laneoff = cl; halfstep = HALF; }
        else { base0 = XBC + (pn - 7) * 256; stride = 1024; laneoff = cl; halfstep = HALF; }
        const unsigned off0 = (unsigned)(row0 * stride + laneoff);
#pragma unroll
        for (int ai = 0; ai < 2; ++ai)
#pragma unroll
            for (int m = 0; m < 4; ++m) {
                const unsigned off = off0 + (unsigned)((ai * HALF + m * 16) * stride);
                *(u32x4*)(base0 + off) = pack8(acc[ai][0][m][0], acc[ai][0][m][1]);
                *(u32x4*)(base0 + halfstep + off) = pack8(acc[ai][1][m][0], acc[ai][1][m][1]);
                asm volatile("" ::: "memory");
            }
    }
};
struct EpiSwiGLU {
    static constexpr bool PERM = true, AFTER_DRAIN = false;
    bf16_t* T; int ldc;
    __device__ __forceinline__ void operator()(const f32x4 (&acc)[2][2][4][2], const Unit& u, int wr, int wc, int fr, int fq) const {
        const int row0 = u.pm * BM + wr * 64 + fr, col0 = u.pn * HALF + wc * 32 + 8 * fq;
#pragma unroll
        for (int ai = 0; ai < 2; ++ai)
#pragma unroll
            for (int m = 0; m < 4; ++m) {
                f32x4 v0, v1;
#pragma unroll
                for (int j = 0; j < 4; ++j) { v0[j] = silu_f(acc[ai][0][m][0][j]) * acc[ai][1][m][0][j]; v1[j] = silu_f(acc[ai][0][m][1][j]) * acc[ai][1][m][1][j]; }
                *(u32x4*)(T + (size_t)(row0 + ai * HALF + m * 16) * ldc + col0) = pack8(v0, v1);
            }
    }
};
struct EpiGelu {
    static constexpr bool PERM = true, AFTER_DRAIN = false;
    bf16_t* U; bf16_t* V; float* ST;
    __device__ __forceinline__ void operator()(const f32x4 (&acc)[2][2][4][2], const Unit& u, int wr, int wc, int fr, int fq) const {
        const int row0 = u.pm * BM + wr * 64 + fr, pn = u.pn;
        const bool isv = pn >= 8; bf16_t* base = isv ? V : U; const int col0 = (isv ? pn - 8 : pn) * BM + wc * 32 + 8 * fq;
#pragma unroll
        for (int ai = 0; ai < 2; ++ai)
#pragma unroll
            for (int m = 0; m < 4; ++m) {
                const int row = row0 + ai * HALF + m * 16; float s = 0.f, ss = 0.f;
#pragma unroll
                for (int bj = 0; bj < 2; ++bj) {
                    const f32x4 x0 = acc[ai][bj][m][0], x1 = acc[ai][bj][m][1];
                    const f32x2 a = gelu_pk((f32x2){x0[0], x0[1]}), b = gelu_pk((f32x2){x0[2], x0[3]}), c = gelu_pk((f32x2){x1[0], x1[1]}), d = gelu_pk((f32x2){x1[2], x1[3]});
                    s += (a.x + a.y) + (b.x + b.y) + (c.x + c.y) + (d.x + d.y);
                    ss += (a.x * a.x + a.y * a.y) + (b.x * b.x + b.y * b.y) + (c.x * c.x + c.y * c.y) + (d.x * d.x + d.y * d.y);
                    *(u32x4*)(base + (size_t)row * 2048 + col0 + bj * HALF) = pack8((f32x4){a.x, a.y, b.x, b.y}, (f32x4){c.x, c.y, d.x, d.y});
                }
                if (isv) {
                    s += __shfl_xor(s, 16); s += __shfl_xor(s, 32); ss += __shfl_xor(ss, 16); ss += __shfl_xor(ss, 32);
                    if (fq == 0) *(f32x2*)(ST + ((size_t)row * 32 + (pn - 8) * 4 + wc) * 2) = (f32x2){s, ss};
                }
            }
    }
};
struct EpiCmp {
    static constexpr bool PERM = true, AFTER_DRAIN = false;
    bf16_t* H1; const float* bias;
    __device__ __forceinline__ void operator()(const f32x4 (&acc)[2][2][4][2], const Unit& u, int wr, int wc, int fr, int fq) const {
        const int row0 = u.pm * BM + wr * 64 + fr, cl = wc * 32 + 8 * fq; const float* bs = bias + u.pn * 256;
#pragma unroll
        for (int bj = 0; bj < 2; ++bj) {
            const f32x4 b0 = *(const f32x4*)(bs + bj * HALF + cl), b1 = *(const f32x4*)(bs + bj * HALF + cl + 4);
#pragma unroll
            for (int ai = 0; ai < 2; ++ai)
#pragma unroll
                for (int m = 0; m < 4; ++m) {
                    f32x4 v0 = acc[ai][bj][m][0] + b0, v1 = acc[ai][bj][m][1] + b1;
#pragma unroll
                    for (int j = 0; j < 4; ++j) { v0[j] = silu_f(v0[j]); v1[j] = silu_f(v1[j]); }
                    *(u32x4*)(H1 + (size_t)(row0 + ai * HALF + m * 16) * 256 + bj * HALF + cl) = pack8(v0, v1);
                }
        }
    }
};

template <class Epi, class Sched, bool ALIGN_EPI = false, bool SP2 = false>
__device__ __forceinline__ void gemm_phase(PG8_LAS unsigned char* lds, const Gemm g, const Sched& S, const Epi& E, const int tid) {
    const int wid = __builtin_amdgcn_readfirstlane(tid >> 6), lane = tid & 63, wr = wid >> 2, wc = wid & 3, fr = lane & 15, fq = lane >> 4;
    const int K = g.K, nt = K / BK;
    unsigned voffA[2], voffB[2];
#pragma unroll
    for (int i = 0; i < 2; ++i) { int R, C; stage_rc(tid * 16 + i * 8192, R, C); const int Rb = Epi::PERM ? ((R & ~31) + perm32(R & 31)) : R;
        voffA[i] = (unsigned)(R * g.lda + C) * 2u; voffB[i] = (unsigned)(Rb * K + C) * 2u; }
    const size_t kstep = (size_t)(BK * 2);
    const size_t hstepB = (size_t)HALF * K * 2, hstepA = (size_t)HALF * g.lda * 2;
    const size_t tstepA = 2 * hstepA, tstepB = 2 * hstepB;
    const unsigned ldsw = (unsigned)wid * 1024u;
    const int aoff = lds_byte(wr * 64 + fr, fq * 8), boff = lds_byte(wc * 32 + fr, fq * 8);
#define PG8_SA(b, h) (((b) * 2 + (h)) * HTB)
#define PG8_SB(b, h) ((4 + (b) * 2 + (h)) * HTB)
#define PG8_STAGE(bufoff, gbase, voff) do { _Pragma("unroll") for (int _i = 0; _i < 2; ++_i) \
        __builtin_amdgcn_global_load_lds((const unsigned*)((const char*)(gbase) + (voff)[_i]), (PG8_LAS unsigned*)(lds + (bufoff) + ldsw + _i * 8192), 16, 0, 0); } while (0)
#define PG8_LDA(dst, b, h) do { _Pragma("unroll") for (int m = 0; m < 4; ++m) _Pragma("unroll") for (int k = 0; k < 2; ++k) dst[m][k] = *(const PG8_LAS bf16x8*)(lds + PG8_SA(b, h) + aoff + m * 2048 + k * 1024); } while (0)
#define PG8_LDB(dst, b, h) do { _Pragma("unroll") for (int n = 0; n < 2; ++n) _Pragma("unroll") for (int k = 0; k < 2; ++k) dst[n][k] = *(const PG8_LAS bf16x8*)(lds + PG8_SB(b, h) + boff + n * 2048 + k * 1024); } while (0)
#define PG8_MMA(ai, bj, At, Bt) do { __builtin_amdgcn_s_setprio(1); _Pragma("unroll") for (int m = 0; m < 4; ++m) _Pragma("unroll") for (int n = 0; n < 2; ++n) _Pragma("unroll") for (int k = 0; k < 2; ++k) \
        acc[ai][bj][m][n] = __builtin_amdgcn_mfma_f32_16x16x32_bf16(Bt[n][k], At[m][k], acc[ai][bj][m][n], 0, 0, 0); __builtin_amdgcn_s_setprio(0); } while (0)
#define PG8_WAIT_V(n) asm volatile("s_waitcnt vmcnt(" #n ")" ::: "memory")
#define PG8_WAIT_L(n) asm volatile("s_waitcnt lgkmcnt(" #n ")" ::: "memory")
#define PG8_BAR __builtin_amdgcn_s_barrier()
#define PG8_SCHED __builtin_amdgcn_sched_barrier(0)
    Unit cur, nxt; int ui = 0;
    if (!S.next(0, cur)) return;
    f32x4 acc[2][2][4][2];
#pragma unroll
    for (int a = 0; a < 2; ++a)
#pragma unroll
        for (int b = 0; b < 2; ++b)
#pragma unroll
            for (int m = 0; m < 4; ++m)
#pragma unroll
                for (int n = 0; n < 2; ++n) acc[a][b][m][n] = (f32x4){0.f, 0.f, 0.f, 0.f};
    bf16x8 At[4][2], B0[2][2], B1[2][2];
    const char* cA = (const char*)g.A + (size_t)cur.pm * tstepA; const char* cB = (const char*)g.Bt + (size_t)cur.pn * tstepB;
    S.a_ready(cur);
    if constexpr (SP2) {
        PG8_STAGE(PG8_SB(0, 0), cB, voffB); PG8_STAGE(PG8_SB(0, 1), cB + hstepB, voffB); PG8_STAGE(PG8_SA(0, 0), cA, voffA); PG8_STAGE(PG8_SA(0, 1), cA + hstepA, voffA);
        if (wr == 1) PG8_BAR;
        PG8_WAIT_V(2); PG8_BAR;
        PG8_STAGE(PG8_SB(1, 0), cB + kstep, voffB); PG8_STAGE(PG8_SA(1, 0), cA + kstep, voffA); PG8_STAGE(PG8_SB(1, 1), cB + hstepB + kstep, voffB);
        PG8_WAIT_V(6); PG8_BAR;
    } else {
        PG8_STAGE(PG8_SB(0, 0), cB, voffB); PG8_STAGE(PG8_SA(0, 0), cA, voffA); PG8_STAGE(PG8_SB(0, 1), cB + hstepB, voffB); PG8_STAGE(PG8_SA(0, 1), cA + hstepA, voffA);
        if (wr == 1) PG8_BAR;
        PG8_WAIT_V(4); PG8_BAR;
        PG8_STAGE(PG8_SB(1, 0), cB + kstep, voffB); PG8_STAGE(PG8_SA(1, 0), cA + kstep, voffA); PG8_STAGE(PG8_SB(1, 1), cB + hstepB + kstep, voffB);
        PG8_WAIT_V(6); PG8_BAR;
    }
    for (;;) {
        const bool has_next = S.next(ui + 1, nxt);
        const char* nA = has_next ? (const char*)g.A + (size_t)nxt.pm * tstepA : cA; const char* nB = has_next ? (const char*)g.Bt + (size_t)nxt.pn * tstepB : cB;
        for (int t = 0; t < nt; t += 2) {
            const bool last = (t == nt - 2);
            const char* a1 = cA + (size_t)(t + 1) * kstep;
            const char* a2 = last ? nA : cA + (size_t)(t + 2) * kstep; const char* b2 = last ? nB : cB + (size_t)(t + 2) * kstep;
            const char* a3 = a2 + kstep; const char* b3 = b2 + kstep;
            if (last && has_next) S.a_ready(nxt);
            if constexpr (SP2) {
            PG8_LDB(B0, 0, 0); PG8_LDB(B1, 0, 1); PG8_SCHED; PG8_LDA(At, 0, 0); PG8_STAGE(PG8_SA(1, 1), a1 + hstepA, voffA);
            PG8_WAIT_V(8); PG8_WAIT_L(0); PG8_BAR; PG8_MMA(0, 0, At, B0); PG8_MMA(0, 1, At, B1); PG8_BAR; PG8_SCHED;
            PG8_LDA(At, 0, 1); PG8_STAGE(PG8_SB(0, 0), b2, voffB); PG8_STAGE(PG8_SB(0, 1), b2 + hstepB, voffB); PG8_STAGE(PG8_SA(0, 0), a2, voffA);
            PG8_WAIT_V(8); PG8_WAIT_L(0); PG8_BAR; PG8_MMA(1, 0, At, B0); PG8_MMA(1, 1, At, B1); PG8_BAR; PG8_SCHED;
            PG8_LDB(B0, 1, 0); PG8_LDB(B1, 1, 1); PG8_SCHED; PG8_LDA(At, 1, 0); PG8_STAGE(PG8_SA(0, 1), a2 + hstepA, voffA);
            PG8_WAIT_V(8); PG8_WAIT_L(0); PG8_BAR; PG8_MMA(0, 0, At, B0); PG8_MMA(0, 1, At, B1); PG8_BAR; PG8_SCHED;
            PG8_LDA(At, 1, 1); PG8_STAGE(PG8_SB(1, 0), b3, voffB); PG8_STAGE(PG8_SB(1, 1), b3 + hstepB, voffB); PG8_STAGE(PG8_SA(1, 0), a3, voffA);
            PG8_WAIT_V(8); PG8_WAIT_L(0); PG8_BAR; PG8_MMA(1, 0, At, B0); PG8_MMA(1, 1, At, B1); PG8_BAR; PG8_SCHED;
            } else {
            PG8_LDB(B0, 0, 0); PG8_SCHED; PG8_LDA(At, 0, 0); PG8_STAGE(PG8_SA(1, 1), a1 + hstepA, voffA);
            PG8_WAIT_L(8); PG8_BAR; PG8_WAIT_L(0); PG8_MMA(0, 0, At, B0); PG8_BAR; PG8_SCHED;
            PG8_LDB(B1, 0, 1); PG8_STAGE(PG8_SB(0, 0), b2, voffB);
            PG8_BAR; PG8_WAIT_L(0); PG8_MMA(0, 1, At, B1); PG8_BAR;
            PG8_LDA(At, 0, 1); PG8_STAGE(PG8_SA(0, 0), a2, voffA);
            PG8_BAR; PG8_WAIT_L(0); PG8_MMA(1, 0, At, B0); PG8_BAR; PG8_SCHED;
            PG8_STAGE(PG8_SB(0, 1), b2 + hstepB, voffB);
            PG8_WAIT_V(6); PG8_BAR; PG8_MMA(1, 1, At, B1); PG8_BAR;
            PG8_LDB(B0, 1, 0); PG8_SCHED; PG8_LDA(At, 1, 0); PG8_STAGE(PG8_SA(0, 1), a2 + hstepA, voffA);
            PG8_WAIT_L(8); PG8_BAR; PG8_WAIT_L(0); PG8_MMA(0, 0, At, B0); PG8_BAR; PG8_SCHED;
            PG8_LDB(B1, 1, 1); PG8_STAGE(PG8_SB(1, 0), b3, voffB);
            PG8_BAR; PG8_WAIT_L(0); PG8_MMA(0, 1, At, B1); PG8_BAR;
            PG8_LDA(At, 1, 1); PG8_STAGE(PG8_SA(1, 0), a3, voffA);
            PG8_BAR; PG8_WAIT_L(0); PG8_MMA(1, 0, At, B0); PG8_BAR; PG8_SCHED;
            PG8_STAGE(PG8_SB(1, 1), b3 + hstepB, voffB);
            PG8_WAIT_V(6); PG8_BAR; PG8_MMA(1, 1, At, B1); PG8_BAR;
            }
        }
        if constexpr (ALIGN_EPI) { if (wr == 0) PG8_BAR; }
        if constexpr (!Epi::AFTER_DRAIN) { E(acc, cur, wr, wc, fr, fq); S.done(cur); }
        if (!has_next) break;
#pragma unroll
        for (int a = 0; a < 2; ++a)
#pragma unroll
            for (int b = 0; b < 2; ++b)
#pragma unroll
                for (int m = 0; m < 4; ++m)
#pragma unroll
                    for (int n = 0; n < 2; ++n) acc[a][b][m][n] = (f32x4){0.f, 0.f, 0.f, 0.f};
        cur = nxt; cA = nA; cB = nB; ++ui;
        if constexpr (ALIGN_EPI) { if (wr == 1) PG8_BAR; }
    }
    PG8_WAIT_V(0);
    if constexpr (!ALIGN_EPI) { if (wr == 0) PG8_BAR; }
    PG8_BAR;
    if constexpr (Epi::AFTER_DRAIN) { E.fused(acc, cur, wr, wc, fr, fq, lds, wid, lane); S.done(cur); }
#undef PG8_SA
#undef PG8_SB
#undef PG8_STAGE
#undef PG8_LDA
#undef PG8_LDB
#undef PG8_MMA
#undef PG8_WAIT_V
#undef PG8_WAIT_L
#undef PG8_BAR
#undef PG8_SCHED
}
}

constexpr int NWAVES = 8;
constexpr int BATCH = 8, SEQ = 2048, D = 1024, M = BATCH * SEQ, FFH = 2816, DEPTH = 4;
constexpr int EV_IN = 2848, EV_IN_PAD = 3072;
constexpr float RMS_EPS = 1e-6f, LN_EPS = 1e-5f;

constexpr size_t MiB = 1u << 20;
constexpr size_t WS_CTL = 0, CTL_ZERO_BYTES = 64 * 1024;
constexpr size_t WS_SMALL = 1 * MiB;
constexpr size_t WS_WFFN = 2 * MiB, WFFN_STRIDE = 17301504;
constexpr size_t WS_WEV = 68 * MiB, WEV_STRIDE = 10 * MiB;
constexpr size_t WS_WOD = 88 * MiB, WOD_STRIDE = 12 * MiB;
constexpr size_t WS_A = 112 * MiB;
constexpr size_t WS_BIG = 144 * MiB;
constexpr size_t WS_Q = WS_BIG, WS_KV = WS_BIG + 16 * MiB, WS_Z = WS_BIG + 40 * MiB, WS_XBC = WS_BIG + 56 * MiB, WS_GLDT = WS_BIG + 88 * MiB, WS_YD = WS_BIG + 90 * MiB  ,
                 WS_SST = WS_BIG + 106 * MiB  , WS_CCONV = WS_BIG + 122 * MiB  , WS_H1 = WS_BIG + 130 * MiB, WS_KCB = WS_BIG + 132 * MiB, WS_YEV = WS_BIG;
constexpr size_t WS_ACSG = WS_SMALL + 64 * 1024  , WS_ATOT = WS_SMALL + 640 * 1024  ;
constexpr size_t WS_T = WS_BIG, WS_YFF = WS_BIG + 88 * MiB;
constexpr size_t WS_U = WS_BIG, WS_V = WS_BIG + 64 * MiB, WS_ST = WS_BIG + 128 * MiB, WS_YOD = WS_BIG + 64 * MiB;
constexpr size_t WS_END = 280 * MiB;
constexpr int CW_BAR = 4096;

constexpr int SCR_BYTES = 152 * 1024;
constexpr int MISC_OFF = SCR_BYTES;
constexpr int LDS_BYTES = SCR_BYTES + 512;

#define GAS __attribute__((address_space(1)))
#define LAS __attribute__((address_space(3)))
typedef unsigned short bf16;
typedef unsigned v4u __attribute__((ext_vector_type(4)));
typedef unsigned v2u __attribute__((ext_vector_type(2)));
typedef float f32x4 __attribute__((ext_vector_type(4)));
typedef float f32x2 __attribute__((ext_vector_type(2)));
typedef GAS unsigned gu32;
#define RLX_AGENT __ATOMIC_RELAXED, __HIP_MEMORY_SCOPE_AGENT
#define LDS_WAIT() asm volatile("s_waitcnt lgkmcnt(0)" ::: "memory")
#define VM_WAIT() asm volatile("s_waitcnt vmcnt(0)" ::: "memory")
__device__ __forceinline__ unsigned f2bf(float f) { unsigned u = __builtin_bit_cast(unsigned, f); return (u + 0x7fffu + ((u >> 16) & 1u)) >> 16; }
__device__ __forceinline__ unsigned pk2(float lo, float hi) { return f2bf(lo) | (f2bf(hi) << 16); }
__device__ __forceinline__ float bflo(unsigned w) { return __builtin_bit_cast(float, w << 16); }
__device__ __forceinline__ float bfhi(unsigned w) { return __builtin_bit_cast(float, w & 0xffff0000u); }
__device__ __forceinline__ float bf2f(bf16 h) { return __builtin_bit_cast(float, (unsigned)h << 16); }
__device__ __forceinline__ float wave_sum(float v) {
#pragma unroll
    for (int o = 1; o < 64; o <<= 1) v += __shfl_xor(v, o);
    return v;
}
__device__ __forceinline__ float wave_max(float v) {
#pragma unroll
    for (int o = 1; o < 64; o <<= 1) v = fmaxf(v, __shfl_xor(v, o));
    return v;
}
__device__ __forceinline__ float silu_f(float x) { return x / (1.0f + __expf(-x)); }
__device__ __forceinline__ float sigmoid_f(float x) { return 1.0f / (1.0f + __expf(-x)); }

__device__ __forceinline__ int flane() { return (int)__builtin_amdgcn_mbcnt_hi(~0u, __builtin_amdgcn_mbcnt_lo(~0u, 0u)); }
#define XB_TMO      128
#define XB_XCNT(j)  (256  + 64 * (j))
#define XB_XSUB(j)  (1280 + 64 * (j))
#define XB_XGEN(j)  (2304 + 64 * (j))
#define XB_TOP      3328
#define XB_TOPGEN   3392
#define XCD_BAR_WORDS 3456
#define XB_SPIN_CAP (1u << 22)

__device__ __forceinline__ unsigned xb_ld(unsigned* p)              { return __hip_atomic_load(p, __ATOMIC_RELAXED, __HIP_MEMORY_SCOPE_AGENT); }
__device__ __forceinline__ unsigned xb_add(unsigned* p, unsigned v) { return __hip_atomic_fetch_add(p, v, __ATOMIC_RELAXED, __HIP_MEMORY_SCOPE_AGENT); }
__device__ __forceinline__ unsigned xb_xcc_id() { return (unsigned)__builtin_amdgcn_s_getreg((3 << 11) | 20) & 0xFu; }
#define XB_SPIN(cond, bar) do { unsigned _sp = 0; while (cond) { __builtin_amdgcn_s_sleep(1); \
    if ((++_sp & 255u) == 0u) { if (xb_ld(&(bar)[XB_TMO])) break; if (_sp > XB_SPIN_CAP) { atomicAdd(&(bar)[XB_TMO], 1u); break; } } } } while (0)

struct XcdBarrier { unsigned* bar; unsigned x; volatile LAS unsigned* st; };
__device__ __forceinline__ XcdBarrier xcd_barrier_post(unsigned* bar, volatile LAS unsigned* st) {
    XcdBarrier b; b.bar = bar; b.x = xb_xcc_id(); b.st = st;
    if (threadIdx.x == 0) (void)xb_add(&bar[XB_XCNT(b.x)], 1u);
    return b;
}
__device__ __forceinline__ void xcd_barrier_complete(unsigned* bar, unsigned x, unsigned& nloc, unsigned& nx) {
    const unsigned G = gridDim.x * gridDim.y * gridDim.z;
    unsigned sum, cnt, mine, sp = 0u;
    for (;;) {
        sum = 0u; cnt = 0u; mine = 0u;
#pragma unroll
        for (unsigned j = 0; j < 16; ++j) { const unsigned c = xb_ld(&bar[XB_XCNT(j)]); sum += c; cnt += (c > 0u) ? 1u : 0u; mine = (j == x) ? c : mine; }
        if (sum == G) break;
        __builtin_amdgcn_s_sleep(1);
        if ((++sp & 255u) == 0u) { if (xb_ld(&bar[XB_TMO])) break; if (sp > XB_SPIN_CAP) { atomicAdd(&bar[XB_TMO], 1u); break; } }
    }
    nloc = mine > 0u ? mine : 1u; nx = cnt > 0u ? cnt : 1u;
}
__device__ __forceinline__ void xcd_barrier(const XcdBarrier& b, const int wave) {
    asm volatile("s_waitcnt vmcnt(0)" ::: "memory");
    __syncthreads();
    if (wave == 0 && flane() == 0) {
        unsigned* bar = b.bar;
        __builtin_amdgcn_s_waitcnt(0);
        unsigned nloc = b.st[0], nx = b.st[1];
        if (nloc == 0u) { xcd_barrier_complete(bar, b.x, nloc, nx); b.st[0] = nloc; b.st[1] = nx; }
        const unsigned old = xb_add(&bar[XB_XSUB(b.x)], 1u);
        const unsigned gen = old / nloc;
        if (old + 1u == (gen + 1u) * nloc) {
            __builtin_amdgcn_fence(__ATOMIC_RELEASE, "agent");
            asm volatile("s_waitcnt vmcnt(0)" ::: "memory");
            const unsigned og = xb_add(&bar[XB_TOP], 1u);
            const unsigned tg = og / nx;
            if (og + 1u == (tg + 1u) * nx) xb_add(&bar[XB_TOPGEN], 1u);
            else XB_SPIN(xb_ld(&bar[XB_TOPGEN]) == tg, bar);
            __builtin_amdgcn_fence(__ATOMIC_ACQUIRE, "agent");
            xb_add(&bar[XB_XGEN(b.x)], 1u);
            asm volatile("s_waitcnt vmcnt(0)" ::: "memory");
        } else {
            XB_SPIN(xb_ld(&bar[XB_XGEN(b.x)]) == gen, bar);
            __builtin_amdgcn_fence(__ATOMIC_ACQUIRE, "agent");
            asm volatile("s_waitcnt vmcnt(0)" ::: "memory");
        }
    }
    __syncthreads();
}

struct Frame {
    LAS unsigned char* lds;
    unsigned char* ws;
    int tid, lane, wave, G, bid;
    float* out;
};

enum InIdx { I_X = 0, I_GAINS, I_WG, I_WU, I_WD, I_EVIN, I_EVOUT, I_PE, I_CW1, I_CW2, I_CONVW, I_CONVB, I_DTB, I_ALOG, I_DSKIP, I_SNORM, I_ODIN, I_LNW, I_LNB, I_WS, I_BS, I_ODOUT };

__device__ __forceinline__ const float* inp(const Frame& F, int i) {
    volatile LAS unsigned* t = (volatile LAS unsigned*)(F.lds + MISC_OFF) + 32 + 2 * i;
    const unsigned lo = __builtin_amdgcn_readfirstlane(t[0]), hi = __builtin_amdgcn_readfirstlane(t[1]);
    return (const float*)(((unsigned long long)hi << 32) | lo);
}
struct TJob { const float* W; int K, N; bf16* dst; int mode; const float* gain; int gain_lo; int row_off; };
__device__ __forceinline__ int evin_row(int n) {
    if (n < 1280) return n;
    if (n < 1304) return 2816 + (n - 1280);
    if (n < 1816) return 1280 + (n - 1304);
    if (n < 2840) return 1792 + (n - 1816);
    return 2840 + (n - 2840);
}
__device__ __forceinline__ void transpose_item(const TJob& J, int local, LAS float* scr, int lane) {
    const int nblk = J.N / 32, kb = local / nblk, nb = local % nblk, k0 = 64 * kb, n0 = 32 * nb;
#pragma unroll 8
    for (int i = 0; i < 32; ++i) { const int kk = 2 * i + (lane >> 5), k = k0 + kk; float g = 1.0f; if (J.gain != nullptr && k >= J.gain_lo) g = J.gain[k];
        scr[kk * 33 + (lane & 31)] = J.W[(size_t)k * J.N + n0 + (lane & 31)] * g; }
    LDS_WAIT(); asm volatile("" ::: "memory");
    const int c = lane & 7;
#pragma unroll
    for (int j = 0; j < 4; ++j) { const int n = (lane >> 3) + 8 * j, nn = n0 + n; const LAS float* s = scr + (8 * c) * 33 + n;
        int dr; float sc = 1.0f;
        if (J.mode == 0) dr = J.row_off + nn; else if (J.mode == 1) dr = 256 * (nn >> 7) + (nn & 127) + J.row_off; else { dr = evin_row(nn); if (nn < 512) sc = 0.125f * 1.4426950408889634f; }
        v4u o; o.x = pk2(s[0 * 33] * sc, s[1 * 33] * sc); o.y = pk2(s[2 * 33] * sc, s[3 * 33] * sc); o.z = pk2(s[4 * 33] * sc, s[5 * 33] * sc); o.w = pk2(s[6 * 33] * sc, s[7 * 33] * sc);
        *(v4u*)(J.dst + (size_t)dr * J.K + k0 + 8 * c) = o; }
    LDS_WAIT(); asm volatile("" ::: "memory");
}
constexpr int IT_FFN = 16 * 88, IT_EVIN = 16 * 89, IT_EVOUT = 16 * 32, IT_W1 = 32 * 8, IT_ODIN = 16 * 128, IT_ODOUT = 32 * 32;
constexpr int IT_EV = IT_EVIN + IT_EVOUT + 2 * IT_W1, IT_OD = IT_ODIN + IT_ODOUT;
constexpr int N_TRANS = 12 * IT_FFN + 2 * IT_EV + 2 * IT_OD;
__device__ __forceinline__ void get_job(Frame& F, int it, TJob& J, int& local) {
    if (it < 12 * IT_FFN) { const int L = it / (3 * IT_FFN), r = it % (3 * IT_FFN), w = r / IT_FFN; local = r % IT_FFN;
        bf16* base = (bf16*)(F.ws + WS_WFFN + (size_t)L * WFFN_STRIDE);
        if (w == 0) J = TJob{inp(F, I_WG) + (size_t)L * D * FFH, D, FFH, base, 1, inp(F, I_GAINS) + (L * 4 + 2) * D, 0, 0};
        else if (w == 1) J = TJob{inp(F, I_WU) + (size_t)L * D * FFH, D, FFH, base, 1, inp(F, I_GAINS) + (L * 4 + 2) * D, 0, 128};
        else J = TJob{inp(F, I_WD) + (size_t)L * FFH * D, FFH, D, base + (size_t)5632 * 1024, 0, nullptr, 0, 0};
        return; }
    it -= 12 * IT_FFN;
    if (it < 2 * IT_EV) { const int i = it / IT_EV; int r = it % IT_EV; unsigned char* base = F.ws + WS_WEV + (size_t)i * WEV_STRIDE;
        if (r < IT_EVIN) { local = r; J = TJob{inp(F, I_EVIN) + (size_t)i * D * EV_IN, D, EV_IN, (bf16*)base, 2, inp(F, I_GAINS) + (2 * i * 4 + 0) * D, 0, 0}; return; } r -= IT_EVIN;
        if (r < IT_EVOUT) { local = r; J = TJob{inp(F, I_EVOUT) + (size_t)i * D * D, D, D, (bf16*)(base + 6 * MiB), 0, inp(F, I_SNORM) + i * 512 - 512, 512, 0}; return; } r -= IT_EVOUT;
        const int kv = r / IT_W1; local = r % IT_W1;
        J = TJob{inp(F, I_CW1) + (size_t)(i * 2 + kv) * 2048 * 256, 2048, 256, (bf16*)(base + 8 * MiB), 0, nullptr, 0, kv * 256}; return; }
    it -= 2 * IT_EV;
    { const int i = it / IT_OD; int r = it % IT_OD; unsigned char* base = F.ws + WS_WOD + (size_t)i * WOD_STRIDE;
        if (r < IT_ODIN) { local = r; J = TJob{inp(F, I_ODIN) + (size_t)i * D * 4096, D, 4096, (bf16*)base, 0, inp(F, I_GAINS) + ((2 * i + 1) * 4 + 0) * D, 0, 0}; return; } r -= IT_ODIN;
        local = r; J = TJob{inp(F, I_ODOUT) + (size_t)i * 2048 * D, 2048, D, (bf16*)(base + 8 * MiB), 0, nullptr, 0, 0}; }
}
__device__ __forceinline__ void rms_row_to_bf16(const float* xrow, bf16* orow, int lane) {
    const f32x4* xr = (const f32x4*)xrow + lane;
    f32x4 v[4]; float s = 0.f;
#pragma unroll
    for (int j = 0; j < 4; ++j) { v[j] = xr[64 * j]; s += (v[j].x * v[j].x + v[j].y * v[j].y) + (v[j].z * v[j].z + v[j].w * v[j].w); }
    const float rstd = 1.0f / sqrtf(wave_sum(s) * (1.f / D) + RMS_EPS);
    v2u* o8 = (v2u*)orow + lane;
#pragma unroll
    for (int j = 0; j < 4; ++j) o8[64 * j] = (v2u){pk2(v[j].x * rstd, v[j].y * rstd), pk2(v[j].z * rstd, v[j].w * rstd)};
}
__device__ __forceinline__ void p0_prologue(Frame& F) {
    LAS float* scr = (LAS float*)(F.lds + F.wave * 16384);
    const int gw = F.bid * NWAVES + F.wave, NGW = F.G * NWAVES;
    for (int it = gw; it < N_TRANS; it += NGW) { TJob J; int local; get_job(F, it, J, local); transpose_item(J, local, scr, F.lane); }
    float* bias1 = (float*)(F.ws + WS_SMALL);
    for (int o = gw; o < 1024; o += NGW) { const int ik = o >> 8, j = o & 255; const float* pe = inp(F, I_PE) + (size_t)ik * 2048; const float* w1 = inp(F, I_CW1) + (size_t)ik * 2048 * 256 + j;
        float s = 0.f;
        for (int t = 0; t < 32; ++t) { const int k = t * 64 + F.lane; s += pe[k] * w1[(size_t)k * 256]; }
        s = wave_sum(s); if (F.lane == 0) bias1[o] = s; }
    for (int m = gw; m < M; m += NGW) rms_row_to_bf16(inp(F, I_X) + (size_t)m * D, (bf16*)(F.ws + WS_A) + (size_t)m * D, F.lane);
}

__device__ __forceinline__ void rowpass(Frame& F, const bf16* Y, const float* hin, float* hout, bf16* aout, const float* gain) {
    const int gw = F.bid * NWAVES + F.wave, NGW = F.G * NWAVES, lane = F.lane;
    f32x4 gv[4];
#pragma unroll
    for (int j = 0; j < 4; ++j) gv[j] = ((const f32x4*)gain)[lane + 64 * j];
    for (int m = gw; m < M; m += NGW) {
        const v2u* yr = (const v2u*)(Y + (size_t)m * D) + lane; const f32x4* hr = (const f32x4*)(hin + (size_t)m * D) + lane;
        f32x4 y[4], h[4]; float s = 0.f;
#pragma unroll
        for (int j = 0; j < 4; ++j) { const v2u w = yr[64 * j]; y[j] = (f32x4){bflo(w.x), bfhi(w.x), bflo(w.y), bfhi(w.y)}; h[j] = hr[64 * j];
            s += (y[j].x * y[j].x + y[j].y * y[j].y) + (y[j].z * y[j].z + y[j].w * y[j].w); }
        const float rstd = 1.0f / sqrtf(wave_sum(s) * (1.f / D) + RMS_EPS);
        float s2 = 0.f;
#pragma unroll
        for (int j = 0; j < 4; ++j) { h[j] = h[j] + y[j] * rstd * gv[j]; s2 += (h[j].x * h[j].x + h[j].y * h[j].y) + (h[j].z * h[j].z + h[j].w * h[j].w); }
        f32x4* ho = (f32x4*)(hout + (size_t)m * D) + lane;
#pragma unroll
        for (int j = 0; j < 4; ++j) ho[64 * j] = h[j];
        if (aout != nullptr) {
            const float r2 = 1.0f / sqrtf(wave_sum(s2) * (1.f / D) + RMS_EPS);
            v2u* o8 = (v2u*)(aout + (size_t)m * D) + lane;
#pragma unroll
            for (int j = 0; j < 4; ++j) o8[64 * j] = (v2u){pk2(h[j].x * r2, h[j].y * r2), pk2(h[j].z * r2, h[j].w * r2)};
        }
    }
}

__device__ __forceinline__ void compress2(Frame& F, int ie, int b0) {
    const bf16* H1 = (const bf16*)(F.ws + WS_H1); bf16* KCB = (bf16*)(F.ws + WS_KCB);
    const int nb = F.G - b0; if (F.bid < b0) return;
    for (int idx = (F.bid - b0) * 512 + F.tid; idx < 4096 * 64; idx += nb * 512) {
        const int r = idx >> 6, d = idx & 63, kv = r >> 11; const float* w2 = inp(F, I_CW2) + (size_t)(ie * 2 + kv) * 256 * 64 + d; const bf16* h = H1 + (size_t)r * 256;
        float s = 0.f;
        for (int j = 0; j < 256; j += 2) { const unsigned w = *(const unsigned*)(h + j); s += bflo(w) * w2[(size_t)j * 64]; s += bfhi(w) * w2[(size_t)(j + 1) * 64]; }
        KCB[idx] = (bf16)f2bf(s);
    }
}
typedef short bf16x8v __attribute__((ext_vector_type(8)));
typedef float f32x16 __attribute__((ext_vector_type(16)));
__device__ __forceinline__ int crow(int r, int hi) { return (r & 3) + 8 * (r >> 2) + 4 * hi; }
template <int KS> __device__ __forceinline__ f32x16 mma_rows(const LAS unsigned char* arow, const LAS unsigned char* brow, f32x16 acc) {
#pragma unroll
    for (int ks = 0; ks < KS; ++ks) { const bf16x8v a = *(const LAS bf16x8v*)(arow + ks * 32), b = *(const LAS bf16x8v*)(brow + ks * 32); acc = __builtin_amdgcn_mfma_f32_32x32x16_bf16(a, b, acc, 0, 0, 0); }
    return acc;
}
constexpr int SP = 272;
constexpr int S1_BC = 0, S1_BT = 34816, S1_CM = 69632, S1_XD = 104448, S1_XE = 121856, S1_DT = 139264, S1_ACS = 141312;
static_assert(S1_ACS + 2048 <= SCR_BYTES, "SSM S1 LDS map");
__device__ __forceinline__ float softplus_f(float x) { return fmaxf(x, 0.f) + log1pf(__expf(-fabsf(x))); }

__device__ __forceinline__ void ssm_s1_item(Frame& F, int ie, int item) {
    const int tid = F.tid, lane = F.lane, w = F.wave, r32 = lane & 31, hi = lane >> 5;
    const int g = item & 1, bc = item >> 1, c = bc & 15, b = bc >> 4; const size_t R0 = (size_t)b * SEQ + c * 128;
    LAS unsigned char* L = F.lds;
    LAS float* DT = (LAS float*)(L + S1_DT); LAS float* ACS = (LAS float*)(L + S1_ACS);
    const bf16* X = (const bf16*)(F.ws + WS_XBC); const float* GLDT = (const float*)(F.ws + WS_GLDT);
    bf16* YD = (bf16*)(F.ws + WS_YD); bf16* STg = (bf16*)(F.ws + WS_SST); bf16* CCONV = (bf16*)(F.ws + WS_CCONV); float* ACSG = (float*)(F.ws + WS_ACSG); float* ATOT = (float*)(F.ws + WS_ATOT);
    const float* cw = inp(F, I_CONVW) + (size_t)ie * 4 * 1024; const float* cb = inp(F, I_CONVB) + (size_t)ie * 1024;
    __syncthreads();
    if (w < 4) { const int h = 4 * g + w; const float Ah = -__expf(inp(F, I_ALOG)[ie * 8 + h]), dtb = inp(F, I_DTB)[ie * 8 + h];
        const float d0 = softplus_f(GLDT[(R0 + 2 * lane) * 32 + 24 + h] + dtb), d1 = softplus_f(GLDT[(R0 + 2 * lane + 1) * 32 + 24 + h] + dtb);
        const float a0 = d0 * Ah, a1 = d1 * Ah; float s = a0 + a1;
#pragma unroll
        for (int o = 1; o < 64; o <<= 1) { const float t = __shfl_up(s, o); if (lane >= o) s += t; }
        DT[w * 128 + 2 * lane] = d0; DT[w * 128 + 2 * lane + 1] = d1; ACS[w * 128 + 2 * lane] = s - a1; ACS[w * 128 + 2 * lane + 1] = s;
        ACSG[(R0 + 2 * lane) * 8 + h] = s - a1; ACSG[(R0 + 2 * lane + 1) * 8 + h] = s;
        if (lane == 63) ATOT[(size_t)bc * 8 + h] = s; }
    { const int grp = tid & 31, seg = tid >> 5, isC = grp >> 4, n8 = (grp & 15) * 8, ch = 512 + 256 * isC + 128 * g + n8;
      float wk[4][8], bias[8], xr[4][8];
#pragma unroll
      for (int e = 0; e < 8; ++e) { bias[e] = cb[ch + e];
#pragma unroll
          for (int k = 0; k < 4; ++k) wk[k][e] = cw[k * 1024 + ch + e]; }
#pragma unroll
      for (int j = 0; j < 11; ++j) {
          const int l = 8 * seg - 3 + j; const bool ok = (c * 128 + l) >= 0;
          v4u x = (v4u){0u, 0u, 0u, 0u}; if (ok) x = *(const v4u*)(X + (size_t)((long)R0 + l) * 1024 + ch);
          const int sl = j & 3;
          xr[sl][0] = bflo(x.x); xr[sl][1] = bfhi(x.x); xr[sl][2] = bflo(x.y); xr[sl][3] = bfhi(x.y); xr[sl][4] = bflo(x.z); xr[sl][5] = bfhi(x.z); xr[sl][6] = bflo(x.w); xr[sl][7] = bfhi(x.w);
          if (j >= 3) { float o[8];
#pragma unroll
              for (int e = 0; e < 8; ++e) { float a = bias[e];
#pragma unroll
                  for (int k = 0; k < 4; ++k) a += wk[k][e] * xr[(j - 3 + k) & 3][e];
                  o[e] = silu_f(a); }
              const v4u pk = (v4u){pk2(o[0], o[1]), pk2(o[2], o[3]), pk2(o[4], o[5]), pk2(o[6], o[7])};
              if (isC) { *(LAS v4u*)(L + S1_CM + l * SP + n8 * 2) = pk; *(v4u*)(CCONV + ((size_t)R0 + l) * 256 + g * 128 + n8) = pk; }
              else { *(LAS v4u*)(L + S1_BC + l * SP + n8 * 2) = pk;
#pragma unroll
                  for (int e = 0; e < 8; ++e) *(LAS bf16*)(L + S1_BT + (n8 + e) * SP + l * 2) = (bf16)f2bf(o[e]); } } } }
    __syncthreads();
    const int l0 = 32 * (w >> 1), s0 = 64 * (w & 1);
    f32x16 cb0, cb1;
    { const f32x16 z = {0.f, 0.f, 0.f, 0.f, 0.f, 0.f, 0.f, 0.f, 0.f, 0.f, 0.f, 0.f, 0.f, 0.f, 0.f, 0.f};
      const LAS unsigned char* ar = L + S1_CM + (l0 + r32) * SP + hi * 16;
      cb0 = mma_rows<8>(ar, L + S1_BC + (s0 + r32) * SP + hi * 16, z); cb1 = mma_rows<8>(ar, L + S1_BC + (s0 + 32 + r32) * SP + hi * 16, z); }
    __syncthreads();
#pragma unroll 1
    for (int hh = 0; hh < 4; ++hh) {
        const int h = 4 * g + hh; const float Dk = inp(F, I_DSKIP)[ie * 8 + h];
        { const int cg = tid & 7, seg = tid >> 3, ch = h * 64 + 8 * cg, la = 2 * seg;
          float xv[5][8];
#pragma unroll
          for (int j = 0; j < 5; ++j) { const int l = la - 3 + j; v4u x = (v4u){0u, 0u, 0u, 0u}; if ((c * 128 + l) >= 0) x = *(const v4u*)(X + (size_t)((long)R0 + l) * 1024 + ch);
              xv[j][0] = bflo(x.x); xv[j][1] = bfhi(x.x); xv[j][2] = bflo(x.y); xv[j][3] = bfhi(x.y); xv[j][4] = bflo(x.z); xv[j][5] = bfhi(x.z); xv[j][6] = bflo(x.w); xv[j][7] = bfhi(x.w); }
          const float alast = ACS[hh * 128 + 127], d0 = DT[hh * 128 + la], d1 = DT[hh * 128 + la + 1], e0 = __expf(alast - ACS[hh * 128 + la]), e1 = __expf(alast - ACS[hh * 128 + la + 1]);
#pragma unroll
          for (int e = 0; e < 8; ++e) { float a0 = cb[ch + e], a1 = a0;
#pragma unroll
              for (int k = 0; k < 4; ++k) { const float wv = cw[k * 1024 + ch + e]; a0 += wv * xv[k][e]; a1 += wv * xv[k + 1][e]; }
              const float x0 = silu_f(a0) * d0, x1 = silu_f(a1) * d1;
              *(LAS unsigned*)(L + S1_XD + (8 * cg + e) * SP + la * 2) = pk2(x0, x1); *(LAS unsigned*)(L + S1_XE + (8 * cg + e) * SP + la * 2) = pk2(x0 * e0, x1 * e1); } }
#pragma unroll
        for (int t = 0; t < 2; ++t) { const f32x16 cbv = t == 0 ? cb0 : cb1; const int s = s0 + 32 * t + r32; const float as = ACS[hh * 128 + s];
#pragma unroll
            for (int i = 0; i < 16; ++i) { const int l = l0 + crow(i, hi); float v = 0.f; if (s <= l) v = cbv[i] * __expf(ACS[hh * 128 + l] - as); if (s == l) v += Dk / DT[hh * 128 + l];
                *(LAS bf16*)(L + S1_CM + l * SP + s * 2) = (bf16)f2bf(v); } }
        __syncthreads();
        { const f32x16 z = {0.f, 0.f, 0.f, 0.f, 0.f, 0.f, 0.f, 0.f, 0.f, 0.f, 0.f, 0.f, 0.f, 0.f, 0.f, 0.f};
          const int p0 = 32 * (w & 1);
          const f32x16 y = mma_rows<8>(L + S1_CM + (l0 + r32) * SP + hi * 16, L + S1_XD + (p0 + r32) * SP + hi * 16, z);
#pragma unroll
          for (int i = 0; i < 16; ++i) YD[((size_t)R0 + l0 + crow(i, hi)) * 512 + h * 64 + p0 + r32] = (bf16)f2bf(y[i]);
          const int ps = 32 * (w >> 2), n0 = 32 * (w & 3);
          const f32x16 st = mma_rows<8>(L + S1_XE + (ps + r32) * SP + hi * 16, L + S1_BT + (n0 + r32) * SP + hi * 16, z);
#pragma unroll
          for (int i = 0; i < 16; ++i) STg[(((size_t)bc * 8 + h) * 64 + ps + crow(i, hi)) * 128 + n0 + r32] = (bf16)f2bf(st[i]); }
        __syncthreads();
    }
}

constexpr int S3_PV = 0, S3_CC = 69632, S3_RS = 104448, S3_WT = 105472, S3_EA = 105728;
__device__ __forceinline__ void ssm_s3_item(Frame& F, int item) {
    const int tid = F.tid, lane = F.lane, w = F.wave, r32 = lane & 31, hi = lane >> 5;
    const int g = item & 1, bc = item >> 1, c = bc & 15, b = bc >> 4; const size_t R0 = (size_t)b * SEQ + c * 128;
    LAS unsigned char* L = F.lds; LAS float* RS = (LAS float*)(L + S3_RS); LAS float* WT = (LAS float*)(L + S3_WT); LAS float* EA = (LAS float*)(L + S3_EA);
    const bf16* YD = (const bf16*)(F.ws + WS_YD); const bf16* STg = (const bf16*)(F.ws + WS_SST); const bf16* CCONV = (const bf16*)(F.ws + WS_CCONV); const float* ACSG = (const float*)(F.ws + WS_ACSG); const float* ATOT = (const float*)(F.ws + WS_ATOT);
    const bf16* Z = (const bf16*)(F.ws + WS_Z); bf16* O = (bf16*)(F.ws + WS_A);
    __syncthreads();
    { const int hh = tid >> 7, l = tid & 127; EA[tid] = __expf(ACSG[(R0 + l) * 8 + 4 * g + hh]); }
    if (tid < 64) { const int hh = tid >> 4, cp = tid & 15, h = 4 * g + hh; float s = 0.f; for (int c2 = cp + 1; c2 < c; ++c2) s += ATOT[((size_t)(b * 16 + c2)) * 8 + h]; WT[tid] = cp < c ? __expf(s) : 0.f; }
    for (int idx = tid; idx < 128 * 16; idx += 512) { const int l = idx >> 4, n8 = (idx & 15) * 8; *(LAS v4u*)(L + S3_CC + l * SP + n8 * 2) = *(const v4u*)(CCONV + ((size_t)R0 + l) * 256 + g * 128 + n8); }
    __syncthreads();
    for (int idx = tid; idx < 4 * 64 * 16; idx += 512) { const int hh = idx >> 10, p = (idx >> 4) & 63, n8 = (idx & 15) * 8, h = 4 * g + hh;
        float a[8] = {0.f, 0.f, 0.f, 0.f, 0.f, 0.f, 0.f, 0.f};
        for (int c2 = 0; c2 < c; ++c2) { const float wv = WT[hh * 16 + c2]; const v4u x = *(const v4u*)(STg + ((((size_t)(b * 16 + c2)) * 8 + h) * 64 + p) * 128 + n8);
            a[0] += wv * bflo(x.x); a[1] += wv * bfhi(x.x); a[2] += wv * bflo(x.y); a[3] += wv * bfhi(x.y); a[4] += wv * bflo(x.z); a[5] += wv * bfhi(x.z); a[6] += wv * bflo(x.w); a[7] += wv * bfhi(x.w); }
        *(LAS v4u*)(L + S3_PV + (hh * 64 + p) * SP + n8 * 2) = (v4u){pk2(a[0], a[1]), pk2(a[2], a[3]), pk2(a[4], a[5]), pk2(a[6], a[7])}; }
    __syncthreads();
    const int l0 = 32 * (w >> 1), p0 = 32 * (w & 1);
#pragma unroll 1
    for (int pass = 0; pass < 2; ++pass) {
        float ss[16];
#pragma unroll
        for (int i = 0; i < 16; ++i) ss[i] = pass == 0 ? 0.f : 1.0f / sqrtf((RS[(l0 + crow(i, hi)) * 2] + RS[(l0 + crow(i, hi)) * 2 + 1]) * (1.f / 256.f) + RMS_EPS);
#pragma unroll 1
        for (int hh = 0; hh < 4; ++hh) { const int h = 4 * g + hh; const f32x16 z = {0.f, 0.f, 0.f, 0.f, 0.f, 0.f, 0.f, 0.f, 0.f, 0.f, 0.f, 0.f, 0.f, 0.f, 0.f, 0.f};
            const f32x16 yo = mma_rows<8>(L + S3_CC + (l0 + r32) * SP + hi * 16, L + S3_PV + (hh * 64 + p0 + r32) * SP + hi * 16, z);
            const size_t base = (R0 + l0 + 4 * hi) * 512 + h * 64 + p0 + r32; const bf16* ydp = YD + base; const bf16* zp = Z + base; const LAS float* eap = EA + hh * 128 + l0 + 4 * hi;
            bf16* op = O + (R0 + l0 + 4 * hi) * 1024 + 512 + g * 256 + hh * 64 + p0 + r32;
#pragma unroll
            for (int i = 0; i < 16; ++i) { const int ro = (i & 3) + 8 * (i >> 2);
                const float y = bf2f(ydp[ro * 512]) + yo[i] * eap[ro]; const float t = y * silu_f(bf2f(zp[ro * 512]));
                if (pass == 0) ss[i] += t * t; else op[ro * 1024] = (bf16)f2bf(t * ss[i]); }
        }
        if (pass == 0) {
#pragma unroll
            for (int i = 0; i < 16; ++i) { float s = ss[i]; s += __shfl_xor(s, 1); s += __shfl_xor(s, 2); s += __shfl_xor(s, 4); s += __shfl_xor(s, 8); s += __shfl_xor(s, 16); if (r32 == 0) RS[(l0 + crow(i, hi)) * 2 + (w & 1)] = s; }
            __syncthreads();
        }
    }
}

typedef __attribute__((address_space(3))) const unsigned char* lds_cp;
typedef short v4i16_t __attribute__((ext_vector_type(4)));
__device__ __forceinline__ v4i16_t vtr(lds_cp p) { return __builtin_amdgcn_ds_read_tr16_b64_v4i16((__attribute__((address_space(3))) v4i16_t*)p); }
constexpr int AM_K = 0, AM_V = 16384, AM_PS = 32768, AM_IMP = 65536, AM_RS = 73728;
constexpr float LOG2E = 1.4426950408889634f;
__device__ __forceinline__ unsigned pkbf(float lo, float hi) { return pk2(lo, hi); }

struct AttnStage { v4u k, v; };
__device__ __forceinline__ void am_stage_load(AttnStage& s, const bf16* kb, const bf16* vb, int j, int wid, int lane) {
    s.k = *(const v4u*)(kb + (size_t)(64 * j + lane) * 64 + wid * 8);
    s.v = *(const v4u*)(vb + (size_t)(64 * j + 16 * (wid & 3) + (lane >> 2)) * 64 + (wid >> 2) * 32 + (lane & 3) * 8);
}
__device__ __forceinline__ void am_stage_write(const AttnStage& s, LAS unsigned char* L, int slot, int wid, int lane) {
    *(LAS v4u*)(L + AM_K + slot * 8192 + wid * 1024 + lane * 16) = s.k; *(LAS v4u*)(L + AM_V + slot * 8192 + wid * 1024 + lane * 16) = s.v;
}
__device__ __forceinline__ void am_qkt(f32x16& p0, f32x16& p1, lds_cp kslot, const bf16x8v (&qr)[5], bf16x8v kaug0, bf16x8v kaug1, int r32, int hi) {
    const f32x16 z = {0.f, 0.f, 0.f, 0.f, 0.f, 0.f, 0.f, 0.f, 0.f, 0.f, 0.f, 0.f, 0.f, 0.f, 0.f, 0.f};
    lds_cp kb = kslot + hi * 1024 + r32 * 16;
    p0 = __builtin_amdgcn_mfma_f32_32x32x16_bf16(kaug0, qr[4], z, 0, 0, 0); p1 = __builtin_amdgcn_mfma_f32_32x32x16_bf16(kaug1, qr[4], z, 0, 0, 0);
#pragma unroll
    for (int d0 = 0; d0 < 4; ++d0) { const bf16x8v b0 = *(const LAS bf16x8v*)(kb + d0 * 2048), b1 = *(const LAS bf16x8v*)(kb + d0 * 2048 + 512);
        p0 = __builtin_amdgcn_mfma_f32_32x32x16_bf16(b0, qr[d0], p0, 0, 0, 0); p1 = __builtin_amdgcn_mfma_f32_32x32x16_bf16(b1, qr[d0], p1, 0, 0, 0); }
}
__device__ __forceinline__ void am_pv(f32x16 (&o)[2], lds_cp vb, bf16x8v pa0, bf16x8v pa1, bf16x8v pa2, bf16x8v pa3) {
#pragma unroll
    for (int d0 = 0; d0 < 2; ++d0) {
        v4i16_t lo[4], hh[4];
#pragma unroll
        for (int ks = 0; ks < 4; ++ks) { lo[ks] = vtr(vb + d0 * 4096 + ks * 1024); hh[ks] = vtr(vb + d0 * 4096 + ks * 1024 + 512); }
#define AM_PK(k) (bf16x8v){lo[k][0], lo[k][1], lo[k][2], lo[k][3], hh[k][0], hh[k][1], hh[k][2], hh[k][3]}
        o[d0] = __builtin_amdgcn_mfma_f32_32x32x16_bf16(pa0, AM_PK(0), o[d0], 0, 0, 0); o[d0] = __builtin_amdgcn_mfma_f32_32x32x16_bf16(pa1, AM_PK(1), o[d0], 0, 0, 0);
        o[d0] = __builtin_amdgcn_mfma_f32_32x32x16_bf16(pa2, AM_PK(2), o[d0], 0, 0, 0); o[d0] = __builtin_amdgcn_mfma_f32_32x32x16_bf16(pa3, AM_PK(3), o[d0], 0, 0, 0);
#undef AM_PK
    }
}
__device__ __forceinline__ bf16x8v am_pack8(const f32x16& p, int b) { const v4u w = (v4u){pkbf(p[b], p[b + 1]), pkbf(p[b + 2], p[b + 3]), pkbf(p[b + 4], p[b + 5]), pkbf(p[b + 6], p[b + 7])}; return __builtin_bit_cast(bf16x8v, w); }
__device__ __forceinline__ bf16x8v am_kaug(unsigned w0, unsigned w1, unsigned w2) { const v4u w = (v4u){w0, w1, w2, 0u}; return __builtin_bit_cast(bf16x8v, w); }
__device__ __forceinline__ void am_fold(f32x16 (&fin)[2], const f32x16 (&o)[2], float rowscale, volatile LAS float* rsw, int r32, int hi) {
    asm volatile("" ::: "memory"); if (hi == 0) rsw[r32] = rowscale; asm volatile("s_waitcnt lgkmcnt(0)" ::: "memory");
#pragma unroll
    for (int i = 0; i < 16; ++i) { const float s = rsw[crow(i, hi)]; fin[0][i] += o[0][i] * s; fin[1][i] += o[1][i] * s; }
    asm volatile("s_waitcnt lgkmcnt(0)" ::: "memory");
}

__device__ __forceinline__ void attn_unit(Frame& F, int bg, int jq) {
    const int lane = F.lane, w = F.wave, r32 = lane & 31, hi = lane >> 5, b = bg >> 1, g = bg & 1;
    LAS unsigned char* L = F.lds;
    const bf16* Qg = (const bf16*)(F.ws + WS_Q); const bf16* KVg = (const bf16*)(F.ws + WS_KV); const bf16* KCBb = (const bf16*)(F.ws + WS_KCB); const float* GLDT = (const float*)(F.ws + WS_GLDT);
    const int qloc = r32 >> 2, rh = r32 & 3, tl = 8 * w + qloc, t = 64 * jq + tl, head = 4 * g + rh; const size_t row = (size_t)b * SEQ + t;
    bf16x8v qr[5];
#pragma unroll
    for (int d0 = 0; d0 < 4; ++d0) qr[d0] = *(const bf16x8v*)(Qg + row * 512 + head * 64 + d0 * 16 + hi * 8);
    const float sl2 = exp2f(-(float)(head + 1)) * LOG2E; const float hs = bf2f((bf16)f2bf(sl2)), ls = sl2 - hs;
    const unsigned qa0 = pkbf(hs, ls), qa1 = pkbf(64.f * hs, 64.f * ls), qa2_on = pkbf(-sl2 * (float)tl, 0.f), qa2_off = pkbf(-sl2 * (float)tl, -30000.f);
    qr[4] = hi == 0 ? am_kaug(qa0, qa1, qa2_on) : am_kaug(0u, 0u, 0u);
    const float* gl = GLDT + row * 32 + head * 3; const float g_cmp = sigmoid_f(gl[0]), g_sel = sigmoid_f(gl[1]), g_win = sigmoid_f(gl[2]);
    const unsigned kw0a = hi == 0 ? pkbf((float)r32, (float)r32) : 0u, kw0b = hi == 0 ? pkbf((float)(r32 + 32), (float)(r32 + 32)) : 0u, kw2 = hi == 0 ? pkbf(1.f, 1.f) : 0u;
    volatile LAS float* rsw = (volatile LAS float*)(L + AM_RS) + w * 32;
    lds_cp vb0 = (lds_cp)(L + AM_V) + ((lane >> 4) & 1) * 32 + (lane & 3) * 8 + (4 * hi + ((lane & 15) >> 2)) * 64;
    f32x16 fin[2], o[2];
    const f32x16 zz = {0.f, 0.f, 0.f, 0.f, 0.f, 0.f, 0.f, 0.f, 0.f, 0.f, 0.f, 0.f, 0.f, 0.f, 0.f, 0.f};
    o[0] = zz; o[1] = zz;
    AttnStage st;
    __syncthreads();
    unsigned selm;
    {
        const bf16* kc = KCBb + (size_t)(bg * 128) * 64; const bf16* vc = KCBb + (size_t)(2048 + bg * 128) * 64;
        am_stage_load(st, kc, vc, 0, w, lane); am_stage_write(st, L, 0, w, lane); am_stage_load(st, kc, vc, 1, w, lane); am_stage_write(st, L, 1, w, lane);
        __syncthreads();
        const int cmax = (t - 31) >> 4;
        LAS float* PS = (LAS float*)(L + AM_PS) + (w * 8) * 128; LAS float* IMP = (LAS float*)(L + AM_IMP) + (w * 8) * 32;
        float l = 0.f, inv = 0.f;
#pragma unroll 1
        for (int pass = 0; pass < 2; ++pass) {
#pragma unroll 1
            for (int tile = 0; tile < 2; ++tile) {
                const int c0 = 64 * tile + r32, c1 = c0 + 32, e0 = 16 * c0 + 31, e1 = 16 * c1 + 31;
                const bf16x8v ka0 = am_kaug(hi == 0 ? pkbf((float)(e0 & 63), (float)(e0 & 63)) : 0u, hi == 0 ? pkbf((float)((e0 >> 6) - jq), (float)((e0 >> 6) - jq)) : 0u, kw2);
                const bf16x8v ka1 = am_kaug(hi == 0 ? pkbf((float)(e1 & 63), (float)(e1 & 63)) : 0u, hi == 0 ? pkbf((float)((e1 >> 6) - jq), (float)((e1 >> 6) - jq)) : 0u, kw2);
                f32x16 p0, p1;
                am_qkt(p0, p1, (lds_cp)(L + AM_K + tile * 8192), qr, ka0, ka1, r32, hi);
#pragma unroll
                for (int i = 0; i < 16; ++i) { const int ca = 64 * tile + crow(i, hi), cb2 = ca + 32;
                    p0[i] = (ca <= cmax && ca <= 126) ? __builtin_amdgcn_exp2f(p0[i]) : 0.f; p1[i] = (cb2 <= cmax && cb2 <= 126) ? __builtin_amdgcn_exp2f(p1[i]) : 0.f; }
                if (pass == 0) {
#pragma unroll
                    for (int i = 0; i < 16; ++i) l += p0[i] + p1[i];
                } else {
#pragma unroll
                    for (int i = 0; i < 16; ++i) { p0[i] *= inv; p1[i] *= inv; }
#pragma unroll
                    for (int half = 0; half < 2; ++half)
#pragma unroll
                        for (int k = 0; k < 4; ++k) { f32x4 s4;
#pragma unroll
                            for (int e = 0; e < 4; ++e) { float x = half == 0 ? p0[4 * k + e] : p1[4 * k + e]; x += __shfl_xor(x, 1); x += __shfl_xor(x, 2); s4[e] = x; }
                            if (rh == 0) *(LAS f32x4*)(PS + qloc * 128 + 64 * tile + 32 * half + 8 * k + 4 * hi) = s4; }
                    am_pv(o, vb0 + tile * 8192, am_pack8(p0, 0), am_pack8(p0, 8), am_pack8(p1, 0), am_pack8(p1, 8));
                }
            }
            if (pass == 0) { l += __shfl_xor(l, 32); inv = l > 0.f ? 1.0f / l : 0.f; }
        }
        fin[0] = zz; fin[1] = zz; am_fold(fin, o, g_cmp, rsw, r32, hi); o[0] = zz; o[1] = zz;
        asm volatile("s_waitcnt lgkmcnt(0)" ::: "memory");
        {
            const int q2 = lane >> 3, jb = (lane & 7) * 4; const volatile LAS float* ps = PS + q2 * 128; volatile LAS float* im = IMP + q2 * 32;
#pragma unroll
            for (int jj = 0; jj < 4; ++jj) { const int j = jb + jj; float imp = ps[4 * j] + ps[4 * j + 1] + ps[4 * j + 2] + 0.5f * ps[4 * j + 3] + (j > 0 ? 0.5f * ps[4 * j - 1] : 0.f);
                if (j == 0 || j == jq || j == jq - 1) imp += 1e4f; im[j] = j <= jq ? imp : -1.0f; }
            asm volatile("s_waitcnt lgkmcnt(0)" ::: "memory");
            unsigned m = 0u;
#pragma unroll
            for (int jj = 0; jj < 4; ++jj) { const int j = jb + jj; const float v = im[j]; int rank = 0;
#pragma unroll 8
                for (int o2 = 0; o2 < 32; ++o2) { const float vo = im[o2]; rank += (vo > v || (vo == v && o2 < j)) ? 1 : 0; }
                if (rank < 16) m |= 1u << j; }
            m |= __shfl_xor(m, 1); m |= __shfl_xor(m, 2); m |= __shfl_xor(m, 4);
            selm = __shfl(m, 8 * qloc);
        }
        __syncthreads();
    }
    unsigned anysel = selm; anysel |= __shfl_xor(anysel, 4); anysel |= __shfl_xor(anysel, 8); anysel |= __shfl_xor(anysel, 16); anysel = __builtin_amdgcn_readfirstlane(anysel);
    const bf16* ks = KVg + ((size_t)2 << 21) + (size_t)bg * SEQ * 64; const bf16* vs = KVg + ((size_t)3 << 21) + (size_t)bg * SEQ * 64;
    const bf16* kwn = KVg + ((size_t)4 << 21) + (size_t)bg * SEQ * 64; const bf16* vwn = KVg + ((size_t)5 << 21) + (size_t)bg * SEQ * 64;
    const int nsel = jq + 1, jw0 = jq >= 8 ? jq - 8 : 0, nwin = jq - jw0 + 1, nst = nsel + nwin;
    float l = 0.f;
    am_stage_load(st, ks, vs, 0, w, lane); am_stage_write(st, L, 0, w, lane);
    if (nst > 1) { if (1 < nsel) am_stage_load(st, ks, vs, 1, w, lane); else am_stage_load(st, kwn, vwn, jw0, w, lane); }
    __syncthreads();
#pragma unroll 1
    for (int s = 0; s < nst; ++s) {
        const bool win = s >= nsel; const int j = win ? jw0 + (s - nsel) : s; const int slot = s & 1;
        if (win && s == nsel) { am_fold(fin, o, (l + __shfl_xor(l, 32)) > 0.f ? g_sel / (l + __shfl_xor(l, 32)) : 0.f, rsw, r32, hi); o[0] = zz; o[1] = zz; l = 0.f; }
        if (win || ((anysel >> j) & 1u)) {
            const float wr = (float)(j - jq); const unsigned kw1 = hi == 0 ? pkbf(wr, wr) : 0u;
            if (hi == 0) { v4u qa = (v4u){qa0, qa1, (win || ((selm >> j) & 1u)) ? qa2_on : qa2_off, 0u}; qr[4] = __builtin_bit_cast(bf16x8v, qa); }
            f32x16 p0, p1;
            am_qkt(p0, p1, (lds_cp)(L + AM_K + slot * 8192), qr, am_kaug(kw0a, kw1, kw2), am_kaug(kw0b, kw1, kw2), r32, hi);
            const bool diag = (j == jq), edge = win && (jq >= 8) && (j == jw0);
            if (diag || edge) {
#pragma unroll
                for (int i = 0; i < 16; ++i) { const int kv0 = crow(i, hi), kv1 = kv0 + 32;
                    const bool bad0 = diag ? (kv0 > tl) : (kv0 <= tl), bad1 = diag ? (kv1 > tl) : (kv1 <= tl);
                    if (bad0) p0[i] = -1e30f; if (bad1) p1[i] = -1e30f; } }
#pragma unroll
            for (int i = 0; i < 16; ++i) { p0[i] = __builtin_amdgcn_exp2f(p0[i]); p1[i] = __builtin_amdgcn_exp2f(p1[i]); l += p0[i] + p1[i]; }
            am_pv(o, vb0 + slot * 8192, am_pack8(p0, 0), am_pack8(p0, 8), am_pack8(p1, 0), am_pack8(p1, 8));
        }
        if (s + 1 < nst) am_stage_write(st, L, slot ^ 1, w, lane);
        __syncthreads();
        if (s + 2 < nst) { if (s + 2 < nsel) am_stage_load(st, ks, vs, s + 2, w, lane); else am_stage_load(st, kwn, vwn, jw0 + (s + 2 - nsel), w, lane); }
    }
    { const float lt = l + __shfl_xor(l, 32); am_fold(fin, o, lt > 0.f ? g_win / lt : 0.f, rsw, r32, hi); }
    bf16* O = (bf16*)(F.ws + WS_A);
#pragma unroll
    for (int i = 0; i < 16; ++i) { const int rho = crow(i, hi); const size_t orow = (size_t)b * SEQ + 64 * jq + 8 * w + (rho >> 2); bf16* op = O + orow * 1024 + (4 * g + (rho & 3)) * 64 + r32;
        op[0] = (bf16)f2bf(fin[0][i]); op[32] = (bf16)f2bf(fin[1][i]); }
}

constexpr int GM_V = 0, GM_W = 65536, GM_ST = GM_W + 128 * SP;
static_assert(GM_ST + 1024 <= SCR_BYTES, "gMLP LDS map");
__device__ __forceinline__ void gmlp_item(Frame& F, int io, int item) {
    const int tid = F.tid, lane = F.lane, w = F.wave, r32 = lane & 31, hi = lane >> 5; const int g = item & 7, bc = item >> 3; const size_t row0 = (size_t)bc * 128;
    LAS unsigned char* L = F.lds; LAS float* ST = (LAS float*)(L + GM_ST);
    bf16* U = (bf16*)(F.ws + WS_U); const bf16* V = (const bf16*)(F.ws + WS_V); const float* STg = (const float*)(F.ws + WS_ST);
    const float* lnw = inp(F, I_LNW) + (size_t)io * 2048 + g * 256; const float* lnb = inp(F, I_LNB) + (size_t)io * 2048 + g * 256;
    const float* wsg = inp(F, I_WS) + ((size_t)io * 8 + g) * 128 * 128; const float* bsg = inp(F, I_BS) + ((size_t)io * 8 + g) * 128;
    __syncthreads();
    if (tid < 128) { const float* p = STg + (row0 + tid) * 64; float s = 0.f, ss = 0.f;
        for (int k = 0; k < 32; ++k) { s += p[2 * k]; ss += p[2 * k + 1]; }
        const float mean = s * (1.f / 2048.f), var = ss * (1.f / 2048.f) - mean * mean; ST[2 * tid] = mean; ST[2 * tid + 1] = 1.0f / sqrtf(fmaxf(var, 0.f) + LN_EPS); }
    for (int idx = tid; idx < 128 * 16; idx += 512) { const int t = idx >> 4, s8 = (idx & 15) * 8; const f32x4 a = *(const f32x4*)(wsg + t * 128 + s8), b2 = *(const f32x4*)(wsg + t * 128 + s8 + 4);
        float f[8] = {a.x, a.y, a.z, a.w, b2.x, b2.y, b2.z, b2.w};
#pragma unroll
        for (int e = 0; e < 8; ++e) if (s8 + e > t) f[e] = 0.f;
        *(LAS v4u*)(L + GM_W + t * SP + s8 * 2) = (v4u){pk2(f[0], f[1]), pk2(f[2], f[3]), pk2(f[4], f[5]), pk2(f[6], f[7])}; }
    __syncthreads();
    { const int ch = tid & 31, c8 = ch * 8; float lw[8], lb[8];
#pragma unroll
      for (int e = 0; e < 8; ++e) { lw[e] = lnw[c8 + e]; lb[e] = lnb[c8 + e]; }
#pragma unroll
      for (int k = 0; k < 8; ++k) { const int s = (tid >> 5) + 16 * k; const v4u x = *(const v4u*)(V + (row0 + s) * 2048 + g * 256 + c8); const float mean = ST[2 * s], rstd = ST[2 * s + 1];
          float f[8] = {bflo(x.x), bfhi(x.x), bflo(x.y), bfhi(x.y), bflo(x.z), bfhi(x.z), bflo(x.w), bfhi(x.w)};
#pragma unroll
          for (int e = 0; e < 8; ++e) f[e] = (f[e] - mean) * rstd * lw[e] + lb[e];
          *(LAS v4u*)(L + GM_V + (ch >> 2) * 8192 + s * 64 + (ch & 3) * 16) = (v4u){pk2(f[0], f[1]), pk2(f[2], f[3]), pk2(f[4], f[5]), pk2(f[6], f[7])}; } }
    __syncthreads();
    const int tb = w >> 1, t0 = 32 * tb, db0 = 4 * (w & 1);
    const f32x16 zz = {0.f, 0.f, 0.f, 0.f, 0.f, 0.f, 0.f, 0.f, 0.f, 0.f, 0.f, 0.f, 0.f, 0.f, 0.f, 0.f};
    f32x16 acc[4] = {zz, zz, zz, zz};
    const LAS unsigned char* ap = L + GM_W + (t0 + r32) * SP + hi * 16;
    lds_cp vb = (lds_cp)(L + GM_V) + ((lane >> 4) & 1) * 32 + (lane & 3) * 8 + (8 * hi + ((lane & 15) >> 2)) * 64;
#pragma unroll 1
    for (int ks = 0; ks < 2 * (tb + 1); ++ks) {
        const bf16x8v a = *(const LAS bf16x8v*)(ap + ks * 32);
#pragma unroll
        for (int q = 0; q < 4; ++q) { const v4i16_t lo = vtr(vb + (db0 + q) * 8192 + ks * 1024), h4 = vtr(vb + (db0 + q) * 8192 + ks * 1024 + 256);
            const bf16x8v bfr = (bf16x8v){lo[0], lo[1], lo[2], lo[3], h4[0], h4[1], h4[2], h4[3]};
            acc[q] = __builtin_amdgcn_mfma_f32_32x32x16_bf16(a, bfr, acc[q], 0, 0, 0); }
    }
    bf16* up = U + (row0 + t0 + 4 * hi) * 2048 + g * 256 + db0 * 32 + r32; const float* bp = bsg + t0 + 4 * hi;
#pragma unroll
    for (int i = 0; i < 16; ++i) { const int ro = (i & 3) + 8 * (i >> 2); const float bs = bp[ro];
#pragma unroll
        for (int q = 0; q < 4; ++q) { bf16* o = up + (size_t)ro * 2048 + q * 32; *o = (bf16)f2bf(bf2f(*o) * (acc[q][i] + bs)); }
        if ((i & 3) == 3) asm volatile("" ::: "memory"); }
}

enum Kind { K_PREP = 0, K_G1, K_E3, K_E4, K_E5, K_GY, K_RP, K_G3, K_G5, K_O2 };
constexpr int N_PHASES = 33;
struct Args { const float* in[22]; float* out; unsigned char* ws; int ph_lo, ph_hi; };

__global__ void __launch_bounds__(NWAVES * 64, 2) mk_fwd(Args args) {
    extern __shared__ __attribute__((aligned(16))) unsigned char lds_raw[];
    Frame F;
    F.lds = (LAS unsigned char*)(uintptr_t)0u  ; F.ws = args.ws; F.out = args.out;
    F.wave = __builtin_amdgcn_readfirstlane(threadIdx.x >> 6); F.G = gridDim.x; F.bid = blockIdx.x;
    volatile LAS unsigned* MISC = (volatile LAS unsigned*)((LAS unsigned char*)lds_raw + MISC_OFF);
    { const int t0 = threadIdx.x; if (t0 < 32) MISC[t0] = 0u;
      if (t0 >= 64 && t0 < 64 + 22) { const unsigned long long pv = (unsigned long long)args.in[t0 - 64]; MISC[32 + 2 * (t0 - 64)] = (unsigned)pv; MISC[33 + 2 * (t0 - 64)] = (unsigned)(pv >> 32); } }
    __syncthreads();
    const int wave0 = __builtin_amdgcn_readfirstlane(threadIdx.x >> 6);
    XcdBarrier bar = xcd_barrier_post((unsigned*)(F.ws + WS_CTL) + CW_BAR, MISC + 8);

    for (int p = args.ph_lo; p < args.ph_hi; ++p) {
        int L = 0, k = 0, kind = K_PREP, var = 0;
        if (p > 0) { const int q = p - 1; if (q < 9) { L = 0; k = q; } else if (q < 16) { L = 1; k = q - 9; } else if (q < 25) { L = 2; k = q - 16; } else { L = 3; k = q - 25; }
            if ((L & 1) == 0) { kind = (int)((0x657654321ull >> (4 * k)) & 15ull); var = (int)((0x110000000ull >> (4 * k)) & 15ull); }
            else { kind = (int)((0x6576598ull >> (4 * k)) & 15ull); var = (int)((0x1102200ull >> (4 * k)) & 15ull); } }
        { unsigned long long wsv = (unsigned long long)args.ws, outv = (unsigned long long)args.out; int wv = wave0, bidv = blockIdx.x, gv = gridDim.x;
          asm volatile("" : "+s"(wsv), "+s"(outv), "+s"(bidv), "+s"(gv), "+s"(wv));
          int tidv = (wv << 6) | flane(); asm volatile("" : "+v"(tidv));
          F.ws = (unsigned char*)wsv; F.out = (float*)outv; F.tid = tidv; F.lane = tidv & 63; F.wave = wv; F.G = gv; F.bid = bidv; }
        const int ie = L >> 1;
        unsigned char* wev = F.ws + WS_WEV + (size_t)ie * WEV_STRIDE; unsigned char* wod = F.ws + WS_WOD + (size_t)ie * WOD_STRIDE; unsigned char* wff = F.ws + WS_WFFN + (size_t)L * WFFN_STRIDE;
        switch (kind) {
        case K_PREP:
#ifndef NO_P0
            p0_prologue(F);
#endif
            break;
        case K_G1: {
#ifndef NO_K_G1
            pg8::Gemm g{(const bf16*)(F.ws + WS_A), (const bf16*)wev, M, EV_IN_PAD, D, D}; pg8::StaticOrder S; S.init(M, EV_IN_PAD, F.G, F.bid);
            pg8::EpiProj E{(bf16*)(F.ws + WS_Q), (bf16*)(F.ws + WS_KV), (bf16*)(F.ws + WS_Z), (bf16*)(F.ws + WS_XBC), (float*)(F.ws + WS_GLDT)};
            pg8::gemm_phase<pg8::EpiProj, pg8::StaticOrder, true, true>(F.lds, g, S, E, F.tid);
#endif
            } break;
        case K_E3: {
#ifndef NO_K_E3
            pg8::Gemm g{(const bf16*)(F.ws + WS_KV), (const bf16*)(wev + 8 * MiB), 4096, 512, 2048, 1024}; pg8::CmpOrder S{F.bid};
            pg8::EpiCmp E{(bf16*)(F.ws + WS_H1), (const float*)(F.ws + WS_SMALL) + ie * 512};
            pg8::gemm_phase<pg8::EpiCmp, pg8::CmpOrder, true, true>(F.lds, g, S, E, F.tid);
            for (int it = F.bid; it < 256; it += F.G) ssm_s1_item(F, ie, it);
#endif
            } break;
        case K_E4:
#ifndef NO_E4
            compress2(F, ie, 0);
#endif
            break;
        case K_E5: {
#ifndef NO_S3
            for (int it = F.bid; it < 256; it += F.G) ssm_s3_item(F, it);
#endif
#ifndef NO_E5
            for (int u = F.bid; u < 256; u += F.G) { const int bg = u & 15, s = u >> 4; attn_unit(F, bg, 31 - s); attn_unit(F, bg, s); }
#endif
            } break;
        case K_GY: {
#ifndef NO_K_GY
            const bf16* A = var == 0 ? (const bf16*)(F.ws + WS_A) : var == 1 ? (const bf16*)(F.ws + WS_T) : (const bf16*)(F.ws + WS_U);
            const bf16* W = var == 0 ? (const bf16*)(wev + 6 * MiB) : var == 1 ? (const bf16*)(wff + (size_t)5632 * 1024 * 2) : (const bf16*)(wod + 8 * MiB);
            const int K = var == 0 ? 1024 : var == 1 ? FFH : 2048; bf16* Y = (bf16*)(F.ws + (var == 0 ? WS_YEV : var == 1 ? WS_YFF : WS_YOD));
            pg8::Gemm g{A, W, M, D, K, K}; pg8::StaticOrder S; S.init(M, D, F.G, F.bid); pg8::EpiBf16Plain E{Y, D};
            pg8::gemm_phase<pg8::EpiBf16Plain, pg8::StaticOrder, true, true>(F.lds, g, S, E, F.tid);
#endif
            } break;
        case K_RP: {
            const bf16* Y = (const bf16*)(F.ws + (var == 0 ? WS_YEV : var == 1 ? WS_YFF : WS_YOD)); const bool mixer = (var != 1);
            const float* hin = (L == 0 && mixer) ? inp(F, I_X) : F.out; bf16* aout = (L == DEPTH - 1 && !mixer) ? nullptr : (bf16*)(F.ws + WS_A);
            rowpass(F, Y, hin, F.out, aout, inp(F, I_GAINS) + (L * 4 + (mixer ? 1 : 3)) * D); } break;
        case K_G3: {
#ifndef NO_K_G3
            pg8::Gemm g{(const bf16*)(F.ws + WS_A), (const bf16*)wff, M, 2 * FFH, D, D}; pg8::StaticOrder S; S.init(M, 2 * FFH, F.G, F.bid);
            pg8::EpiSwiGLU E{(bf16*)(F.ws + WS_T), FFH};
            pg8::gemm_phase<pg8::EpiSwiGLU, pg8::StaticOrder, true, true>(F.lds, g, S, E, F.tid);
#endif
            } break;
        case K_G5: {
#ifndef NO_K_G5
            pg8::Gemm g{(const bf16*)(F.ws + WS_A), (const bf16*)wod, M, 4096, D, D}; pg8::StaticOrder S; S.init(M, 4096, F.G, F.bid);
            pg8::EpiGelu E{(bf16*)(F.ws + WS_U), (bf16*)(F.ws + WS_V), (float*)(F.ws + WS_ST)};
            pg8::gemm_phase<pg8::EpiGelu, pg8::StaticOrder, true, true>(F.lds, g, S, E, F.tid);
#endif
            } break;
        case K_O2: {
#ifndef NO_O2
            for (int it = F.bid; it < 1024; it += F.G) gmlp_item(F, ie, it);
#endif
            } break;
        default: break;
        }
        if (p + 1 < args.ph_hi) xcd_barrier(bar, F.wave);
    }
}

#ifndef MK_PER_PHASE
#define MK_PER_PHASE 0
#endif
extern "C" void kernel_launch(void* const* d_in, const int* in_sizes, int n_in, void* d_out, int out_size, void* d_ws, size_t ws_size, hipStream_t stream) {
    static int grid = 0;
    if (grid == 0) {
        if (n_in != 22 || in_sizes[0] != M * D || out_size != M * D || ws_size < WS_END) { fprintf(stderr, "kernel_launch: unexpected shapes (n_in %d, in0 %d, out %d, ws %zu)\n", n_in, n_in > 0 ? in_sizes[0] : -1, out_size, ws_size); grid = -1; return; }
        int dev = 0, cus = 0, per_cu = 0;
        if (hipGetDevice(&dev) != hipSuccess || hipDeviceGetAttribute(&cus, hipDeviceAttributeMultiprocessorCount, dev) != hipSuccess) { grid = -1; return; }
        if (hipFuncSetAttribute((const void*)mk_fwd, hipFuncAttributeMaxDynamicSharedMemorySize, LDS_BYTES) != hipSuccess) { fprintf(stderr, "kernel_launch: hipFuncSetAttribute failed\n"); grid = -1; return; }
        if (hipOccupancyMaxActiveBlocksPerMultiprocessor(&per_cu, (const void*)mk_fwd, NWAVES * 64, LDS_BYTES) != hipSuccess || per_cu < 1) { fprintf(stderr, "kernel_launch: occupancy query says %d\n", per_cu); per_cu = 1; }
        (void)hipGetLastError();
        grid = cus;
        if (grid != 256) fprintf(stderr, "kernel_launch: %d CUs (built for 256)\n", grid);
    }
    if (grid < 0) return;
    Args a{};
    for (int i = 0; i < 22; ++i) a.in[i] = (const float*)d_in[i];
    a.out = (float*)d_out; a.ws = (unsigned char*)d_ws;
#if MK_PER_PHASE
    for (int p = 0; p < N_PHASES; ++p) { a.ph_lo = p; a.ph_hi = p + 1; hipLaunchKernelGGL(mk_fwd, dim3(grid), dim3(NWAVES * 64), LDS_BYTES, stream, a); }
#else
    (void)hipMemsetAsync((char*)d_ws + WS_CTL, 0, CTL_ZERO_BYTES, stream);
    a.ph_lo = 0; a.ph_hi = N_PHASES;
    hipLaunchKernelGGL(mk_fwd, dim3(grid), dim3(NWAVES * 64), LDS_BYTES, stream, a);
#endif
}
```

```cpp
#include <hip/hip_runtime.h>
#include <cstdio>
#include <cstdint>

namespace pg8 {
#define PG8_LAS __attribute__((address_space(3)))
typedef unsigned short bf16_t;
typedef short bf16x8 __attribute__((ext_vector_type(8)));
typedef float f32x4 __attribute__((ext_vector_type(4)));
typedef unsigned u32x4 __attribute__((ext_vector_type(4)));
typedef float f32x2 __attribute__((ext_vector_type(2)));
constexpr int BM = 256, BK = 64, HALF = 128, HTB = HALF * BK * 2  , STAGE_BYTES = 8 * HTB, NXCD = 8, WGM = 8;

__host__ __device__ __forceinline__ int lds_byte(int r, int c) { const int st = (r >> 4) * 2 + (c >> 5), rr = r & 15, cc = c & 31, ob = rr * 64 + cc * 2; return st * 1024 + (ob ^ (((ob >> 9) & 1) << 5)); }
__host__ __device__ __forceinline__ void stage_rc(int b, int& R, int& C) { const int st = b / 1024, sb = b % 1024, swz = sb ^ (((sb >> 9) & 1) << 5); R = (st >> 1) * 16 + swz / 64; C = (st & 1) * 32 + (swz % 64) / 2; }
__host__ __device__ __forceinline__ int perm32(int rho) { const int n = rho >> 4, i = rho & 15; return 8 * (i >> 2) + 4 * n + (i & 3); }

struct Unit { int pm, pn; };
struct Gemm { const bf16_t* A; const bf16_t* Bt; int M, N, K, lda; };

struct StaticOrder {
    int nM, nN, nwg, G, c;
    __host__ __device__ void init(int M, int N, int G_, int c_) { nM = M / BM; nN = N / BM; nwg = nM * nN; G = G_; c = c_; }
    __host__ __device__ bool next(int i, Unit& u) const {
        const long L = (long)i * G + c; if (L >= nwg) return false;
        int wgid = (int)L; { const int q = nwg / NXCD, r = nwg % NXCD, xcd = wgid % NXCD, off = wgid / NXCD; wgid = (xcd < r ? xcd * (q + 1) : r * (q + 1) + (xcd - r) * q) + off; }
        const int nig = WGM * nN, gid = wgid / nig, fm = gid * WGM, gsz = (nM - fm) < WGM ? (nM - fm) : WGM;
        u.pm = fm + ((wgid % nig) % gsz); u.pn = (wgid % nig) / gsz; return true;
    }
    __device__ __forceinline__ void a_ready(const Unit&) const {}
    __device__ __forceinline__ void done(const Unit&) const {}
};
struct CmpOrder {
    int c;
    __device__ bool next(int i, Unit& u) const { if (i > 0 || c >= 16) return false; u.pm = c; u.pn = c >> 3; return true; }
    __device__ __forceinline__ void a_ready(const Unit&) const {}
    __device__ __forceinline__ void done(const Unit&) const {}
};

__device__ __forceinline__ unsigned cvt_pk_bf16(float lo, float hi) { unsigned r; asm volatile("v_cvt_pk_bf16_f32 %0, %1, %2" : "=v"(r) : "v"(lo), "v"(hi)); return r; }
__device__ __forceinline__ f32x2 gelu_pk(f32x2 v) {
    const f32x2 av = __builtin_elementwise_abs(v), d = av * 0.2316418882f + 1.0f;
    f32x2 t; t.x = __builtin_amdgcn_rcpf(d.x); t.y = __builtin_amdgcn_rcpf(d.y);
    f32x2 q = t * 0.5307027145f + (-0.7265760135f); q = q * t + 0.7107068705f; q = q * t + (-0.142248368f); q = q * t + 0.127414796f; q = q * t;
    const f32x2 s = (v * v) * (-0.72134752044f);
    f32x2 e; e.x = __builtin_amdgcn_exp2f(s.x); e.y = __builtin_amdgcn_exp2f(s.y);
    const f32x2 m = v * (q * e), r = v - m;
    f32x2 o; o.x = v.x < 0.f ? m.x : r.x; o.y = v.y < 0.f ? m.y : r.y; return o;
}
__device__ __forceinline__ float silu_f(float x) { return x * __builtin_amdgcn_rcpf(1.0f + __builtin_amdgcn_exp2f(-1.4426950408889634f * x)); }
__device__ __forceinline__ u32x4 pack8(const f32x4 v0, const f32x4 v1) { u32x4 w; w.x = cvt_pk_bf16(v0[0], v0[1]); w.y = cvt_pk_bf16(v0[2], v0[3]); w.z = cvt_pk_bf16(v1[0], v1[1]); w.w = cvt_pk_bf16(v1[2], v1[3]); return w; }

struct EpiBf16Plain {
    static constexpr bool PERM = true, AFTER_DRAIN = false;
    bf16_t* O; int ldc;
    __device__ __forceinline__ void operator()(const f32x4 (&acc)[2][2][4][2], const Unit& u, int wr, int wc, int fr, int fq) const {
        const int row0 = u.pm * BM + wr * 64 + fr, col0 = u.pn * BM + wc * 32 + 8 * fq;
#pragma unroll
        for (int ai = 0; ai < 2; ++ai)
#pragma unroll
            for (int m = 0; m < 4; ++m) { bf16_t* rowp = O + (size_t)(row0 + ai * HALF + m * 16) * ldc + col0;
#pragma unroll
                for (int bj = 0; bj < 2; ++bj) *(u32x4*)(rowp + bj * HALF) = pack8(acc[ai][bj][m][0], acc[ai][bj][m][1]); }
    }
};
struct EpiProj {
    static constexpr bool PERM = true, AFTER_DRAIN = false;
    bf16_t* Q; bf16_t* KV; bf16_t* Z; bf16_t* XBC; float* GLDT;
    __device__ __forceinline__ void operator()(const f32x4 (&acc)[2][2][4][2], const Unit& u, int wr, int wc, int fr, int fq) const {
        const int row0 = u.pm * BM + wr * 64 + fr, pn = u.pn, cl = wc * 32 + 8 * fq;
        if (pn == 11) {
            if (wc == 0) {
#pragma unroll
                for (int ai = 0; ai < 2; ++ai)
#pragma unroll
                    for (int m = 0; m < 4; ++m) { float* rowp = GLDT + (size_t)(row0 + ai * HALF + m * 16) * 32 + 8 * fq;
                        *(f32x4*)(rowp) = acc[ai][0][m][0]; *(f32x4*)(rowp + 4) = acc[ai][0][m][1]; }
            }
            return;
        }
        bf16_t* base0; int stride, laneoff, halfstep;
        if (pn < 2) { base0 = Q + pn * 256; stride = 512; laneoff = cl; halfstep = HALF; }
        else if (pn < 5) { const int b = (u.pm * BM) >> 11; base0 = KV + ((size_t)((pn - 2) * 2) << 21) + (size_t)b * 131072; stride = 64; laneoff = (wc >> 1) * 131072 + (wc & 1) * 32 + 8 * fq; halfstep = 1 << 21; }
        else if (pn < 7) { base0 = Z + (pn - 5) * 256; stride = 512; laneoff = cl; halfstep = HALF; }
        else { base0 = XBC + (pn - 7) * 256; stride = 1024; laneoff = cl; halfstep = HALF; }
        const unsigned off0 = (unsigned)(row0 * stride + laneoff);
#pragma unroll
        for (int ai = 0; ai < 2; ++ai)
#pragma unroll
            for (int m = 0; m < 4; ++m) {
                const unsigned off = off0 + (unsigned)((ai * HALF + m * 16) * stride);
                *(u32x4*)(base0 + off) = pack8(acc[ai][0][m][0], acc[ai][0][m][1]);
                *(u32x4*)(base0 + halfstep + off) = pack8(acc[ai][1][m][0], acc[ai][1][m][1]);
                asm volatile("" ::: "memory");
            }
    }
};
struct EpiSwiGLU {
    static constexpr bool PERM = true, AFTER_DRAIN = false;
    bf16_t* T; int ldc;
    __device__ __forceinline__ void operator()(const f32x4 (&acc)[2][2][4][2], const Unit& u, int wr, int wc, int fr, int fq) const {
        const int row0 = u.pm * BM + wr * 64 + fr, col0 = u.pn * HALF + wc * 32 + 8 * fq;
#pragma unroll
        for (int ai = 0; ai < 2; ++ai)
#pragma unroll
            for (int m = 0; m < 4; ++m) {
                f32x4 v0, v1;
#pragma unroll
                for (int j = 0; j < 4; ++j) { v0[j] = silu_f(acc[ai][0][m][0][j]) * acc[ai][1][m][0][j]; v1[j] = silu_f(acc[ai][0][m][1][j]) * acc[ai][1][m][1][j]; }
                *(u32x4*)(T + (size_t)(row0 + ai * HALF + m * 16) * ldc + col0) = pack8(v0, v1);
            }
    }
};
struct EpiGelu {
    static constexpr bool PERM = true, AFTER_DRAIN = false;
    bf16_t* U; bf16_t* V; float* ST;
    __device__ __forceinline__ void operator()(const f32x4 (&acc)[2][2][4][2], const Unit& u, int wr, int wc, int fr, int fq) const {
        const int row0 = u.pm * BM + wr * 64 + fr, pn = u.pn;
        const bool isv = pn >= 8; bf16_t* base = isv ? V : U; const int col0 = (isv ? pn - 8 : pn) * BM + wc * 32 + 8 * fq;
#pragma unroll
        for (int ai = 0; ai < 2; ++ai)
#pragma unroll
            for (int m = 0; m < 4; ++m) {
                const int row = row0 + ai * HALF + m * 16; float s = 0.f, ss = 0.f;
#pragma unroll
                for (int bj = 0; bj < 2; ++bj) {
                    const f32x4 x0 = acc[ai][bj][m][0], x1 = acc[ai][bj][m][1];
                    const f32x2 a = gelu_pk((f32x2){x0[0], x0[1]}), b = gelu_pk((f32x2){x0[2], x0[3]}), c = gelu_pk((f32x2){x1[0], x1[1]}), d = gelu_pk((f32x2){x1[2], x1[3]});
                    s += (a.x + a.y) + (b.x + b.y) + (c.x + c.y) + (d.x + d.y);
                    ss += (a.x * a.x + a.y * a.y) + (b.x * b.x + b.y * b.y) + (c.x * c.x + c.y * c.y) + (d.x * d.x + d.y * d.y);
                    *(u32x4*)(base + (size_t)row * 2048 + col0 + bj * HALF) = pack8((f32x4){a.x, a.y, b.x, b.y}, (f32x4){c.x, c.y, d.x, d.y});
                }
                if (isv) {
                    s += __shfl_xor(s, 16); s += __shfl_xor(s, 32); ss += __shfl_xor(ss, 16); ss += __shfl_xor(ss, 32);
                    if (fq == 0) *(f32x2*)(ST + ((size_t)row * 32 + (pn - 8) * 4 + wc) * 2) = (f32x2){s, ss};
                }
            }
    }
};
struct EpiCmp {
    static constexpr bool PERM = true, AFTER_DRAIN = false;
    bf16_t* H1; const float* bias;
    __device__ __forceinline__ void operator()(const f32x4 (&acc)[2][2][4][2], const Unit& u, int wr, int wc, int fr, int fq) const {
        const int row0 = u.pm * BM + wr * 64 + fr, cl = wc * 32 + 8 * fq; const float* bs = bias + u.pn * 256;
#pragma unroll
        for (int bj = 0; bj < 2; ++bj) {
            const f32x4 b0 = *(const f32x4*)(bs + bj * HALF + cl), b1 = *(const f32x4*)(bs + bj * HALF + cl + 4);
#pragma unroll
            for (int ai = 0; ai < 2; ++ai)
#pragma unroll
                for (int m = 0; m < 4; ++m) {
                    f32x4 v0 = acc[ai][bj][m][0] + b0, v1 = acc[ai][bj][m][1] + b1;
#pragma unroll
                    for (int j = 0; j < 4; ++j) { v0[j] = silu_f(v0[j]); v1[j] = silu_f(v1[j]); }
                    *(u32x4*)(H1 + (size_t)(row0 + ai * HALF + m * 16) * 256 + bj * HALF + cl) = pack8(v0, v1);
                }
        }
    }
};

template <class Epi, class Sched, bool ALIGN_EPI = false, bool SP2 = false>
__device__ __forceinline__ void gemm_phase(PG8_LAS unsigned char* lds, const Gemm g, const Sched& S, const Epi& E, const int tid) {
    const int wid = __builtin_amdgcn_readfirstlane(tid >> 6), lane = tid & 63, wr = wid >> 2, wc = wid & 3, fr = lane & 15, fq = lane >> 4;
    const int K = g.K, nt = K / BK;
    unsigned voffA[2], voffB[2];
#pragma unroll
    for (int i = 0; i < 2; ++i) { int R, C; stage_rc(tid * 16 + i * 8192, R, C); const int Rb = Epi::PERM ? ((R & ~31) + perm32(R & 31)) : R;
        voffA[i] = (unsigned)(R * g.lda + C) * 2u; voffB[i] = (unsigned)(Rb * K + C) * 2u; }
    const size_t kstep = (size_t)(BK * 2);
    const size_t hstepB = (size_t)HALF * K * 2, hstepA = (size_t)HALF * g.lda * 2;
    const size_t tstepA = 2 * hstepA, tstepB = 2 * hstepB;
    const unsigned ldsw = (unsigned)wid * 1024u;
    const int aoff = lds_byte(wr * 64 + fr, fq * 8), boff = lds_byte(wc * 32 + fr, fq * 8);
#define PG8_SA(b, h) (((b) * 2 + (h)) * HTB)
#define PG8_SB(b, h) ((4 + (b) * 2 + (h)) * HTB)
#define PG8_STAGE(bufoff, gbase, voff) do { _Pragma("unroll") for (int _i = 0; _i < 2; ++_i) \
        __builtin_amdgcn_global_load_lds((const unsigned*)((const char*)(gbase) + (voff)[_i]), (PG8_LAS unsigned*)(lds + (bufoff) + ldsw + _i * 8192), 16, 0, 0); } while (0)
#define PG8_LDA(dst, b, h) do { _Pragma("unroll") for (int m = 0; m < 4; ++m) _Pragma("unroll") for (int k = 0; k < 2; ++k) dst[m][k] = *(const PG8_LAS bf16x8*)(lds + PG8_SA(b, h) + aoff + m * 2048 + k * 1024); } while (0)
#define PG8_LDB(dst, b, h) do { _Pragma("unroll") for (int n = 0; n < 2; ++n) _Pragma("unroll") for (int k = 0; k < 2; ++k) dst[n][k] = *(const PG8_LAS bf16x8*)(lds + PG8_SB(b, h) + boff + n * 2048 + k * 1024); } while (0)
#define PG8_MMA(ai, bj, At, Bt) do { __builtin_amdgcn_s_setprio(1); _Pragma("unroll") for (int m = 0; m < 4; ++m) _Pragma("unroll") for (int n = 0; n < 2; ++n) _Pragma("unroll") for (int k = 0; k < 2; ++k) \
        acc[ai][bj][m][n] = __builtin_amdgcn_mfma_f32_16x16x32_bf16(Bt[n][k], At[m][k], acc[ai][bj][m][n], 0, 0, 0); __builtin_amdgcn_s_setprio(0); } while (0)
#define PG8_WAIT_V(n) asm volatile("s_waitcnt vmcnt(" #n ")" ::: "memory")
#define PG8_WAIT_L(n) asm volatile("s_waitcnt lgkmcnt(" #n ")" ::: "memory")
#define PG8_BAR __builtin_amdgcn_s_barrier()
#define PG8_SCHED __builtin_amdgcn_sched_barrier(0)
    Unit cur, nxt; int ui = 0;
    if (!S.next(0, cur)) return;
    f32x4 acc[2][2][4][2];
#pragma unroll
    for (int a = 0; a < 2; ++a)
#pragma unroll
        for (int b = 0; b < 2; ++b)
#pragma unroll
            for (int m = 0; m < 4; ++m)
#pragma unroll
                for (int n = 0; n < 2; ++n) acc[a][b][m][n] = (f32x4){0.f, 0.f, 0.f, 0.f};
    bf16x8 At[4][2], B0[2][2], B1[2][2];
    const char* cA = (const char*)g.A + (size_t)cur.pm * tstepA; const char* cB = (const char*)g.Bt + (size_t)cur.pn * tstepB;
    S.a_ready(cur);
    if constexpr (SP2) {
        PG8_STAGE(PG8_SB(0, 0), cB, voffB); PG8_STAGE(PG8_SB(0, 1), cB + hstepB, voffB); PG8_STAGE(PG8_SA(0, 0), cA, voffA); PG8_STAGE(PG8_SA(0, 1), cA + hstepA, voffA);
        if (wr == 1) PG8_BAR;
        PG8_WAIT_V(2); PG8_BAR;
        PG8_STAGE(PG8_SB(1, 0), cB + kstep, voffB); PG8_STAGE(PG8_SA(1, 0), cA + kstep, voffA); PG8_STAGE(PG8_SB(1, 1), cB + hstepB + kstep, voffB);
        PG8_WAIT_V(6); PG8_BAR;
    } else {
        PG8_STAGE(PG8_SB(0, 0), cB, voffB); PG8_STAGE(PG8_SA(0, 0), cA, voffA); PG8_STAGE(PG8_SB(0, 1), cB + hstepB, voffB); PG8_STAGE(PG8_SA(0, 1), cA + hstepA, voffA);
        if (wr == 1) PG8_BAR;
        PG8_WAIT_V(4); PG8_BAR;
        PG8_STAGE(PG8_SB(1, 0), cB + kstep, voffB); PG8_STAGE(PG8_SA(1, 0), cA + kstep, voffA); PG8_STAGE(PG8_SB(1, 1), cB + hstepB + kstep, voffB);
        PG8_WAIT_V(6); PG8_BAR;
    }
    for (;;) {
        const bool has_next = S.next(ui + 1, nxt);
        const char* nA = has_next ? (const char*)g.A + (size_t)nxt.pm * tstepA : cA; const char* nB = has_next ? (const char*)g.Bt + (size_t)nxt.pn * tstepB : cB;
        for (int t = 0; t < nt; t += 2) {
            const bool last = (t == nt - 2);
            const char* a1 = cA + (size_t)(t + 1) * kstep;
            const char* a2 = last ? nA : cA + (size_t)(t + 2) * kstep; const char* b2 = last ? nB : cB + (size_t)(t + 2) * kstep;
            const char* a3 = a2 + kstep; const char* b3 = b2 + kstep;
            if (last && has_next) S.a_ready(nxt);
            if constexpr (SP2) {
            PG8_LDB(B0, 0, 0); PG8_LDB(B1, 0, 1); PG8_SCHED; PG8_LDA(At, 0, 0); PG8_STAGE(PG8_SA(1, 1), a1 + hstepA, voffA);
            PG8_WAIT_V(8); PG8_WAIT_L(0); PG8_BAR; PG8_MMA(0, 0, At, B0); PG8_MMA(0, 1, At, B1); PG8_BAR; PG8_SCHED;
            PG8_LDA(At, 0, 1); PG8_STAGE(PG8_SB(0, 0), b2, voffB); PG8_STAGE(PG8_SB(0, 1), b2 + hstepB, voffB); PG8_STAGE(PG8_SA(0, 0), a2, voffA);
            PG8_WAIT_V(8); PG8_WAIT_L(0); PG8_BAR; PG8_MMA(1, 0, At, B0); PG8_MMA(1, 1, At, B1); PG8_BAR; PG8_SCHED;
            PG8_LDB(B0, 1, 0); PG8_LDB(B1, 1, 1); PG8_SCHED; PG8_LDA(At, 1, 0); PG8_STAGE(PG8_SA(0, 1), a2 + hstepA, voffA);
            PG8_WAIT_V(8); PG8_WAIT_L(0); PG8_BAR; PG8_MMA(0, 0, At, B0); PG8_MMA(0, 1, At, B1); PG8_BAR; PG8_SCHED;
            PG8_LDA(At, 1, 1); PG8_STAGE(PG8_SB(1, 0), b3, voffB); PG8_STAGE(PG8_SB(1, 1), b3 + hstepB, voffB); PG8_STAGE(PG8_SA(1, 0), a3, voffA);
            PG8_WAIT_V(8); PG8_WAIT_L(0); PG8_BAR; PG8_MMA(1, 0, At, B0); PG8_MMA(1, 1, At, B1); PG8_BAR; PG8_SCHED;
            } else {
            PG8_LDB(B0, 0, 0); PG8_SCHED; PG8_LDA(At, 0, 0); PG8_STAGE(PG8_SA(1, 1), a1 + hstepA, voffA);
            PG8_WAIT_L(8); PG8_BAR; PG8_WAIT_L(0); PG8_MMA(0, 0, At, B0); PG8_BAR; PG8_SCHED;
            PG8_LDB(B1, 0, 1); PG8_STAGE(PG8_SB(0, 0), b2, voffB);
            PG8_BAR; PG8_WAIT_L(0); PG8_MMA(0, 1, At, B1); PG8_BAR;
            PG8_LDA(At, 0, 1); PG8_STAGE(PG8_SA(0, 0), a2, voffA);
            PG8_BAR; PG8_WAIT_L(0); PG8_MMA(1, 0, At, B0); PG8_BAR; PG8_SCHED;
            PG8_STAGE(PG8_SB(0, 1), b2 + hstepB, voffB);
            PG8_WAIT_V(6); PG8_BAR; PG8_MMA(1, 1, At, B1); PG8_BAR;
            PG8_LDB(B0, 1, 0); PG8_SCHED; PG8_LDA(At, 1, 0); PG8_STAGE(PG8_SA(0, 1), a2 + hstepA, voffA);
            PG8_WAIT_L(8); PG8_BAR; PG8_WAIT_L(0); PG8_MMA(0, 0, At, B0); PG8_BAR; PG8_SCHED;
            PG8_LDB(B1, 1, 1); PG8_STAGE(PG8_SB(1, 0), b3, voffB);
            PG8_BAR; PG8_WAIT_L(0); PG8_MMA(0, 1, At, B1); PG8_BAR;
            PG8_LDA(At, 1, 1); PG8_STAGE(PG8_SA(1, 0), a3, voffA);
            PG8_BAR; PG8_WAIT_L(0); PG8_MMA(1, 0, At, B0); PG8_BAR; PG8_SCHED;
            PG8_STAGE(PG8_SB(1, 1), b3 + hstepB, voffB);
            PG8_WAIT_V(6); PG8_BAR; PG8_MMA(1, 1, At, B1); PG8_BAR;
            }
        }
        if constexpr (ALIGN_EPI) { if (wr == 0) PG8_BAR; }
        if constexpr (!Epi::AFTER_DRAIN) { E(acc, cur, wr, wc, fr, fq); S.done(cur); }
        if (!has_next) break;
#pragma unroll
        for (int a = 0; a < 2; ++a)
#pragma unroll
            for (int b = 0; b < 2; ++b)
#pragma unroll
                for (int m = 0; m < 4; ++m)
#pragma unroll
                    for (int n = 0; n < 2; ++n) acc[a][b][m][n] = (f32x4){0.f, 0.f, 0.f, 0.f};
        cur = nxt; cA = nA; cB = nB; ++ui;
        if constexpr (ALIGN_EPI) { if (wr == 1) PG8_BAR; }
    }
    PG8_WAIT_V(0);
    if constexpr (!ALIGN_EPI) { if (wr == 0) PG8_BAR; }
    PG8_BAR;
    if constexpr (Epi::AFTER_DRAIN) { E.fused(acc, cur, wr, wc, fr, fq, lds, wid, lane); S.done(cur); }
#undef PG8_SA
#undef PG8_SB
#undef PG8_STAGE
#undef PG8_LDA
#undef PG8_LDB
#undef PG8_MMA
#undef PG8_WAIT_V
#undef PG8_WAIT_L
#undef PG8_BAR
#undef PG8_SCHED
}
}

constexpr int NWAVES = 8;
constexpr int BATCH = 8, SEQ = 2048, D = 1024, M = BATCH * SEQ, FFH = 2816, DEPTH = 4;
constexpr int EV_IN = 2848, EV_IN_PAD = 3072;
constexpr float RMS_EPS = 1e-6f, LN_EPS = 1e-5f;

constexpr size_t MiB = 1u << 20;
constexpr size_t WS_CTL = 0, CTL_ZERO_BYTES = 64 * 1024;
constexpr size_t WS_SMALL = 1 * MiB;
constexpr size_t WS_WFFN = 2 * MiB, WFFN_STRIDE = 17301504;
constexpr size_t WS_WEV = 68 * MiB, WEV_STRIDE = 10 * MiB;
constexpr size_t WS_WOD = 88 * MiB, WOD_STRIDE = 12 * MiB;
constexpr size_t WS_A = 112 * MiB;
constexpr size_t WS_BIG = 144 * MiB;
constexpr size_t WS_Q = WS_BIG, WS_KV = WS_BIG + 16 * MiB, WS_Z = WS_BIG + 40 * MiB, WS_XBC = WS_BIG + 56 * MiB, WS_GLDT = WS_BIG + 88 * MiB, WS_YD = WS_BIG + 90 * MiB  ,
                 WS_SST = WS_BIG + 106 * MiB  , WS_CCONV = WS_BIG + 122 * MiB  , WS_H1 = WS_BIG + 130 * MiB, WS_KCB = WS_BIG + 132 * MiB, WS_YEV = WS_BIG;
constexpr size_t WS_W2T = WS_SMALL + 768 * 1024  ;
constexpr size_t WS_ACSG = WS_SMALL + 64 * 1024  , WS_ATOT = WS_SMALL + 640 * 1024  ;
constexpr size_t WS_T = WS_BIG, WS_YFF = WS_BIG + 88 * MiB;
constexpr size_t WS_U = WS_BIG, WS_V = WS_BIG + 64 * MiB, WS_ST = WS_BIG + 128 * MiB, WS_YOD = WS_BIG + 64 * MiB;
constexpr size_t WS_END = 280 * MiB;
constexpr int CW_BAR = 4096;

constexpr int SCR_BYTES = 152 * 1024;
constexpr int MISC_OFF = SCR_BYTES;
constexpr int LDS_BYTES = SCR_BYTES + 512;

#define GAS __attribute__((address_space(1)))
#define LAS __attribute__((address_space(3)))
typedef unsigned short bf16;
typedef unsigned v4u __attribute__((ext_vector_type(4)));
typedef unsigned v2u __attribute__((ext_vector_type(2)));
typedef float f32x4 __attribute__((ext_vector_type(4)));
typedef float f32x2 __attribute__((ext_vector_type(2)));
typedef GAS unsigned gu32;
#define RLX_AGENT __ATOMIC_RELAXED, __HIP_MEMORY_SCOPE_AGENT
#define LDS_WAIT() asm volatile("s_waitcnt lgkmcnt(0)" ::: "memory")
#define VM_WAIT() asm volatile("s_waitcnt vmcnt(0)" ::: "memory")
__device__ __forceinline__ unsigned f2bf(float f) { unsigned u = __builtin_bit_cast(unsigned, f); return (u + 0x7fffu + ((u >> 16) & 1u)) >> 16; }
__device__ __forceinline__ unsigned pk2(float lo, float hi) { return f2bf(lo) | (f2bf(hi) << 16); }
__device__ __forceinline__ float bflo(unsigned w) { return __builtin_bit_cast(float, w << 16); }
__device__ __forceinline__ float bfhi(unsigned w) { return __builtin_bit_cast(float, w & 0xffff0000u); }
__device__ __forceinline__ float bf2f(bf16 h) { return __builtin_bit_cast(float, (unsigned)h << 16); }
__device__ __forceinline__ float wave_sum(float v) {
#pragma unroll
    for (int o = 1; o < 64; o <<= 1) v += __shfl_xor(v, o);
    return v;
}
__device__ __forceinline__ float wave_max(float v) {
#pragma unroll
    for (int o = 1; o < 64; o <<= 1) v = fmaxf(v, __shfl_xor(v, o));
    return v;
}
__device__ __forceinline__ float silu_f(float x) { return x / (1.0f + __expf(-x)); }
__device__ __forceinline__ float sigmoid_f(float x) { return 1.0f / (1.0f + __expf(-x)); }

__device__ __forceinline__ int flane() { return (int)__builtin_amdgcn_mbcnt_hi(~0u, __builtin_amdgcn_mbcnt_lo(~0u, 0u)); }
#define XB_TMO      128
#define XB_XCNT(j)  (256  + 64 * (j))
#define XB_XSUB(j)  (1280 + 64 * (j))
#define XB_XGEN(j)  (2304 + 64 * (j))
#define XB_TOP      3328
#define XB_TOPGEN   3392
#define XCD_BAR_WORDS 3456
#define XB_SPIN_CAP (1u << 22)

__device__ __forceinline__ unsigned xb_ld(unsigned* p)              { return __hip_atomic_load(p, __ATOMIC_RELAXED, __HIP_MEMORY_SCOPE_AGENT); }
__device__ __forceinline__ unsigned xb_add(unsigned* p, unsigned v) { return __hip_atomic_fetch_add(p, v, __ATOMIC_RELAXED, __HIP_MEMORY_SCOPE_AGENT); }
__device__ __forceinline__ unsigned xb_xcc_id() { return (unsigned)__builtin_amdgcn_s_getreg((3 << 11) | 20) & 0xFu; }
#define XB_SPIN(cond, bar) do { unsigned _sp = 0; while (cond) { __builtin_amdgcn_s_sleep(1); \
    if ((++_sp & 255u) == 0u) { if (xb_ld(&(bar)[XB_TMO])) break; if (_sp > XB_SPIN_CAP) { atomicAdd(&(bar)[XB_TMO], 1u); break; } } } } while (0)

struct XcdBarrier { unsigned* bar; unsigned x; volatile LAS unsigned* st; };
__device__ __forceinline__ XcdBarrier xcd_barrier_post(unsigned* bar, volatile LAS unsigned* st) {
    XcdBarrier b; b.bar = bar; b.x = xb_xcc_id(); b.st = st;
    if (threadIdx.x == 0) (void)xb_add(&bar[XB_XCNT(b.x)], 1u);
    return b;
}
__device__ __forceinline__ void xcd_barrier_complete(unsigned* bar, unsigned x, unsigned& nloc, unsigned& nx) {
    const unsigned G = gridDim.x * gridDim.y * gridDim.z;
    unsigned sum, cnt, mine, sp = 0u;
    for (;;) {
        sum = 0u; cnt = 0u; mine = 0u;
#pragma unroll
        for (unsigned j = 0; j < 16; ++j) { const unsigned c = xb_ld(&bar[XB_XCNT(j)]); sum += c; cnt += (c > 0u) ? 1u : 0u; mine = (j == x) ? c : mine; }
        if (sum == G) break;
        __builtin_amdgcn_s_sleep(1);
        if ((++sp & 255u) == 0u) { if (xb_ld(&bar[XB_TMO])) break; if (sp > XB_SPIN_CAP) { atomicAdd(&bar[XB_TMO], 1u); break; } }
    }
    nloc = mine > 0u ? mine : 1u; nx = cnt > 0u ? cnt : 1u;
}
__device__ __forceinline__ void xcd_barrier(const XcdBarrier& b, const int wave) {
    asm volatile("s_waitcnt vmcnt(0)" ::: "memory");
    __syncthreads();
    if (wave == 0 && flane() == 0) {
        unsigned* bar = b.bar;
        __builtin_amdgcn_s_waitcnt(0);
        unsigned nloc = b.st[0], nx = b.st[1];
        if (nloc == 0u) { xcd_barrier_complete(bar, b.x, nloc, nx); b.st[0] = nloc; b.st[1] = nx; }
        const unsigned old = xb_add(&bar[XB_XSUB(b.x)], 1u);
        const unsigned gen = old / nloc;
        if (old + 1u == (gen + 1u) * nloc) {
            __builtin_amdgcn_fence(__ATOMIC_RELEASE, "agent");
            asm volatile("s_waitcnt vmcnt(0)" ::: "memory");
            const unsigned og = xb_add(&bar[XB_TOP], 1u);
            const unsigned tg = og / nx;
            if (og + 1u == (tg + 1u) * nx) xb_add(&bar[XB_TOPGEN], 1u);
            else XB_SPIN(xb_ld(&bar[XB_TOPGEN]) == tg, bar);
            __builtin_amdgcn_fence(__ATOMIC_ACQUIRE, "agent");
            xb_add(&bar[XB_XGEN(b.x)], 1u);
            asm volatile("s_waitcnt vmcnt(0)" ::: "memory");
        } else {
            XB_SPIN(xb_ld(&bar[XB_XGEN(b.x)]) == gen, bar);
            __builtin_amdgcn_fence(__ATOMIC_ACQUIRE, "agent");
            asm volatile("s_waitcnt vmcnt(0)" ::: "memory");
        }
    }
    __syncthreads();
}

struct Frame {
    LAS unsigned char* lds;
    unsigned char* ws;
    int tid, lane, wave, G, bid;
    float* out;
};

enum InIdx { I_X = 0, I_GAINS, I_WG, I_WU, I_WD, I_EVIN, I_EVOUT, I_PE, I_CW1, I_CW2, I_CONVW, I_CONVB, I_DTB, I_ALOG, I_DSKIP, I_SNORM, I_ODIN, I_LNW, I_LNB, I_WS, I_BS, I_ODOUT };

__device__ __forceinline__ const float* inp(const Frame& F, int i) {
    volatile LAS unsigned* t = (volatile LAS unsigned*)(F.lds + MISC_OFF) + 32 + 2 * i;
    const unsigned lo = __builtin_amdgcn_readfirstlane(t[0]), hi = __builtin_amdgcn_readfirstlane(t[1]);
    return (const float*)(((unsigned long long)hi << 32) | lo);
}
struct TJob { const float* W; int K, N; bf16* dst; int mode; const float* gain; int gain_lo; int row_off; };
__device__ __forceinline__ int evin_row(int n) {
    if (n < 1280) return n;
    if (n < 1304) return 2816 + (n - 1280);
    if (n < 1816) return 1280 + (n - 1304);
    if (n < 2840) return 1792 + (n - 1816);
    return 2840 + (n - 2840);
}
__device__ __forceinline__ void transpose_item(const TJob& J, int local, LAS float* scr, int lane) {
    const int nblk = J.N / 32, kb = local / nblk, nb = local % nblk, k0 = 64 * kb, n0 = 32 * nb;
#pragma unroll 8
    for (int i = 0; i < 32; ++i) { const int kk = 2 * i + (lane >> 5), k = k0 + kk; float g = 1.0f; if (J.gain != nullptr && k >= J.gain_lo) g = J.gain[k];
        scr[kk * 33 + (lane & 31)] = J.W[(size_t)k * J.N + n0 + (lane & 31)] * g; }
    LDS_WAIT(); asm volatile("" ::: "memory");
    const int c = lane & 7;
#pragma unroll
    for (int j = 0; j < 4; ++j) { const int n = (lane >> 3) + 8 * j, nn = n0 + n; const LAS float* s = scr + (8 * c) * 33 + n;
        int dr; float sc = 1.0f;
        if (J.mode == 0) dr = J.row_off + nn; else if (J.mode == 1) dr = 256 * (nn >> 7) + (nn & 127) + J.row_off; else { dr = evin_row(nn); if (nn < 512) sc = 0.125f * 1.4426950408889634f; }
        v4u o; o.x = pk2(s[0 * 33] * sc, s[1 * 33] * sc); o.y = pk2(s[2 * 33] * sc, s[3 * 33] * sc); o.z = pk2(s[4 * 33] * sc, s[5 * 33] * sc); o.w = pk2(s[6 * 33] * sc, s[7 * 33] * sc);
        *(v4u*)(J.dst + (size_t)dr * J.K + k0 + 8 * c) = o; }
    LDS_WAIT(); asm volatile("" ::: "memory");
}
constexpr int IT_FFN = 16 * 88, IT_EVIN = 16 * 89, IT_EVOUT = 16 * 32, IT_W1 = 32 * 8, IT_ODIN = 16 * 128, IT_ODOUT = 32 * 32;
constexpr int IT_EV = IT_EVIN + IT_EVOUT + 2 * IT_W1, IT_OD = IT_ODIN + IT_ODOUT;
constexpr int IT_W2 = 4 * 2;
constexpr int N_TRANS = 12 * IT_FFN + 2 * IT_EV + 2 * IT_OD + 4 * IT_W2;
__device__ __forceinline__ void get_job(Frame& F, int it, TJob& J, int& local) {
    if (it < 12 * IT_FFN) { const int L = it / (3 * IT_FFN), r = it % (3 * IT_FFN), w = r / IT_FFN; local = r % IT_FFN;
        bf16* base = (bf16*)(F.ws + WS_WFFN + (size_t)L * WFFN_STRIDE);
        if (w == 0) J = TJob{inp(F, I_WG) + (size_t)L * D * FFH, D, FFH, base, 1, inp(F, I_GAINS) + (L * 4 + 2) * D, 0, 0};
        else if (w == 1) J = TJob{inp(F, I_WU) + (size_t)L * D * FFH, D, FFH, base, 1, inp(F, I_GAINS) + (L * 4 + 2) * D, 0, 128};
        else J = TJob{inp(F, I_WD) + (size_t)L * FFH * D, FFH, D, base + (size_t)5632 * 1024, 0, nullptr, 0, 0};
        return; }
    it -= 12 * IT_FFN;
    if (it < 2 * IT_EV) { const int i = it / IT_EV; int r = it % IT_EV; unsigned char* base = F.ws + WS_WEV + (size_t)i * WEV_STRIDE;
        if (r < IT_EVIN) { local = r; J = TJob{inp(F, I_EVIN) + (size_t)i * D * EV_IN, D, EV_IN, (bf16*)base, 2, inp(F, I_GAINS) + (2 * i * 4 + 0) * D, 0, 0}; return; } r -= IT_EVIN;
        if (r < IT_EVOUT) { local = r; J = TJob{inp(F, I_EVOUT) + (size_t)i * D * D, D, D, (bf16*)(base + 6 * MiB), 0, inp(F, I_SNORM) + i * 512 - 512, 512, 0}; return; } r -= IT_EVOUT;
        const int kv = r / IT_W1; local = r % IT_W1;
        J = TJob{inp(F, I_CW1) + (size_t)(i * 2 + kv) * 2048 * 256, 2048, 256, (bf16*)(base + 8 * MiB), 0, nullptr, 0, kv * 256}; return; }
    it -= 2 * IT_EV;
    if (it >= 2 * IT_OD) { it -= 2 * IT_OD; const int ik = it / IT_W2; local = it % IT_W2;
        J = TJob{inp(F, I_CW2) + (size_t)ik * 256 * 64, 256, 64, (bf16*)(F.ws + WS_W2T) + (size_t)ik * 64 * 256, 0, nullptr, 0, 0}; return; }
    { const int i = it / IT_OD; int r = it % IT_OD; unsigned char* base = F.ws + WS_WOD + (size_t)i * WOD_STRIDE;
        if (r < IT_ODIN) { local = r; J = TJob{inp(F, I_ODIN) + (size_t)i * D * 4096, D, 4096, (bf16*)base, 0, inp(F, I_GAINS) + ((2 * i + 1) * 4 + 0) * D, 0, 0}; return; } r -= IT_ODIN;
        local = r; J = TJob{inp(F, I_ODOUT) + (size_t)i * 2048 * D, 2048, D, (bf16*)(base + 8 * MiB), 0, nullptr, 0, 0}; }
}
__device__ __forceinline__ void rms_row_to_bf16(const float* xrow, bf16* orow, int lane) {
    const f32x4* xr = (const f32x4*)xrow + lane;
    f32x4 v[4]; float s = 0.f;
#pragma unroll
    for (int j = 0; j < 4; ++j) { v[j] = xr[64 * j]; s += (v[j].x * v[j].x + v[j].y * v[j].y) + (v[j].z * v[j].z + v[j].w * v[j].w); }
    const float rstd = 1.0f / sqrtf(wave_sum(s) * (1.f / D) + RMS_EPS);
    v2u* o8 = (v2u*)orow + lane;
#pragma unroll
    for (int j = 0; j < 4; ++j) o8[64 * j] = (v2u){pk2(v[j].x * rstd, v[j].y * rstd), pk2(v[j].z * rstd, v[j].w * rstd)};
}
__device__ __forceinline__ void p0_prologue(Frame& F) {
    LAS float* scr = (LAS float*)(F.lds + F.wave * 16384);
    const int gw = F.bid * NWAVES + F.wave, NGW = F.G * NWAVES;
    for (int it = gw; it < N_TRANS; it += NGW) { TJob J; int local; get_job(F, it, J, local); transpose_item(J, local, scr, F.lane); }
    float* bias1 = (float*)(F.ws + WS_SMALL);
    for (int o = gw; o < 1024; o += NGW) { const int ik = o >> 8, j = o & 255; const float* pe = inp(F, I_PE) + (size_t)ik * 2048; const float* w1 = inp(F, I_CW1) + (size_t)ik * 2048 * 256 + j;
        float s = 0.f;
        for (int t = 0; t < 32; ++t) { const int k = t * 64 + F.lane; s += pe[k] * w1[(size_t)k * 256]; }
        s = wave_sum(s); if (F.lane == 0) bias1[o] = s; }
    for (int m = gw; m < M; m += NGW) rms_row_to_bf16(inp(F, I_X) + (size_t)m * D, (bf16*)(F.ws + WS_A) + (size_t)m * D, F.lane);
}

__device__ __forceinline__ void rowpass(Frame& F, const bf16* Y, const float* hin, float* hout, bf16* aout, const float* gain) {
    const int gw = F.bid * NWAVES + F.wave, NGW = F.G * NWAVES, lane = F.lane;
    f32x4 gv[4];
#pragma unroll
    for (int j = 0; j < 4; ++j) gv[j] = ((const f32x4*)gain)[lane + 64 * j];
    for (int m = gw; m < M; m += NGW) {
        const v2u* yr = (const v2u*)(Y + (size_t)m * D) + lane; const f32x4* hr = (const f32x4*)(hin + (size_t)m * D) + lane;
        f32x4 y[4], h[4]; float s = 0.f;
#pragma unroll
        for (int j = 0; j < 4; ++j) { const v2u w = yr[64 * j]; y[j] = (f32x4){bflo(w.x), bfhi(w.x), bflo(w.y), bfhi(w.y)}; h[j] = hr[64 * j];
            s += (y[j].x * y[j].x + y[j].y * y[j].y) + (y[j].z * y[j].z + y[j].w * y[j].w); }
        const float rstd = 1.0f / sqrtf(wave_sum(s) * (1.f / D) + RMS_EPS);
        float s2 = 0.f;
#pragma unroll
        for (int j = 0; j < 4; ++j) { h[j] = h[j] + y[j] * rstd * gv[j]; s2 += (h[j].x * h[j].x + h[j].y * h[j].y) + (h[j].z * h[j].z + h[j].w * h[j].w); }
        f32x4* ho = (f32x4*)(hout + (size_t)m * D) + lane;
#pragma unroll
        for (int j = 0; j < 4; ++j) ho[64 * j] = h[j];
        if (aout != nullptr) {
            const float r2 = 1.0f / sqrtf(wave_sum(s2) * (1.f / D) + RMS_EPS);
            v2u* o8 = (v2u*)(aout + (size_t)m * D) + lane;
#pragma unroll
            for (int j = 0; j < 4; ++j) o8[64 * j] = (v2u){pk2(h[j].x * r2, h[j].y * r2), pk2(h[j].z * r2, h[j].w * r2)};
        }
    }
}

__device__ __forceinline__ void compress2_mfma(Frame& F, int ie) {
    const int gw = F.bid * NWAVES + F.wave; if (gw >= 128) return;
    const int lane = F.lane, r32 = lane & 31, hi = lane >> 5, r0 = 32 * gw, kv = r0 >> 11;
    const bf16* H1 = (const bf16*)(F.ws + WS_H1) + (size_t)(r0 + r32) * 256 + hi * 8; const bf16* W2 = (const bf16*)(F.ws + WS_W2T) + (size_t)(ie * 2 + kv) * 64 * 256 + (size_t)r32 * 256 + hi * 8;
    bf16* KCB = (bf16*)(F.ws + WS_KCB);
    typedef short bf16x8w __attribute__((ext_vector_type(8))); typedef float f32x16w __attribute__((ext_vector_type(16)));
    f32x16w c0 = {0.f, 0.f, 0.f, 0.f, 0.f, 0.f, 0.f, 0.f, 0.f, 0.f, 0.f, 0.f, 0.f, 0.f, 0.f, 0.f}, c1 = c0;
#pragma unroll 4
    for (int ks = 0; ks < 16; ++ks) { const bf16x8w av = *(const bf16x8w*)(H1 + ks * 16), b0 = *(const bf16x8w*)(W2 + ks * 16), b1 = *(const bf16x8w*)(W2 + 32 * 256 + ks * 16);
        c0 = __builtin_amdgcn_mfma_f32_32x32x16_bf16(av, b0, c0, 0, 0, 0); c1 = __builtin_amdgcn_mfma_f32_32x32x16_bf16(av, b1, c1, 0, 0, 0); }
#pragma unroll
    for (int i = 0; i < 16; ++i) { const int row = r0 + (i & 3) + 8 * (i >> 2) + 4 * hi; KCB[(size_t)row * 64 + r32] = (bf16)f2bf(c0[i]); KCB[(size_t)row * 64 + 32 + r32] = (bf16)f2bf(c1[i]); }
}
__device__ __forceinline__ void ssm_scan_chunks(Frame& F) {
    const int idx = F.bid * 512 + F.tid; if (idx >= 8 * 8 * 64 * 16) return;
    const int n8 = (idx & 15) * 8, p = (idx >> 4) & 63, h = (idx >> 10) & 7, b = idx >> 13;
    bf16* ST = (bf16*)(F.ws + WS_SST) + (((size_t)(b * 16) * 8 + h) * 64 + p) * 128 + n8; const float* AT = (const float*)(F.ws + WS_ATOT) + (size_t)(b * 16) * 8 + h;
    v4u st[16]; float dec[16];
#pragma unroll
    for (int c = 0; c < 16; ++c) { st[c] = *(const v4u*)(ST + (size_t)c * 65536); dec[c] = __expf(AT[c * 8]); }
    float z0 = 0.f; asm volatile("" : "+v"(z0));
    float cr[8] = {z0, z0, z0, z0, z0, z0, z0, z0};
#pragma unroll
    for (int c = 0; c < 16; ++c) {
        *(v4u*)(ST + (size_t)c * 65536) = (v4u){pk2(cr[0], cr[1]), pk2(cr[2], cr[3]), pk2(cr[4], cr[5]), pk2(cr[6], cr[7])};
        const v4u x = st[c]; const float d = dec[c];
        cr[0] = cr[0] * d + bflo(x.x); cr[1] = cr[1] * d + bfhi(x.x); cr[2] = cr[2] * d + bflo(x.y); cr[3] = cr[3] * d + bfhi(x.y);
        cr[4] = cr[4] * d + bflo(x.z); cr[5] = cr[5] * d + bfhi(x.z); cr[6] = cr[6] * d + bflo(x.w); cr[7] = cr[7] * d + bfhi(x.w); }
}
typedef short bf16x8v __attribute__((ext_vector_type(8)));
typedef float f32x16 __attribute__((ext_vector_type(16)));
__device__ __forceinline__ int crow(int r, int hi) { return (r & 3) + 8 * (r >> 2) + 4 * hi; }
template <int KS> __device__ __forceinline__ f32x16 mma_rows(const LAS unsigned char* arow, const LAS unsigned char* brow, f32x16 acc) {
#pragma unroll
    for (int ks = 0; ks < KS; ++ks) { const bf16x8v a = *(const LAS bf16x8v*)(arow + ks * 32), b = *(const LAS bf16x8v*)(brow + ks * 32); acc = __builtin_amdgcn_mfma_f32_32x32x16_bf16(a, b, acc, 0, 0, 0); }
    return acc;
}
constexpr int SP = 272;
constexpr int S1_BC = 0, S1_BT = 34816, S1_CM = 69632, S1_XD = 104448, S1_XE = 121856, S1_DT = 139264, S1_ACS = 141312;
static_assert(S1_ACS + 2048 <= SCR_BYTES, "SSM S1 LDS map");
__device__ __forceinline__ float softplus_f(float x) { return fmaxf(x, 0.f) + log1pf(__expf(-fabsf(x))); }

__device__ __forceinline__ void ssm_s1_item(Frame& F, int ie, int item) {
    const int tid = F.tid, lane = F.lane, w = F.wave, r32 = lane & 31, hi = lane >> 5;
    const int g = item & 1, bc = item >> 1, c = bc & 15, b = bc >> 4; const size_t R0 = (size_t)b * SEQ + c * 128;
    LAS unsigned char* L = F.lds;
    LAS float* DT = (LAS float*)(L + S1_DT); LAS float* ACS = (LAS float*)(L + S1_ACS);
    const bf16* X = (const bf16*)(F.ws + WS_XBC); const float* GLDT = (const float*)(F.ws + WS_GLDT);
    bf16* YD = (bf16*)(F.ws + WS_YD); bf16* STg = (bf16*)(F.ws + WS_SST); bf16* CCONV = (bf16*)(F.ws + WS_CCONV); float* ACSG = (float*)(F.ws + WS_ACSG); float* ATOT = (float*)(F.ws + WS_ATOT);
    const float* cw = inp(F, I_CONVW) + (size_t)ie * 4 * 1024; const float* cb = inp(F, I_CONVB) + (size_t)ie * 1024;
    __syncthreads();
    if (w < 4) { const int h = 4 * g + w; const float Ah = -__expf(inp(F, I_ALOG)[ie * 8 + h]), dtb = inp(F, I_DTB)[ie * 8 + h];
        const float d0 = softplus_f(GLDT[(R0 + 2 * lane) * 32 + 24 + h] + dtb), d1 = softplus_f(GLDT[(R0 + 2 * lane + 1) * 32 + 24 + h] + dtb);
        const float a0 = d0 * Ah, a1 = d1 * Ah; float s = a0 + a1;
#pragma unroll
        for (int o = 1; o < 64; o <<= 1) { const float t = __shfl_up(s, o); if (lane >= o) s += t; }
        DT[w * 128 + 2 * lane] = d0; DT[w * 128 + 2 * lane + 1] = d1; ACS[w * 128 + 2 * lane] = s - a1; ACS[w * 128 + 2 * lane + 1] = s;
        ACSG[(R0 + 2 * lane) * 8 + h] = s - a1; ACSG[(R0 + 2 * lane + 1) * 8 + h] = s;
        if (lane == 63) ATOT[(size_t)bc * 8 + h] = s; }
    { const int grp = tid & 31, seg = tid >> 5, isC = grp >> 4, n8 = (grp & 15) * 8, ch = 512 + 256 * isC + 128 * g + n8;
      float wk[4][8], bias[8], xr[4][8];
#pragma unroll
      for (int e = 0; e < 8; ++e) { bias[e] = cb[ch + e];
#pragma unroll
          for (int k = 0; k < 4; ++k) wk[k][e] = cw[k * 1024 + ch + e]; }
#pragma unroll
      for (int j = 0; j < 11; ++j) {
          const int l = 8 * seg - 3 + j; const bool ok = (c * 128 + l) >= 0;
          v4u x = (v4u){0u, 0u, 0u, 0u}; if (ok) x = *(const v4u*)(X + (size_t)((long)R0 + l) * 1024 + ch);
          const int sl = j & 3;
          xr[sl][0] = bflo(x.x); xr[sl][1] = bfhi(x.x); xr[sl][2] = bflo(x.y); xr[sl][3] = bfhi(x.y); xr[sl][4] = bflo(x.z); xr[sl][5] = bfhi(x.z); xr[sl][6] = bflo(x.w); xr[sl][7] = bfhi(x.w);
          if (j >= 3) { float o[8];
#pragma unroll
              for (int e = 0; e < 8; ++e) { float a = bias[e];
#pragma unroll
                  for (int k = 0; k < 4; ++k) a += wk[k][e] * xr[(j - 3 + k) & 3][e];
                  o[e] = silu_f(a); }
              const v4u pk = (v4u){pk2(o[0], o[1]), pk2(o[2], o[3]), pk2(o[4], o[5]), pk2(o[6], o[7])};
              if (isC) { *(LAS v4u*)(L + S1_CM + l * SP + n8 * 2) = pk; *(v4u*)(CCONV + ((size_t)R0 + l) * 256 + g * 128 + n8) = pk; }
              else { *(LAS v4u*)(L + S1_BC + l * SP + n8 * 2) = pk;
#pragma unroll
                  for (int e = 0; e < 8; ++e) *(LAS bf16*)(L + S1_BT + (n8 + e) * SP + l * 2) = (bf16)f2bf(o[e]); } } } }
    __syncthreads();
    const int l0 = 32 * (w >> 1), s0 = 64 * (w & 1);
    f32x16 cb0, cb1;
    { const f32x16 z = {0.f, 0.f, 0.f, 0.f, 0.f, 0.f, 0.f, 0.f, 0.f, 0.f, 0.f, 0.f, 0.f, 0.f, 0.f, 0.f};
      const LAS unsigned char* ar = L + S1_CM + (l0 + r32) * SP + hi * 16;
      cb0 = mma_rows<8>(ar, L + S1_BC + (s0 + r32) * SP + hi * 16, z); cb1 = mma_rows<8>(ar, L + S1_BC + (s0 + 32 + r32) * SP + hi * 16, z); }
    __syncthreads();
#pragma unroll 1
    for (int hh = 0; hh < 4; ++hh) {
        const int h = 4 * g + hh; const float Dk = inp(F, I_DSKIP)[ie * 8 + h];
        { const int cg = tid & 7, seg = tid >> 3, ch = h * 64 + 8 * cg, la = 2 * seg;
          float xv[5][8];
#pragma unroll
          for (int j = 0; j < 5; ++j) { const int l = la - 3 + j; v4u x = (v4u){0u, 0u, 0u, 0u}; if ((c * 128 + l) >= 0) x = *(const v4u*)(X + (size_t)((long)R0 + l) * 1024 + ch);
              xv[j][0] = bflo(x.x); xv[j][1] = bfhi(x.x); xv[j][2] = bflo(x.y); xv[j][3] = bfhi(x.y); xv[j][4] = bflo(x.z); xv[j][5] = bfhi(x.z); xv[j][6] = bflo(x.w); xv[j][7] = bfhi(x.w); }
          const float alast = ACS[hh * 128 + 127], d0 = DT[hh * 128 + la], d1 = DT[hh * 128 + la + 1], e0 = __expf(alast - ACS[hh * 128 + la]), e1 = __expf(alast - ACS[hh * 128 + la + 1]);
#pragma unroll
          for (int e = 0; e < 8; ++e) { float a0 = cb[ch + e], a1 = a0;
#pragma unroll
              for (int k = 0; k < 4; ++k) { const float wv = cw[k * 1024 + ch + e]; a0 += wv * xv[k][e]; a1 += wv * xv[k + 1][e]; }
              const float x0 = silu_f(a0) * d0, x1 = silu_f(a1) * d1;
              *(LAS unsigned*)(L + S1_XD + (8 * cg + e) * SP + la * 2) = pk2(x0, x1); *(LAS unsigned*)(L + S1_XE + (8 * cg + e) * SP + la * 2) = pk2(x0 * e0, x1 * e1); } }
#pragma unroll
        for (int t = 0; t < 2; ++t) { const f32x16 cbv = t == 0 ? cb0 : cb1; const int s = s0 + 32 * t + r32; const float as = ACS[hh * 128 + s];
#pragma unroll
            for (int i = 0; i < 16; ++i) { const int l = l0 + crow(i, hi); float v = 0.f; if (s <= l) v = cbv[i] * __expf(ACS[hh * 128 + l] - as); if (s == l) v += Dk / DT[hh * 128 + l];
                *(LAS bf16*)(L + S1_CM + l * SP + s * 2) = (bf16)f2bf(v); } }
        __syncthreads();
        { const f32x16 z = {0.f, 0.f, 0.f, 0.f, 0.f, 0.f, 0.f, 0.f, 0.f, 0.f, 0.f, 0.f, 0.f, 0.f, 0.f, 0.f};
          const int p0 = 32 * (w & 1);
          const f32x16 y = mma_rows<8>(L + S1_CM + (l0 + r32) * SP + hi * 16, L + S1_XD + (p0 + r32) * SP + hi * 16, z);
#pragma unroll
          for (int i = 0; i < 16; ++i) YD[((size_t)R0 + l0 + crow(i, hi)) * 512 + h * 64 + p0 + r32] = (bf16)f2bf(y[i]);
          const int ps = 32 * (w >> 2), n0 = 32 * (w & 3);
          const f32x16 st = mma_rows<8>(L + S1_XE + (ps + r32) * SP + hi * 16, L + S1_BT + (n0 + r32) * SP + hi * 16, z);
#pragma unroll
          for (int i = 0; i < 16; ++i) STg[(((size_t)bc * 8 + h) * 64 + ps + crow(i, hi)) * 128 + n0 + r32] = (bf16)f2bf(st[i]); }
        __syncthreads();
    }
}

constexpr int S3_PV = 0, S3_CC = 69632, S3_RS = 104448, S3_WT = 105472, S3_EA = 105728;
__device__ __forceinline__ void ssm_s3_item(Frame& F, int item) {
    const int tid = F.tid, lane = F.lane, w = F.wave, r32 = lane & 31, hi = lane >> 5;
    const int g = item & 1, bc = item >> 1, c = bc & 15, b = bc >> 4; const size_t R0 = (size_t)b * SEQ + c * 128;
    LAS unsigned char* L = F.lds; LAS float* RS = (LAS float*)(L + S3_RS); LAS float* WT = (LAS float*)(L + S3_WT); LAS float* EA = (LAS float*)(L + S3_EA);
    const bf16* YD = (const bf16*)(F.ws + WS_YD); const bf16* STg = (const bf16*)(F.ws + WS_SST); const bf16* CCONV = (const bf16*)(F.ws + WS_CCONV); const float* ACSG = (const float*)(F.ws + WS_ACSG);
    const bf16* Z = (const bf16*)(F.ws + WS_Z); bf16* O = (bf16*)(F.ws + WS_A);
    __syncthreads();
    { const int hh = tid >> 7, l = tid & 127; EA[tid] = __expf(ACSG[(R0 + l) * 8 + 4 * g + hh]); }
    for (int idx = tid; idx < 128 * 16; idx += 512) { const int l = idx >> 4, n8 = (idx & 15) * 8; *(LAS v4u*)(L + S3_CC + l * SP + n8 * 2) = *(const v4u*)(CCONV + ((size_t)R0 + l) * 256 + g * 128 + n8); }
    for (int idx = tid; idx < 4 * 64 * 16; idx += 512) { const int hh = idx >> 10, p = (idx >> 4) & 63, n8 = (idx & 15) * 8, h = 4 * g + hh;
        *(LAS v4u*)(L + S3_PV + (hh * 64 + p) * SP + n8 * 2) = *(const v4u*)(STg + ((((size_t)(b * 16 + c)) * 8 + h) * 64 + p) * 128 + n8); }
    __syncthreads();
    const int l0 = 32 * (w >> 1), p0 = 32 * (w & 1);
#pragma unroll 1
    for (int pass = 0; pass < 2; ++pass) {
        float ss[16];
#pragma unroll
        for (int i = 0; i < 16; ++i) ss[i] = pass == 0 ? 0.f : 1.0f / sqrtf((RS[(l0 + crow(i, hi)) * 2] + RS[(l0 + crow(i, hi)) * 2 + 1]) * (1.f / 256.f) + RMS_EPS);
#pragma unroll 1
        for (int hh = 0; hh < 4; ++hh) { const int h = 4 * g + hh; const f32x16 z = {0.f, 0.f, 0.f, 0.f, 0.f, 0.f, 0.f, 0.f, 0.f, 0.f, 0.f, 0.f, 0.f, 0.f, 0.f, 0.f};
            const f32x16 yo = mma_rows<8>(L + S3_CC + (l0 + r32) * SP + hi * 16, L + S3_PV + (hh * 64 + p0 + r32) * SP + hi * 16, z);
            const size_t base = (R0 + l0 + 4 * hi) * 512 + h * 64 + p0 + r32; const bf16* ydp = YD + base; const bf16* zp = Z + base; const LAS float* eap = EA + hh * 128 + l0 + 4 * hi;
            bf16* op = O + (R0 + l0 + 4 * hi) * 1024 + 512 + g * 256 + hh * 64 + p0 + r32;
#pragma unroll
            for (int i = 0; i < 16; ++i) { const int ro = (i & 3) + 8 * (i >> 2);
                const float y = bf2f(ydp[ro * 512]) + yo[i] * eap[ro]; const float t = y * silu_f(bf2f(zp[ro * 512]));
                if (pass == 0) ss[i] += t * t; else op[ro * 1024] = (bf16)f2bf(t * ss[i]); }
        }
        if (pass == 0) {
#pragma unroll
            for (int i = 0; i < 16; ++i) { float s = ss[i]; s += __shfl_xor(s, 1); s += __shfl_xor(s, 2); s += __shfl_xor(s, 4); s += __shfl_xor(s, 8); s += __shfl_xor(s, 16); if (r32 == 0) RS[(l0 + crow(i, hi)) * 2 + (w & 1)] = s; }
            __syncthreads();
        }
    }
}

typedef __attribute__((address_space(3))) const unsigned char* lds_cp;
typedef short v4i16_t __attribute__((ext_vector_type(4)));
__device__ __forceinline__ v4i16_t vtr(lds_cp p) { return __builtin_amdgcn_ds_read_tr16_b64_v4i16((__attribute__((address_space(3))) v4i16_t*)p); }
constexpr int AM_K = 0, AM_V = 16384, AM_PS = 32768, AM_IMP = 65536, AM_RS = 73728;
constexpr float LOG2E = 1.4426950408889634f;
__device__ __forceinline__ unsigned pkbf(float lo, float hi) { return pk2(lo, hi); }

struct AttnStage { v4u k, v; };
__device__ __forceinline__ void am_stage_load(AttnStage& s, const bf16* kb, const bf16* vb, int j, int wid, int lane) {
    s.k = *(const v4u*)(kb + (size_t)(64 * j + lane) * 64 + wid * 8);
    s.v = *(const v4u*)(vb + (size_t)(64 * j + 16 * (wid & 3) + (lane >> 2)) * 64 + (wid >> 2) * 32 + (lane & 3) * 8);
}
__device__ __forceinline__ void am_stage_write(const AttnStage& s, LAS unsigned char* L, int slot, int wid, int lane) {
    *(LAS v4u*)(L + AM_K + slot * 8192 + wid * 1024 + lane * 16) = s.k; *(LAS v4u*)(L + AM_V + slot * 8192 + wid * 1024 + lane * 16) = s.v;
}
__device__ __forceinline__ void am_qkt(f32x16& p0, f32x16& p1, lds_cp kslot, const bf16x8v (&qr)[5], bf16x8v kaug0, bf16x8v kaug1, int r32, int hi) {
    const f32x16 z = {0.f, 0.f, 0.f, 0.f, 0.f, 0.f, 0.f, 0.f, 0.f, 0.f, 0.f, 0.f, 0.f, 0.f, 0.f, 0.f};
    lds_cp kb = kslot + hi * 1024 + r32 * 16;
    p0 = __builtin_amdgcn_mfma_f32_32x32x16_bf16(kaug0, qr[4], z, 0, 0, 0); p1 = __builtin_amdgcn_mfma_f32_32x32x16_bf16(kaug1, qr[4], z, 0, 0, 0);
#pragma unroll
    for (int d0 = 0; d0 < 4; ++d0) { const bf16x8v b0 = *(const LAS bf16x8v*)(kb + d0 * 2048), b1 = *(const LAS bf16x8v*)(kb + d0 * 2048 + 512);
        p0 = __builtin_amdgcn_mfma_f32_32x32x16_bf16(b0, qr[d0], p0, 0, 0, 0); p1 = __builtin_amdgcn_mfma_f32_32x32x16_bf16(b1, qr[d0], p1, 0, 0, 0); }
}
__device__ __forceinline__ void am_pv(f32x16 (&o)[2], lds_cp vb, bf16x8v pa0, bf16x8v pa1, bf16x8v pa2, bf16x8v pa3) {
#pragma unroll
    for (int d0 = 0; d0 < 2; ++d0) {
        v4i16_t lo[4], hh[4];
#pragma unroll
        for (int ks = 0; ks < 4; ++ks) { lo[ks] = vtr(vb + d0 * 4096 + ks * 1024); hh[ks] = vtr(vb + d0 * 4096 + ks * 1024 + 512); }
#define AM_PK(k) (bf16x8v){lo[k][0], lo[k][1], lo[k][2], lo[k][3], hh[k][0], hh[k][1], hh[k][2], hh[k][3]}
        o[d0] = __builtin_amdgcn_mfma_f32_32x32x16_bf16(pa0, AM_PK(0), o[d0], 0, 0, 0); o[d0] = __builtin_amdgcn_mfma_f32_32x32x16_bf16(pa1, AM_PK(1), o[d0], 0, 0, 0);
        o[d0] = __builtin_amdgcn_mfma_f32_32x32x16_bf16(pa2, AM_PK(2), o[d0], 0, 0, 0); o[d0] = __builtin_amdgcn_mfma_f32_32x32x16_bf16(pa3, AM_PK(3), o[d0], 0, 0, 0);
#undef AM_PK
    }
}
__device__ __forceinline__ bf16x8v am_pack8(const f32x16& p, int b) { const v4u w = (v4u){pkbf(p[b], p[b + 1]), pkbf(p[b + 2], p[b + 3]), pkbf(p[b + 4], p[b + 5]), pkbf(p[b + 6], p[b + 7])}; return __builtin_bit_cast(bf16x8v, w); }
__device__ __forceinline__ bf16x8v am_kaug(unsigned w0, unsigned w1, unsigned w2) { const v4u w = (v4u){w0, w1, w2, 0u}; return __builtin_bit_cast(bf16x8v, w); }
__device__ __forceinline__ void am_fold(f32x16 (&fin)[2], const f32x16 (&o)[2], float rowscale, volatile LAS float* rsw, int r32, int hi) {
    asm volatile("" ::: "memory"); if (hi == 0) rsw[r32] = rowscale; asm volatile("s_waitcnt lgkmcnt(0)" ::: "memory");
#pragma unroll
    for (int i = 0; i < 16; ++i) { const float s = rsw[crow(i, hi)]; fin[0][i] += o[0][i] * s; fin[1][i] += o[1][i] * s; }
    asm volatile("s_waitcnt lgkmcnt(0)" ::: "memory");
}

__device__ __forceinline__ void attn_unit(Frame& F, int bg, int jq) {
    const int lane = F.lane, w = F.wave, r32 = lane & 31, hi = lane >> 5, b = bg >> 1, g = bg & 1;
    LAS unsigned char* L = F.lds;
    const bf16* Qg = (const bf16*)(F.ws + WS_Q); const bf16* KVg = (const bf16*)(F.ws + WS_KV); const bf16* KCBb = (const bf16*)(F.ws + WS_KCB); const float* GLDT = (const float*)(F.ws + WS_GLDT);
    const int qloc = r32 >> 2, rh = r32 & 3, tl = 8 * w + qloc, t = 64 * jq + tl, head = 4 * g + rh; const size_t row = (size_t)b * SEQ + t;
    bf16x8v qr[5];
#pragma unroll
    for (int d0 = 0; d0 < 4; ++d0) qr[d0] = *(const bf16x8v*)(Qg + row * 512 + head * 64 + d0 * 16 + hi * 8);
    const float sl2 = exp2f(-(float)(head + 1)) * LOG2E; const float hs = bf2f((bf16)f2bf(sl2)), ls = sl2 - hs;
    const unsigned qa0 = pkbf(hs, ls), qa1 = pkbf(64.f * hs, 64.f * ls), qa2_on = pkbf(-sl2 * (float)tl, 0.f), qa2_off = pkbf(-sl2 * (float)tl, -30000.f);
    qr[4] = hi == 0 ? am_kaug(qa0, qa1, qa2_on) : am_kaug(0u, 0u, 0u);
    const float* gl = GLDT + row * 32 + head * 3; const float g_cmp = sigmoid_f(gl[0]), g_sel = sigmoid_f(gl[1]), g_win = sigmoid_f(gl[2]);
    const unsigned kw0a = hi == 0 ? pkbf((float)r32, (float)r32) : 0u, kw0b = hi == 0 ? pkbf((float)(r32 + 32), (float)(r32 + 32)) : 0u, kw2 = hi == 0 ? pkbf(1.f, 1.f) : 0u;
    volatile LAS float* rsw = (volatile LAS float*)(L + AM_RS) + w * 32;
    lds_cp vb0 = (lds_cp)(L + AM_V) + ((lane >> 4) & 1) * 32 + (lane & 3) * 8 + (4 * hi + ((lane & 15) >> 2)) * 64;
    f32x16 fin[2], o[2];
    const f32x16 zz = {0.f, 0.f, 0.f, 0.f, 0.f, 0.f, 0.f, 0.f, 0.f, 0.f, 0.f, 0.f, 0.f, 0.f, 0.f, 0.f};
    o[0] = zz; o[1] = zz;
    AttnStage st;
    __syncthreads();
    unsigned selm;
    {
        const bf16* kc = KCBb + (size_t)(bg * 128) * 64; const bf16* vc = KCBb + (size_t)(2048 + bg * 128) * 64;
        am_stage_load(st, kc, vc, 0, w, lane); am_stage_write(st, L, 0, w, lane); am_stage_load(st, kc, vc, 1, w, lane); am_stage_write(st, L, 1, w, lane);
        __syncthreads();
        const int cmax = (t - 31) >> 4;
        LAS float* PS = (LAS float*)(L + AM_PS) + (w * 8) * 128; LAS float* IMP = (LAS float*)(L + AM_IMP) + (w * 8) * 32;
        float l = 0.f, inv = 0.f;
#pragma unroll 1
        for (int pass = 0; pass < 2; ++pass) {
#pragma unroll 1
            for (int tile = 0; tile < 2; ++tile) {
                const int c0 = 64 * tile + r32, c1 = c0 + 32, e0 = 16 * c0 + 31, e1 = 16 * c1 + 31;
                const bf16x8v ka0 = am_kaug(hi == 0 ? pkbf((float)(e0 & 63), (float)(e0 & 63)) : 0u, hi == 0 ? pkbf((float)((e0 >> 6) - jq), (float)((e0 >> 6) - jq)) : 0u, kw2);
                const bf16x8v ka1 = am_kaug(hi == 0 ? pkbf((float)(e1 & 63), (float)(e1 & 63)) : 0u, hi == 0 ? pkbf((float)((e1 >> 6) - jq), (float)((e1 >> 6) - jq)) : 0u, kw2);
                f32x16 p0, p1;
                am_qkt(p0, p1, (lds_cp)(L + AM_K + tile * 8192), qr, ka0, ka1, r32, hi);
#pragma unroll
                for (int i = 0; i < 16; ++i) { const int ca = 64 * tile + crow(i, hi), cb2 = ca + 32;
                    p0[i] = (ca <= cmax && ca <= 126) ? __builtin_amdgcn_exp2f(p0[i]) : 0.f; p1[i] = (cb2 <= cmax && cb2 <= 126) ? __builtin_amdgcn_exp2f(p1[i]) : 0.f; }
                if (pass == 0) {
#pragma unroll
                    for (int i = 0; i < 16; ++i) l += p0[i] + p1[i];
                } else {
#pragma unroll
                    for (int i = 0; i < 16; ++i) { p0[i] *= inv; p1[i] *= inv; }
#pragma unroll
                    for (int half = 0; half < 2; ++half)
#pragma unroll
                        for (int k = 0; k < 4; ++k) { f32x4 s4;
#pragma unroll
                            for (int e = 0; e < 4; ++e) { float x = half == 0 ? p0[4 * k + e] : p1[4 * k + e]; x += __shfl_xor(x, 1); x += __shfl_xor(x, 2); s4[e] = x; }
                            if (rh == 0) *(LAS f32x4*)(PS + qloc * 128 + 64 * tile + 32 * half + 8 * k + 4 * hi) = s4; }
                    am_pv(o, vb0 + tile * 8192, am_pack8(p0, 0), am_pack8(p0, 8), am_pack8(p1, 0), am_pack8(p1, 8));
                }
            }
            if (pass == 0) { l += __shfl_xor(l, 32); inv = l > 0.f ? 1.0f / l : 0.f; }
        }
        fin[0] = zz; fin[1] = zz; am_fold(fin, o, g_cmp, rsw, r32, hi); o[0] = zz; o[1] = zz;
        asm volatile("s_waitcnt lgkmcnt(0)" ::: "memory");
        {
            const int q2 = lane >> 3, jb = (lane & 7) * 4; const volatile LAS float* ps = PS + q2 * 128; volatile LAS float* im = IMP + q2 * 32;
#pragma unroll
            for (int jj = 0; jj < 4; ++jj) { const int j = jb + jj; float imp = ps[4 * j] + ps[4 * j + 1] + ps[4 * j + 2] + 0.5f * ps[4 * j + 3] + (j > 0 ? 0.5f * ps[4 * j - 1] : 0.f);
                if (j == 0 || j == jq || j == jq - 1) imp += 1e4f; im[j] = j <= jq ? imp : -1.0f; }
            asm volatile("s_waitcnt lgkmcnt(0)" ::: "memory");
            unsigned m = 0u;
#pragma unroll
            for (int jj = 0; jj < 4; ++jj) { const int j = jb + jj; const float v = im[j]; int rank = 0;
#pragma unroll 8
                for (int o2 = 0; o2 < 32; ++o2) { const float vo = im[o2]; rank += (vo > v || (vo == v && o2 < j)) ? 1 : 0; }
                if (rank < 16) m |= 1u << j; }
            m |= __shfl_xor(m, 1); m |= __shfl_xor(m, 2); m |= __shfl_xor(m, 4);
            selm = __shfl(m, 8 * qloc);
        }
        __syncthreads();
    }
    unsigned anysel = selm; anysel |= __shfl_xor(anysel, 4); anysel |= __shfl_xor(anysel, 8); anysel |= __shfl_xor(anysel, 16); anysel = __builtin_amdgcn_readfirstlane(anysel);
    const bf16* ks = KVg + ((size_t)2 << 21) + (size_t)bg * SEQ * 64; const bf16* vs = KVg + ((size_t)3 << 21) + (size_t)bg * SEQ * 64;
    const bf16* kwn = KVg + ((size_t)4 << 21) + (size_t)bg * SEQ * 64; const bf16* vwn = KVg + ((size_t)5 << 21) + (size_t)bg * SEQ * 64;
    const int nsel = jq + 1, jw0 = jq >= 8 ? jq - 8 : 0, nwin = jq - jw0 + 1, nst = nsel + nwin;
    float l = 0.f;
    am_stage_load(st, ks, vs, 0, w, lane); am_stage_write(st, L, 0, w, lane);
    if (nst > 1) { if (1 < nsel) am_stage_load(st, ks, vs, 1, w, lane); else am_stage_load(st, kwn, vwn, jw0, w, lane); }
    __syncthreads();
#pragma unroll 1
    for (int s = 0; s < nst; ++s) {
        const bool win = s >= nsel; const int j = win ? jw0 + (s - nsel) : s; const int slot = s & 1;
        if (win && s == nsel) { am_fold(fin, o, (l + __shfl_xor(l, 32)) > 0.f ? g_sel / (l + __shfl_xor(l, 32)) : 0.f, rsw, r32, hi); o[0] = zz; o[1] = zz; l = 0.f; }
        if (win || ((anysel >> j) & 1u)) {
            const float wr = (float)(j - jq); const unsigned kw1 = hi == 0 ? pkbf(wr, wr) : 0u;
            if (hi == 0) { v4u qa = (v4u){qa0, qa1, (win || ((selm >> j) & 1u)) ? qa2_on : qa2_off, 0u}; qr[4] = __builtin_bit_cast(bf16x8v, qa); }
            f32x16 p0, p1;
            am_qkt(p0, p1, (lds_cp)(L + AM_K + slot * 8192), qr, am_kaug(kw0a, kw1, kw2), am_kaug(kw0b, kw1, kw2), r32, hi);
            const bool diag = (j == jq), edge = win && (jq >= 8) && (j == jw0);
            if (diag || edge) {
#pragma unroll
                for (int i = 0; i < 16; ++i) { const int kv0 = crow(i, hi), kv1 = kv0 + 32;
                    const bool bad0 = diag ? (kv0 > tl) : (kv0 <= tl), bad1 = diag ? (kv1 > tl) : (kv1 <= tl);
                    if (bad0) p0[i] = -1e30f; if (bad1) p1[i] = -1e30f; } }
#pragma unroll
            for (int i = 0; i < 16; ++i) { p0[i] = __builtin_amdgcn_exp2f(p0[i]); p1[i] = __builtin_amdgcn_exp2f(p1[i]); l += p0[i] + p1[i]; }
            am_pv(o, vb0 + slot * 8192, am_pack8(p0, 0), am_pack8(p0, 8), am_pack8(p1, 0), am_pack8(p1, 8));
        }
        if (s + 1 < nst) am_stage_write(st, L, slot ^ 1, w, lane);
        __syncthreads();
        if (s + 2 < nst) { if (s + 2 < nsel) am_stage_load(st, ks, vs, s + 2, w, lane); else am_stage_load(st, kwn, vwn, jw0 + (s + 2 - nsel), w, lane); }
    }
    { const float lt = l + __shfl_xor(l, 32); am_fold(fin, o, lt > 0.f ? g_win / lt : 0.f, rsw, r32, hi); }
    bf16* O = (bf16*)(F.ws + WS_A);
#pragma unroll
    for (int i = 0; i < 16; ++i) { const int rho = crow(i, hi); const size_t orow = (size_t)b * SEQ + 64 * jq + 8 * w + (rho >> 2); bf16* op = O + orow * 1024 + (4 * g + (rho & 3)) * 64 + r32;
        op[0] = (bf16)f2bf(fin[0][i]); op[32] = (bf16)f2bf(fin[1][i]); }
}

constexpr int GM_V = 0, GM_W = 65536, GM_ST = GM_W + 128 * SP;
static_assert(GM_ST + 1024 <= SCR_BYTES, "gMLP LDS map");
__device__ __forceinline__ void gmlp_item(Frame& F, int io, int item) {
    const int tid = F.tid, lane = F.lane, w = F.wave, r32 = lane & 31, hi = lane >> 5; const int g = item & 7, bc = item >> 3; const size_t row0 = (size_t)bc * 128;
    LAS unsigned char* L = F.lds; LAS float* ST = (LAS float*)(L + GM_ST);
    bf16* U = (bf16*)(F.ws + WS_U); const bf16* V = (const bf16*)(F.ws + WS_V); const float* STg = (const float*)(F.ws + WS_ST);
    const float* lnw = inp(F, I_LNW) + (size_t)io * 2048 + g * 256; const float* lnb = inp(F, I_LNB) + (size_t)io * 2048 + g * 256;
    const float* wsg = inp(F, I_WS) + ((size_t)io * 8 + g) * 128 * 128; const float* bsg = inp(F, I_BS) + ((size_t)io * 8 + g) * 128;
    __syncthreads();
    if (tid < 128) { const float* p = STg + (row0 + tid) * 64; float s = 0.f, ss = 0.f;
        for (int k = 0; k < 32; ++k) { s += p[2 * k]; ss += p[2 * k + 1]; }
        const float mean = s * (1.f / 2048.f), var = ss * (1.f / 2048.f) - mean * mean; ST[2 * tid] = mean; ST[2 * tid + 1] = 1.0f / sqrtf(fmaxf(var, 0.f) + LN_EPS); }
    for (int idx = tid; idx < 128 * 16; idx += 512) { const int t = idx >> 4, s8 = (idx & 15) * 8; const f32x4 a = *(const f32x4*)(wsg + t * 128 + s8), b2 = *(const f32x4*)(wsg + t * 128 + s8 + 4);
        float f[8] = {a.x, a.y, a.z, a.w, b2.x, b2.y, b2.z, b2.w};
#pragma unroll
        for (int e = 0; e < 8; ++e) if (s8 + e > t) f[e] = 0.f;
        *(LAS v4u*)(L + GM_W + t * SP + s8 * 2) = (v4u){pk2(f[0], f[1]), pk2(f[2], f[3]), pk2(f[4], f[5]), pk2(f[6], f[7])}; }
    __syncthreads();
    { const int ch = tid & 31, c8 = ch * 8; float lw[8], lb[8];
#pragma unroll
      for (int e = 0; e < 8; ++e) { lw[e] = lnw[c8 + e]; lb[e] = lnb[c8 + e]; }
#pragma unroll
      for (int k = 0; k < 8; ++k) { const int s = (tid >> 5) + 16 * k; const v4u x = *(const v4u*)(V + (row0 + s) * 2048 + g * 256 + c8); const float mean = ST[2 * s], rstd = ST[2 * s + 1];
          float f[8] = {bflo(x.x), bfhi(x.x), bflo(x.y), bfhi(x.y), bflo(x.z), bfhi(x.z), bflo(x.w), bfhi(x.w)};
#pragma unroll
          for (int e = 0; e < 8; ++e) f[e] = (f[e] - mean) * rstd * lw[e] + lb[e];
          *(LAS v4u*)(L + GM_V + (ch >> 2) * 8192 + s * 64 + (ch & 3) * 16) = (v4u){pk2(f[0], f[1]), pk2(f[2], f[3]), pk2(f[4], f[5]), pk2(f[6], f[7])}; } }
    __syncthreads();
    const int tb = w >> 1, t0 = 32 * tb, db0 = 4 * (w & 1);
    const f32x16 zz = {0.f, 0.f, 0.f, 0.f, 0.f, 0.f, 0.f, 0.f, 0.f, 0.f, 0.f, 0.f, 0.f, 0.f, 0.f, 0.f};
    f32x16 acc[4] = {zz, zz, zz, zz};
    const LAS unsigned char* ap = L + GM_W + (t0 + r32) * SP + hi * 16;
    lds_cp vb = (lds_cp)(L + GM_V) + ((lane >> 4) & 1) * 32 + (lane & 3) * 8 + (8 * hi + ((lane & 15) >> 2)) * 64;
#pragma unroll 1
    for (int ks = 0; ks < 2 * (tb + 1); ++ks) {
        const bf16x8v a = *(const LAS bf16x8v*)(ap + ks * 32);
#pragma unroll
        for (int q = 0; q < 4; ++q) { const v4i16_t lo = vtr(vb + (db0 + q) * 8192 + ks * 1024), h4 = vtr(vb + (db0 + q) * 8192 + ks * 1024 + 256);
            const bf16x8v bfr = (bf16x8v){lo[0], lo[1], lo[2], lo[3], h4[0], h4[1], h4[2], h4[3]};
            acc[q] = __builtin_amdgcn_mfma_f32_32x32x16_bf16(a, bfr, acc[q], 0, 0, 0); }
    }
    bf16* up = U + (row0 + t0 + 4 * hi) * 2048 + g * 256 + db0 * 32 + r32; const float* bp = bsg + t0 + 4 * hi;
#pragma unroll
    for (int i = 0; i < 16; ++i) { const int ro = (i & 3) + 8 * (i >> 2); const float bs = bp[ro];
#pragma unroll
        for (int q = 0; q < 4; ++q) { bf16* o = up + (size_t)ro * 2048 + q * 32; *o = (bf16)f2bf(bf2f(*o) * (acc[q][i] + bs)); }
        if ((i & 3) == 3) asm volatile("" ::: "memory"); }
}

enum Kind { K_PREP = 0, K_G1, K_E3, K_E4, K_E5, K_GY, K_RP, K_G3, K_G5, K_O2 };
constexpr int N_PHASES = 33;
struct Args { const float* in[22]; float* out; unsigned char* ws; int ph_lo, ph_hi; };

__global__ void __launch_bounds__(NWAVES * 64, 2) mk_fwd(Args args) {
    extern __shared__ __attribute__((aligned(16))) unsigned char lds_raw[];
    Frame F;
    F.lds = (LAS unsigned char*)(uintptr_t)0u  ; F.ws = args.ws; F.out = args.out;
    F.wave = __builtin_amdgcn_readfirstlane(threadIdx.x >> 6); F.G = gridDim.x; F.bid = blockIdx.x;
    volatile LAS unsigned* MISC = (volatile LAS unsigned*)((LAS unsigned char*)lds_raw + MISC_OFF);
    { const int t0 = threadIdx.x; if (t0 < 32) MISC[t0] = 0u;
      if (t0 >= 64 && t0 < 64 + 22) { const unsigned long long pv = (unsigned long long)args.in[t0 - 64]; MISC[32 + 2 * (t0 - 64)] = (unsigned)pv; MISC[33 + 2 * (t0 - 64)] = (unsigned)(pv >> 32); } }
    __syncthreads();
    const int wave0 = __builtin_amdgcn_readfirstlane(threadIdx.x >> 6);
    XcdBarrier bar = xcd_barrier_post((unsigned*)(F.ws + WS_CTL) + CW_BAR, MISC + 8);

    for (int p = args.ph_lo; p < args.ph_hi; ++p) {
        int L = 0, k = 0, kind = K_PREP, var = 0;
        if (p > 0) { const int q = p - 1; if (q < 9) { L = 0; k = q; } else if (q < 16) { L = 1; k = q - 9; } else if (q < 25) { L = 2; k = q - 16; } else { L = 3; k = q - 25; }
            if ((L & 1) == 0) { kind = (int)((0x657654321ull >> (4 * k)) & 15ull); var = (int)((0x110000000ull >> (4 * k)) & 15ull); }
            else { kind = (int)((0x6576598ull >> (4 * k)) & 15ull); var = (int)((0x1102200ull >> (4 * k)) & 15ull); } }
        { unsigned long long wsv = (unsigned long long)args.ws, outv = (unsigned long long)args.out; int wv = wave0, bidv = blockIdx.x, gv = gridDim.x;
          asm volatile("" : "+s"(wsv), "+s"(outv), "+s"(bidv), "+s"(gv), "+s"(wv));
          int tidv = (wv << 6) | flane(); asm volatile("" : "+v"(tidv));
          F.ws = (unsigned char*)wsv; F.out = (float*)outv; F.tid = tidv; F.lane = tidv & 63; F.wave = wv; F.G = gv; F.bid = bidv; }
        const int ie = L >> 1;
        unsigned char* wev = F.ws + WS_WEV + (size_t)ie * WEV_STRIDE; unsigned char* wod = F.ws + WS_WOD + (size_t)ie * WOD_STRIDE; unsigned char* wff = F.ws + WS_WFFN + (size_t)L * WFFN_STRIDE;
        switch (kind) {
        case K_PREP:
#ifndef NO_P0
            p0_prologue(F);
#endif
            break;
        case K_G1: {
#ifndef NO_K_G1
            pg8::Gemm g{(const bf16*)(F.ws + WS_A), (const bf16*)wev, M, EV_IN_PAD, D, D}; pg8::StaticOrder S; S.init(M, EV_IN_PAD, F.G, F.bid);
            pg8::EpiProj E{(bf16*)(F.ws + WS_Q), (bf16*)(F.ws + WS_KV), (bf16*)(F.ws + WS_Z), (bf16*)(F.ws + WS_XBC), (float*)(F.ws + WS_GLDT)};
            pg8::gemm_phase<pg8::EpiProj, pg8::StaticOrder, true, true>(F.lds, g, S, E, F.tid);
#endif
            } break;
        case K_E3: {
#ifndef NO_K_E3
            pg8::Gemm g{(const bf16*)(F.ws + WS_KV), (const bf16*)(wev + 8 * MiB), 4096, 512, 2048, 1024}; pg8::CmpOrder S{F.bid};
            pg8::EpiCmp E{(bf16*)(F.ws + WS_H1), (const float*)(F.ws + WS_SMALL) + ie * 512};
            pg8::gemm_phase<pg8::EpiCmp, pg8::CmpOrder, true, true>(F.lds, g, S, E, F.tid);
            if (F.bid >= 16) for (int it = F.bid - 16; it < 256; it += F.G - 16) ssm_s1_item(F, ie, it);

#endif
            } break;
        case K_E4:
#ifndef NO_E4
            compress2_mfma(F, ie); ssm_scan_chunks(F);
#endif
            break;
        case K_E5: {
#ifndef NO_S3
            for (int it = F.bid; it < 256; it += F.G) ssm_s3_item(F, it);
#endif
#ifndef NO_E5
            for (int u = F.bid; u < 256; u += F.G) { const int bg = u & 15, s = u >> 4; attn_unit(F, bg, 31 - s); attn_unit(F, bg, s); }
#endif
            } break;
        case K_GY: {
#ifndef NO_K_GY
            const bf16* A = var == 0 ? (const bf16*)(F.ws + WS_A) : var == 1 ? (const bf16*)(F.ws + WS_T) : (const bf16*)(F.ws + WS_U);
            const bf16* W = var == 0 ? (const bf16*)(wev + 6 * MiB) : var == 1 ? (const bf16*)(wff + (size_t)5632 * 1024 * 2) : (const bf16*)(wod + 8 * MiB);
            const int K = var == 0 ? 1024 : var == 1 ? FFH : 2048; bf16* Y = (bf16*)(F.ws + (var == 0 ? WS_YEV : var == 1 ? WS_YFF : WS_YOD));
            pg8::Gemm g{A, W, M, D, K, K}; pg8::StaticOrder S; S.init(M, D, F.G, F.bid); pg8::EpiBf16Plain E{Y, D};
            pg8::gemm_phase<pg8::EpiBf16Plain, pg8::StaticOrder, true, true>(F.lds, g, S, E, F.tid);
#endif
            } break;
        case K_RP: {
            const bf16* Y = (const bf16*)(F.ws + (var == 0 ? WS_YEV : var == 1 ? WS_YFF : WS_YOD)); const bool mixer = (var != 1);
            const float* hin = (L == 0 && mixer) ? inp(F, I_X) : F.out; bf16* aout = (L == DEPTH - 1 && !mixer) ? nullptr : (bf16*)(F.ws + WS_A);
            rowpass(F, Y, hin, F.out, aout, inp(F, I_GAINS) + (L * 4 + (mixer ? 1 : 3)) * D); } break;
        case K_G3: {
#ifndef NO_K_G3
            pg8::Gemm g{(const bf16*)(F.ws + WS_A), (const bf16*)wff, M, 2 * FFH, D, D}; pg8::StaticOrder S; S.init(M, 2 * FFH, F.G, F.bid);
            pg8::EpiSwiGLU E{(bf16*)(F.ws + WS_T), FFH};
            pg8::gemm_phase<pg8::EpiSwiGLU, pg8::StaticOrder, true, true>(F.lds, g, S, E, F.tid);
#endif
            } break;
        case K_G5: {
#ifndef NO_K_G5
            pg8::Gemm g{(const bf16*)(F.ws + WS_A), (const bf16*)wod, M, 4096, D, D}; pg8::StaticOrder S; S.init(M, 4096, F.G, F.bid);
            pg8::EpiGelu E{(bf16*)(F.ws + WS_U), (bf16*)(F.ws + WS_V), (float*)(F.ws + WS_ST)};
            pg8::gemm_phase<pg8::EpiGelu, pg8::StaticOrder, true, true>(F.lds, g, S, E, F.tid);
#endif
            } break;
        case K_O2: {
#ifndef NO_O2
            for (int it = F.bid; it < 1024; it += F.G) gmlp_item(F, ie, it);
#endif
            } break;
        default: break;
        }
        if (p + 1 < args.ph_hi) xcd_barrier(bar, F.wave);
    }
}

#ifndef MK_PER_PHASE
#define MK_PER_PHASE 0
#endif
extern "C" void kernel_launch(void* const* d_in, const int* in_sizes, int n_in, void* d_out, int out_size, void* d_ws, size_t ws_size, hipStream_t stream) {
    static int grid = 0;
    if (grid == 0) {
        if (n_in != 22 || in_sizes[0] != M * D || out_size != M * D || ws_size < WS_END) { fprintf(stderr, "kernel_launch: unexpected shapes (n_in %d, in0 %d, out %d, ws %zu)\n", n_in, n_in > 0 ? in_sizes[0] : -1, out_size, ws_size); grid = -1; return; }
        int dev = 0, cus = 0, per_cu = 0;
        if (hipGetDevice(&dev) != hipSuccess || hipDeviceGetAttribute(&cus, hipDeviceAttributeMultiprocessorCount, dev) != hipSuccess) { grid = -1; return; }
        if (hipFuncSetAttribute((const void*)mk_fwd, hipFuncAttributeMaxDynamicSharedMemorySize, LDS_BYTES) != hipSuccess) { fprintf(stderr, "kernel_launch: hipFuncSetAttribute failed\n"); grid = -1; return; }
        if (hipOccupancyMaxActiveBlocksPerMultiprocessor(&per_cu, (const void*)mk_fwd, NWAVES * 64, LDS_BYTES) != hipSuccess || per_cu < 1) { fprintf(stderr, "kernel_launch: occupancy query says %d\n", per_cu); per_cu = 1; }
        (void)hipGetLastError();
        grid = cus;
        if (grid != 256) fprintf(stderr, "kernel_launch: %d CUs (built for 256)\n", grid);
    }
    if (grid < 0) return;
    Args a{};
    for (int i = 0; i < 22; ++i) a.in[i] = (const float*)d_in[i];
    a.out = (float*)d_out; a.ws = (unsigned char*)d_ws;
#if MK_PER_PHASE
    for (int p = 0; p < N_PHASES; ++p) { a.ph_lo = p; a.ph_hi = p + 1; hipLaunchKernelGGL(mk_fwd, dim3(grid), dim3(NWAVES * 64), LDS_BYTES, stream, a); }
#else
    (void)hipMemsetAsync((char*)d_ws + WS_CTL, 0, CTL_ZERO_BYTES, stream);
    a.ph_lo = 0; a.ph_hi = N_PHASES;
    hipLaunchKernelGGL(mk_fwd, dim3(grid), dim3(NWAVES * 64), LDS_BYTES, stream, a);
#endif
}
```
